# Optimizing an MI355X kernel written in HIP

```python
import jax
import jax.numpy as jnp
from jax import lax
import numpy as np

D_MODEL = 1024
BATCH = 32
SEQ = 2048
DEPTH = 2

CHUNK = 64
MLSTM_HEADS = 8
MLSTM_HEAD_DIM = D_MODEL // MLSTM_HEADS
MLSTM_WIDTH = MLSTM_HEADS * MLSTM_HEAD_DIM
MLSTM_CONV = 4
GATE_SOFT_CAP = 15.0
HGRN_HEADS = 8
HGRN_EXPAND = D_MODEL // HGRN_HEADS
HGRN_HEAD_DIM = D_MODEL // HGRN_HEADS
HGRN_KEY_WIDTH = HGRN_HEADS * HGRN_EXPAND
HGRN_WIDTH = HGRN_HEADS * HGRN_HEAD_DIM
HGRN_BLOCK = 16
D_FF = 2816
FFN_CONV = 3
RMS_EPS = 1e-6
NEG_BIG = -1e30
PROJ_COLS = (2 * MLSTM_WIDTH, MLSTM_WIDTH, MLSTM_WIDTH, MLSTM_HEADS, MLSTM_HEADS,
             HGRN_KEY_WIDTH, HGRN_KEY_WIDTH, HGRN_WIDTH, HGRN_WIDTH, D_MODEL, D_MODEL)
PROJ_WIDTH = sum(PROJ_COLS)
OFF_MLSTM_F = 4 * MLSTM_WIDTH + MLSTM_HEADS

kernel_name = 'hybrid_mlstm_hgrn2_convffn_adaln'


def rms_norm(x, w):
    xf = x.astype(jnp.float32)
    y = xf * lax.rsqrt(jnp.mean(xf * xf, axis=-1, keepdims=True) + RMS_EPS)
    return (y * w.astype(jnp.float32)).astype(x.dtype)


def head_rms_norm(y, w):
    y = y * lax.rsqrt(jnp.mean(y * y, axis=-1, keepdims=True) + RMS_EPS)
    return y.reshape(y.shape[:2] + (-1,)) * w.astype(jnp.float32)


def causal_dwconv(x, w, b):
    width, s = w.shape[0], x.shape[1]
    xp = jnp.pad(x, ((0, 0), (width - 1, 0), (0, 0)))
    out = b + xp[:, width - 1:width - 1 + s] * w[width - 1]
    for j in range(width - 1):
        out = out + xp[:, j:j + s] * w[j]
    return out


def soft_cap(z):
    return GATE_SOFT_CAP * jnp.tanh(z / GATE_SOFT_CAP)


def to_chunks(t, size):
    b, s = t.shape[:2]
    t = t.reshape((b, s // size, size) + t.shape[2:])
    return jnp.moveaxis(jnp.swapaxes(t, 2, 3), 1, 0)


def from_chunks(t):
    nc, b, h, l, d = t.shape
    return jnp.swapaxes(jnp.moveaxis(t, 0, 1), 2, 3).reshape(b, nc * l, h, d)


def mlstm_chunkwise(q, k, v, i_pre, f_pre):
    f32 = jnp.float32
    b, s = q.shape[:2]
    shp = (b, s, MLSTM_HEADS, MLSTM_HEAD_DIM)
    q = q.astype(f32).reshape(shp)
    k = k.astype(f32).reshape(shp) * (MLSTM_HEAD_DIM ** -0.5)
    v = v.astype(f32).reshape(shp)
    log_i = soft_cap(i_pre.astype(f32))
    log_f = jax.nn.log_sigmoid(soft_cap(f_pre.astype(f32)))
    causal = jnp.tril(jnp.ones((CHUNK, CHUNK), dtype=bool))

    def step(carry, xs):
        c_st, n_st, m_st = carry
        qc, kc, vc, ic, fc = xs
        bcum = jnp.cumsum(fc, axis=-1)
        dmat = jnp.where(causal, bcum[..., :, None] - bcum[..., None, :] + ic[..., None, :], NEG_BIG)
        m_inter = bcum + m_st[..., None]
        m_t = jnp.maximum(m_inter, jnp.max(dmat, axis=-1))
        w_intra = jnp.einsum('bhtd,bhsd->bhts', qc, kc) * jnp.exp(dmat - m_t[..., None])
        w_inter = jnp.exp(m_inter - m_t)
        num = (jnp.einsum('bhts,bhsv->bhtv', w_intra, vc)
               + w_inter[..., None] * jnp.einsum('bhtd,bhdv->bhtv', qc, c_st))
        den = jnp.sum(w_intra, axis=-1) + w_inter * jnp.einsum('bhtd,bhd->bht', qc, n_st)
        h = num / jnp.maximum(jnp.abs(den), jnp.exp(-m_t))[..., None]
        b_last = bcum[..., -1]
        g = b_last[..., None] - bcum + ic
        m_new = jnp.maximum(b_last + m_st, jnp.max(g, axis=-1))
        wk = jnp.exp(g - m_new[..., None])
        decay = jnp.exp(b_last + m_st - m_new)
        c_st = decay[..., None, None] * c_st + jnp.einsum('bhs,bhsd,bhsv->bhdv', wk, kc, vc)
        n_st = decay[..., None] * n_st + jnp.einsum('bhs,bhsd->bhd', wk, kc)
        return (c_st, n_st, m_new), h

    init = (jnp.zeros((b, MLSTM_HEADS, MLSTM_HEAD_DIM, MLSTM_HEAD_DIM), f32),
            jnp.zeros((b, MLSTM_HEADS, MLSTM_HEAD_DIM), f32),
            jnp.zeros((b, MLSTM_HEADS), f32))
    xs = (to_chunks(q, CHUNK), to_chunks(k, CHUNK), to_chunks(v, CHUNK),
          to_chunks(log_i, CHUNK), to_chunks(log_f, CHUNK))
    _, h = lax.scan(step, init, xs)
    return from_chunks(h)


def hgrn2_chunkwise(q_pre, f_pre, i_in, lower_bound):
    f32 = jnp.float32
    b, s = q_pre.shape[:2]
    kshp = (b, s, HGRN_HEADS, HGRN_EXPAND)
    q = jax.nn.silu(q_pre.astype(f32)).reshape(kshp)
    fp = f_pre.astype(f32).reshape(kshp)
    lb = lower_bound.astype(f32).reshape(HGRN_HEADS, HGRN_EXPAND)
    sig = jax.nn.sigmoid(fp)
    log_f = jnp.log(lb + (1.0 - lb) * sig)
    k = (1.0 - lb) * (1.0 - sig)
    v = i_in.astype(f32).reshape(b, s, HGRN_HEADS, HGRN_HEAD_DIM)
    causal = jnp.tril(jnp.ones((HGRN_BLOCK, HGRN_BLOCK), dtype=bool))[:, :, None]

    def step(s_st, xs):
        qc, kc, fc, vc = xs
        acum = jnp.cumsum(fc, axis=2)
        pair = jnp.exp(jnp.where(causal, acum[:, :, :, None, :] - acum[:, :, None, :, :], NEG_BIG))
        scores = jnp.einsum('bhtk,bhsk,bhtsk->bhts', qc, kc, pair)
        o = (jnp.einsum('bhts,bhsv->bhtv', scores, vc)
             + jnp.einsum('bhtk,bhkv->bhtv', qc * jnp.exp(acum), s_st))
        a_last = acum[:, :, -1]
        s_st = (jnp.exp(a_last)[..., None] * s_st
                + jnp.einsum('bhsk,bhsv->bhkv', kc * jnp.exp(a_last[:, :, None] - acum), vc))
        return s_st, o

    init = jnp.zeros((b, HGRN_HEADS, HGRN_EXPAND, HGRN_HEAD_DIM), f32)
    xs = (to_chunks(q, HGRN_BLOCK), to_chunks(k, HGRN_BLOCK),
          to_chunks(log_f, HGRN_BLOCK), to_chunks(v, HGRN_BLOCK))
    _, o = lax.scan(step, init, xs)
    return from_chunks(o)


def token_mixer(h, lower_bound, in_w, in_b, m_conv_w, m_conv_b, m_norm_w, h_norm_w, out_w):
    f32 = jnp.float32
    p = h @ in_w + in_b
    split_points = [int(t) for t in np.cumsum(PROJ_COLS)[:-1]]
    m_qk, m_v, m_o, m_i, m_f, h_q, h_f, h_i, h_g, g_a, g_b = jnp.split(p, split_points, axis=-1)
    m_qk = jax.nn.silu(causal_dwconv(m_qk, m_conv_w, m_conv_b))
    m_q, m_k = jnp.split(m_qk, 2, axis=-1)
    y_a = head_rms_norm(mlstm_chunkwise(m_q, m_k, m_v, m_i, m_f), m_norm_w) * jax.nn.sigmoid(m_o.astype(f32))
    y_b = head_rms_norm(hgrn2_chunkwise(h_q, h_f, h_i, lower_bound), h_norm_w) * jax.nn.silu(h_g.astype(f32))
    y = jax.nn.sigmoid(g_a.astype(f32)) * y_a + jax.nn.sigmoid(g_b.astype(f32)) * y_b
    return y.astype(h.dtype) @ out_w


def conv_ffn(h, up_w, conv_w, conv_b, down_w):
    u = causal_dwconv(h @ up_w, conv_w, conv_b)
    gate, val = jnp.split(u, 2, axis=-1)
    return (jax.nn.silu(gate) * val) @ down_w


def setup_inputs(seed: int = 0) -> dict:
    key = jax.random.key(seed)
    ks = jax.random.split(key, 19)

    def nrm(k, shape, scale):
        return jax.random.normal(k, shape, jnp.float32) * scale

    def gain(k, shape):
        return 1.0 + nrm(k, shape, 0.02)

    in_b = nrm(ks[6], (DEPTH, PROJ_WIDTH), 0.02)
    in_b = in_b.at[:, OFF_MLSTM_F:OFF_MLSTM_F + MLSTM_HEADS].add(
        jnp.linspace(3.0, 6.0, MLSTM_HEADS, dtype=jnp.float32))
    return {
        'x': nrm(ks[0], (BATCH, SEQ, D_MODEL), 1.0),
        'c': nrm(ks[1], (BATCH, D_MODEL), 1.0),
        'ada_w': nrm(ks[2], (DEPTH, D_MODEL, 6 * D_MODEL), 0.5 * D_MODEL ** -0.5),
        'ada_b': nrm(ks[3], (DEPTH, 6 * D_MODEL), 0.02),
        'mix_norm_w': gain(ks[4], (DEPTH, D_MODEL)),
        'in_w': nrm(ks[5], (DEPTH, D_MODEL, PROJ_WIDTH), D_MODEL ** -0.5),
        'in_b': in_b,
        'mlstm_conv_w': nrm(ks[7], (DEPTH, MLSTM_CONV, 2 * MLSTM_WIDTH), MLSTM_CONV ** -0.5),
        'mlstm_conv_b': nrm(ks[8], (DEPTH, 2 * MLSTM_WIDTH), 0.02),
        'mlstm_norm_w': gain(ks[9], (DEPTH, MLSTM_WIDTH)),
        'hgrn_lower_bounds': nrm(ks[10], (DEPTH, HGRN_KEY_WIDTH), 0.5),
        'hgrn_norm_w': gain(ks[11], (DEPTH, HGRN_WIDTH)),
        'out_w': nrm(ks[12], (DEPTH, D_MODEL, D_MODEL), D_MODEL ** -0.5),
        'ffn_norm_w': gain(ks[13], (DEPTH, D_MODEL)),
        'ffn_up_w': nrm(ks[14], (DEPTH, D_MODEL, 2 * D_FF), D_MODEL ** -0.5),
        'ffn_conv_w': nrm(ks[15], (DEPTH, FFN_CONV, 2 * D_FF), FFN_CONV ** -0.5),
        'ffn_conv_b': nrm(ks[16], (DEPTH, 2 * D_FF), 0.02),
        'ffn_down_w': nrm(ks[17], (DEPTH, D_FF, D_MODEL), D_FF ** -0.5),
        'final_norm_w': gain(ks[18], (D_MODEL,)),
    }


def reference(x, c, ada_w, ada_b, mix_norm_w, in_w, in_b, mlstm_conv_w, mlstm_conv_b,
              mlstm_norm_w, hgrn_lower_bounds, hgrn_norm_w, out_w, ffn_norm_w, ffn_up_w,
              ffn_conv_w, ffn_conv_b, ffn_down_w, final_norm_w):
    lb_soft = jax.nn.softmax(hgrn_lower_bounds.astype(jnp.float32), axis=0)
    lower_bounds = jnp.cumsum(lb_soft, axis=0) - lb_soft[0]
    c_act = jax.nn.silu(c)
    for layer in range(DEPTH):
        mod = (c_act @ ada_w[layer] + ada_b[layer])[:, None, :]
        shift_m, scale_m, gate_m, shift_f, scale_f, gate_f = jnp.split(mod, 6, axis=-1)
        h = rms_norm(x, mix_norm_w[layer]) * (1.0 + scale_m) + shift_m
        x = x + gate_m * token_mixer(h, lower_bounds[layer], in_w[layer], in_b[layer],
                                     mlstm_conv_w[layer], mlstm_conv_b[layer],
                                     mlstm_norm_w[layer], hgrn_norm_w[layer], out_w[layer])
        h = rms_norm(x, ffn_norm_w[layer]) * (1.0 + scale_f) + shift_f
        x = x + gate_f * conv_ffn(h, ffn_up_w[layer], ffn_conv_w[layer], ffn_conv_b[layer],
                                  ffn_down_w[layer])
    return rms_norm(x, final_norm_w)
```

```cpp
#include <hip/hip_runtime.h>
#include <cstdio>
#include <cstdint>
namespace pg8 {
#define PG8_LAS __attribute__((address_space(3)))
typedef unsigned short bf16_t;
typedef short bf16x8 __attribute__((ext_vector_type(8)));
typedef float f32x4 __attribute__((ext_vector_type(4)));
typedef unsigned u32x4 __attribute__((ext_vector_type(4)));
constexpr int BM = 256, BK = 64, HALF = 128, HTB = HALF * BK * 2  , STAGE_BYTES = 8 * HTB, NXCD = 8, WGM = 8;

__host__ __device__ __forceinline__ int lds_byte(int r, int c) { const int st = (r >> 4) * 2 + (c >> 5), rr = r & 15, cc = c & 31, ob = rr * 64 + cc * 2; return st * 1024 + (ob ^ (((ob >> 9) & 1) << 5)); }
__host__ __device__ __forceinline__ void stage_rc(int b, int& R, int& C) { const int st = b / 1024, sb = b % 1024, swz = sb ^ (((sb >> 9) & 1) << 5); R = (st >> 1) * 16 + swz / 64; C = (st & 1) * 32 + (swz % 64) / 2; }
__host__ __device__ __forceinline__ int perm32(int rho) { const int n = rho >> 4, i = rho & 15; return 8 * (i >> 2) + 4 * n + (i & 3); }

struct Unit { int pm, pn; };
struct Gemm { const bf16_t* A; const bf16_t* Bt; int M, N, K; int a_mul, a_add; };

struct StaticOrder {
    int nM, nN, nwg, G, c;
    __host__ __device__ void init(int M, int N, int G_, int c_) { nM = M / BM; nN = N / BM; nwg = nM * nN; G = G_; c = c_; }
    __host__ __device__ bool next(int i, Unit& u) const {
        const long L = (long)i * G + c; if (L >= nwg) return false;
        int wgid = (int)L; { const int q = nwg / NXCD, r = nwg % NXCD, xcd = wgid % NXCD, off = wgid / NXCD; wgid = (xcd < r ? xcd * (q + 1) : r * (q + 1) + (xcd - r) * q) + off; }
        const int nig = WGM * nN, gid = wgid / nig, fm = gid * WGM, gsz = (nM - fm) < WGM ? (nM - fm) : WGM;
        u.pm = fm + ((wgid % nig) % gsz); u.pn = (wgid % nig) / gsz; return true;
    }
    __device__ __forceinline__ void a_ready(const Unit&) const {}
    __device__ __forceinline__ void done(const Unit&) const {}
};

__device__ __forceinline__ unsigned cvt_pk_bf16(float lo, float hi) { unsigned r; asm volatile("v_cvt_pk_bf16_f32 %0, %1, %2" : "=v"(r) : "v"(lo), "v"(hi)); return r; }

struct EpiBf16B {
    static constexpr bool PERM = true, AFTER_DRAIN = false;
    bf16_t* O; int ldc; const float* bias;
    __device__ __forceinline__ void operator()(const f32x4 (&acc)[2][2][4][2], const Unit& u, int wr, int wc, int fr, int fq) const {
        const int row0 = u.pm * BM + wr * 64 + fr; const int col0 = u.pn * BM + wc * 32 + 8 * fq;
        f32x4 bv[2][2];
#pragma unroll
        for (int bj = 0; bj < 2; ++bj)
#pragma unroll
            for (int n = 0; n < 2; ++n) bv[bj][n] = bias ? *(const f32x4*)(bias + col0 + bj * HALF + 4 * n) : (f32x4){0.f, 0.f, 0.f, 0.f};
#pragma unroll
        for (int ai = 0; ai < 2; ++ai)
#pragma unroll
            for (int m = 0; m < 4; ++m) { bf16_t* rowp = O + (size_t)(row0 + ai * HALF + m * 16) * ldc + col0;
#pragma unroll
                for (int bj = 0; bj < 2; ++bj) { const f32x4 v0 = acc[ai][bj][m][0] + bv[bj][0], v1 = acc[ai][bj][m][1] + bv[bj][1];
                    u32x4 w; w.x = cvt_pk_bf16(v0[0], v0[1]); w.y = cvt_pk_bf16(v0[2], v0[3]); w.z = cvt_pk_bf16(v1[0], v1[1]); w.w = cvt_pk_bf16(v1[2], v1[3]);
                    *(u32x4*)(rowp + bj * HALF) = w; } }
    }
};
struct EpiResid {
    static constexpr bool PERM = false, AFTER_DRAIN = false;
    const float* res; float* out; int ldc; const float* gate; int gstride; int row_off;
    __device__ __forceinline__ void operator()(const f32x4 (&acc)[2][2][4][2], const Unit& u, int wr, int wc, int fr, int fq) const {
        const int rbase = row_off + u.pm * BM; const int b = rbase >> 11;
        const int row0 = rbase + wr * 64 + fr, col0 = u.pn * BM + wc * 32 + 4 * fq;
        const float* gp = gate + (size_t)b * gstride + col0;
        f32x4 gv[2][2];
#pragma unroll
        for (int bj = 0; bj < 2; ++bj)
#pragma unroll
            for (int n = 0; n < 2; ++n) gv[bj][n] = *(const f32x4*)(gp + bj * HALF + n * 16);
#pragma unroll
        for (int ai = 0; ai < 2; ++ai)
#pragma unroll
            for (int m = 0; m < 4; ++m) { const size_t off = (size_t)(row0 + ai * HALF + m * 16) * ldc + col0;
#pragma unroll
                for (int bj = 0; bj < 2; ++bj)
#pragma unroll
                    for (int n = 0; n < 2; ++n) { const f32x4 r = *(const f32x4*)(res + off + bj * HALF + n * 16);
                        *(f32x4*)(out + off + bj * HALF + n * 16) = r + gv[bj][n] * acc[ai][bj][m][n]; } }
    }
};

template <class Epi, class Sched, bool ALIGN_EPI = false, bool SP2 = false>
__device__ __forceinline__ void gemm_phase(PG8_LAS unsigned char* lds, const Gemm g, const Sched& S, const Epi& E) {
    int tid_l = threadIdx.x; asm volatile("" : "+v"(tid_l));
    const int tid = tid_l, wid = __builtin_amdgcn_readfirstlane(tid >> 6), lane = tid & 63, wr = wid >> 2, wc = wid & 3, fr = lane & 15, fq = lane >> 4;
    const int K = g.K, nt = K / BK;
    unsigned voffA[2], voffB[2];
#pragma unroll
    for (int i = 0; i < 2; ++i) { int R, C; stage_rc(tid * 16 + i * 8192, R, C); const int Rb = Epi::PERM ? ((R & ~31) + perm32(R & 31)) : R;
        voffA[i] = (unsigned)(R * K + C) * 2u; voffB[i] = (unsigned)(Rb * K + C) * 2u; }
    const size_t kstep = (size_t)(BK * 2);
    const size_t hstep = (size_t)HALF * K * 2;
    const size_t tstep = 2 * hstep;
    const unsigned ldsw = (unsigned)wid * 1024u;
    const int aoff = lds_byte(wr * 64 + fr, fq * 8), boff = lds_byte(wc * 32 + fr, fq * 8);
#define PG8_SA(b, h) (((b) * 2 + (h)) * HTB)
#define PG8_SB(b, h) ((4 + (b) * 2 + (h)) * HTB)
#define PG8_STAGE(bufoff, gbase, voff) do { _Pragma("unroll") for (int _i = 0; _i < 2; ++_i) \
        __builtin_amdgcn_global_load_lds((const unsigned*)((const char*)(gbase) + (voff)[_i]), (PG8_LAS unsigned*)(lds + (bufoff) + ldsw + _i * 8192), 16, 0, 0); } while (0)
#define PG8_LDA(dst, b, h) do { _Pragma("unroll") for (int m = 0; m < 4; ++m) _Pragma("unroll") for (int k = 0; k < 2; ++k) dst[m][k] = *(const PG8_LAS bf16x8*)(lds + PG8_SA(b, h) + aoff + m * 2048 + k * 1024); } while (0)
#define PG8_LDB(dst, b, h) do { _Pragma("unroll") for (int n = 0; n < 2; ++n) _Pragma("unroll") for (int k = 0; k < 2; ++k) dst[n][k] = *(const PG8_LAS bf16x8*)(lds + PG8_SB(b, h) + boff + n * 2048 + k * 1024); } while (0)
#define PG8_MMA(ai, bj, At, Bt) do { __builtin_amdgcn_s_setprio(1); _Pragma("unroll") for (int m = 0; m < 4; ++m) _Pragma("unroll") for (int n = 0; n < 2; ++n) _Pragma("unroll") for (int k = 0; k < 2; ++k) \
        acc[ai][bj][m][n] = __builtin_amdgcn_mfma_f32_16x16x32_bf16(Bt[n][k], At[m][k], acc[ai][bj][m][n], 0, 0, 0); __builtin_amdgcn_s_setprio(0); } while (0)
#define PG8_WAIT_V(n) asm volatile("s_waitcnt vmcnt(" #n ")" ::: "memory")
#define PG8_WAIT_L(n) asm volatile("s_waitcnt lgkmcnt(" #n ")" ::: "memory")
#define PG8_BAR __builtin_amdgcn_s_barrier()
#define PG8_SCHED __builtin_amdgcn_sched_barrier(0)
    Unit cur, nxt; int ui = 0;
    if (!S.next(0, cur)) return;
    f32x4 acc[2][2][4][2];
#pragma unroll
    for (int a = 0; a < 2; ++a)
#pragma unroll
        for (int b = 0; b < 2; ++b)
#pragma unroll
            for (int m = 0; m < 4; ++m)
#pragma unroll
                for (int n = 0; n < 2; ++n) acc[a][b][m][n] = (f32x4){0.f, 0.f, 0.f, 0.f};
    bf16x8 At[4][2], B0[2][2], B1[2][2];
    const char* cA = (const char*)g.A + (size_t)(cur.pm * g.a_mul + g.a_add) * tstep; const char* cB = (const char*)g.Bt + (size_t)cur.pn * tstep;
    S.a_ready(cur);
    if constexpr (SP2) {
        PG8_STAGE(PG8_SB(0, 0), cB, voffB); PG8_STAGE(PG8_SB(0, 1), cB + hstep, voffB); PG8_STAGE(PG8_SA(0, 0), cA, voffA); PG8_STAGE(PG8_SA(0, 1), cA + hstep, voffA);
        if (wr == 1) PG8_BAR;
        PG8_WAIT_V(2); PG8_BAR;
        PG8_STAGE(PG8_SB(1, 0), cB + kstep, voffB); PG8_STAGE(PG8_SA(1, 0), cA + kstep, voffA); PG8_STAGE(PG8_SB(1, 1), cB + hstep + kstep, voffB);
        PG8_WAIT_V(6); PG8_BAR;
    } else {
        PG8_STAGE(PG8_SB(0, 0), cB, voffB); PG8_STAGE(PG8_SA(0, 0), cA, voffA); PG8_STAGE(PG8_SB(0, 1), cB + hstep, voffB); PG8_STAGE(PG8_SA(0, 1), cA + hstep, voffA);
        if (wr == 1) PG8_BAR;
        PG8_WAIT_V(4); PG8_BAR;
        PG8_STAGE(PG8_SB(1, 0), cB + kstep, voffB); PG8_STAGE(PG8_SA(1, 0), cA + kstep, voffA); PG8_STAGE(PG8_SB(1, 1), cB + hstep + kstep, voffB);
        PG8_WAIT_V(6); PG8_BAR;
    }
    for (;;) {
        const bool has_next = S.next(ui + 1, nxt);
        const char* nA = has_next ? (const char*)g.A + (size_t)(nxt.pm * g.a_mul + g.a_add) * tstep : cA; const char* nB = has_next ? (const char*)g.Bt + (size_t)nxt.pn * tstep : cB;
        for (int t = 0; t < nt; t += 2) {
            const bool last = (t == nt - 2);
            const char* a1 = cA + (size_t)(t + 1) * kstep;
            const char* a2 = last ? nA : cA + (size_t)(t + 2) * kstep; const char* b2 = last ? nB : cB + (size_t)(t + 2) * kstep;
            const char* a3 = a2 + kstep; const char* b3 = b2 + kstep;
            if (last && has_next) S.a_ready(nxt);
            if constexpr (SP2) {
            PG8_LDB(B0, 0, 0); PG8_LDB(B1, 0, 1); PG8_SCHED; PG8_LDA(At, 0, 0); PG8_STAGE(PG8_SA(1, 1), a1 + hstep, voffA);
            PG8_WAIT_V(8); PG8_WAIT_L(0); PG8_BAR; PG8_MMA(0, 0, At, B0); PG8_MMA(0, 1, At, B1); PG8_BAR; PG8_SCHED;
            PG8_LDA(At, 0, 1); PG8_STAGE(PG8_SB(0, 0), b2, voffB); PG8_STAGE(PG8_SB(0, 1), b2 + hstep, voffB); PG8_STAGE(PG8_SA(0, 0), a2, voffA);
            PG8_WAIT_V(8); PG8_WAIT_L(0); PG8_BAR; PG8_MMA(1, 0, At, B0); PG8_MMA(1, 1, At, B1); PG8_BAR; PG8_SCHED;
            PG8_LDB(B0, 1, 0); PG8_LDB(B1, 1, 1); PG8_SCHED; PG8_LDA(At, 1, 0); PG8_STAGE(PG8_SA(0, 1), a2 + hstep, voffA);
            PG8_WAIT_V(8); PG8_WAIT_L(0); PG8_BAR; PG8_MMA(0, 0, At, B0); PG8_MMA(0, 1, At, B1); PG8_BAR; PG8_SCHED;
            PG8_LDA(At, 1, 1); PG8_STAGE(PG8_SB(1, 0), b3, voffB); PG8_STAGE(PG8_SB(1, 1), b3 + hstep, voffB); PG8_STAGE(PG8_SA(1, 0), a3, voffA);
            PG8_WAIT_V(8); PG8_WAIT_L(0); PG8_BAR; PG8_MMA(1, 0, At, B0); PG8_MMA(1, 1, At, B1); PG8_BAR; PG8_SCHED;
            } else {
            PG8_LDB(B0, 0, 0); PG8_SCHED; PG8_LDA(At, 0, 0); PG8_STAGE(PG8_SA(1, 1), a1 + hstep, voffA);
            PG8_WAIT_L(8); PG8_BAR; PG8_WAIT_L(0); PG8_MMA(0, 0, At, B0); PG8_BAR; PG8_SCHED;
            PG8_LDB(B1, 0, 1); PG8_STAGE(PG8_SB(0, 0), b2, voffB);
            PG8_BAR; PG8_WAIT_L(0); PG8_MMA(0, 1, At, B1); PG8_BAR;
            PG8_LDA(At, 0, 1); PG8_STAGE(PG8_SA(0, 0), a2, voffA);
            PG8_BAR; PG8_WAIT_L(0); PG8_MMA(1, 0, At, B0); PG8_BAR; PG8_SCHED;
            PG8_STAGE(PG8_SB(0, 1), b2 + hstep, voffB);
            PG8_WAIT_V(6); PG8_BAR; PG8_MMA(1, 1, At, B1); PG8_BAR;
            PG8_LDB(B0, 1, 0); PG8_SCHED; PG8_LDA(At, 1, 0); PG8_STAGE(PG8_SA(0, 1), a2 + hstep, voffA);
            PG8_WAIT_L(8); PG8_BAR; PG8_WAIT_L(0); PG8_MMA(0, 0, At, B0); PG8_BAR; PG8_SCHED;
            PG8_LDB(B1, 1, 1); PG8_STAGE(PG8_SB(1, 0), b3, voffB);
            PG8_BAR; PG8_WAIT_L(0); PG8_MMA(0, 1, At, B1); PG8_BAR;
            PG8_LDA(At, 1, 1); PG8_STAGE(PG8_SA(1, 0), a3, voffA);
            PG8_BAR; PG8_WAIT_L(0); PG8_MMA(1, 0, At, B0); PG8_BAR; PG8_SCHED;
            PG8_STAGE(PG8_SB(1, 1), b3 + hstep, voffB);
            PG8_WAIT_V(6); PG8_BAR; PG8_MMA(1, 1, At, B1); PG8_BAR;
            }
        }
        if constexpr (ALIGN_EPI) { if (wr == 0) PG8_BAR; }
        if constexpr (!Epi::AFTER_DRAIN) { E(acc, cur, wr, wc, fr, fq); S.done(cur); }
        if (!has_next) break;
#pragma unroll
        for (int a = 0; a < 2; ++a)
#pragma unroll
            for (int b = 0; b < 2; ++b)
#pragma unroll
                for (int m = 0; m < 4; ++m)
#pragma unroll
                    for (int n = 0; n < 2; ++n) acc[a][b][m][n] = (f32x4){0.f, 0.f, 0.f, 0.f};
        cur = nxt; cA = nA; cB = nB; ++ui;
        if constexpr (ALIGN_EPI) { if (wr == 1) PG8_BAR; }
    }
    PG8_WAIT_V(0);
    if constexpr (!ALIGN_EPI) { if (wr == 0) PG8_BAR; }
    PG8_BAR;
    if constexpr (Epi::AFTER_DRAIN) { E.fused(acc, cur, wr, wc, fr, fq, lds, wid, lane); S.done(cur); }
#undef PG8_SA
#undef PG8_SB
#undef PG8_STAGE
#undef PG8_LDA
#undef PG8_LDB
#undef PG8_MMA
#undef PG8_WAIT_V
#undef PG8_WAIT_L
#undef PG8_BAR
#undef PG8_SCHED
}
}

#ifndef PG8_SP2
#define PG8_SP2 true
#endif
#ifndef PG8_ALIGN
#define PG8_ALIGN true
#endif

constexpr int NWAVES = 8;
constexpr int D = 1024, BATCH = 32, SEQ = 2048, M = BATCH * SEQ, DEPTH = 2, NH = 8, HD = 128, DFF = 2816;
constexpr int PROJW = 10256;
constexpr int PW = 10240, HB = 1280;
constexpr int NSEG = 8, SEGT = SEQ / NSEG, SEGROWS = BATCH * SEGT;
constexpr int FSEG = 2, FROWS = M / FSEG;
constexpr float RMS_EPS = 1e-6f;
constexpr int MODW = 6 * D;

constexpr size_t MiB = 1u << 20;
constexpr size_t WS_CTL = 0, CTL_ZERO_BYTES = 1 * MiB;
constexpr size_t WS_WIN = 2 * MiB;
constexpr size_t WS_WOUT = 42 * MiB;
constexpr size_t WS_WUP = 46 * MiB;
constexpr size_t WS_WDN = 68 * MiB;
constexpr size_t WS_WG = 79 * MiB;
constexpr size_t WS_BIASP = 79 * MiB + 256 * 1024;
constexpr size_t WS_BG = 79 * MiB + 512 * 1024;
constexpr size_t WS_LB = 79 * MiB + 768 * 1024;
constexpr size_t WS_MOD = 80 * MiB;
constexpr size_t WS_GATES = 84 * MiB;
constexpr size_t WS_STC = 88 * MiB;
constexpr size_t WS_STS = 104 * MiB;
constexpr size_t WS_STN = 120 * MiB;
constexpr size_t WS_STM = 121 * MiB;
constexpr size_t WS_HN = 122 * MiB;
constexpr size_t WS_Y = 250 * MiB;
constexpr size_t WS_P = 378 * MiB;
constexpr size_t P_BYTES = (size_t)SEGROWS * PW * 2;
constexpr size_t WS_U = 250 * MiB;
constexpr size_t WS_G = 602 * MiB;
constexpr size_t WS_END = 778 * MiB;
static_assert(WS_P + 2 * P_BYTES <= 698 * MiB && WS_U + (size_t)FROWS * 2 * DFF * 2 <= WS_G && WS_G + (size_t)FROWS * DFF * 2 <= WS_END, "ws map");
constexpr int CW_TMO = 0, CW_CODE = 1, CW_BAR = 4096;

constexpr int LDS_BYTES = 160 * 1024;
constexpr int RING_OFF = 0;
constexpr int MISC_OFF = 156 * 1024;

#define GAS __attribute__((address_space(1)))
#define LAS __attribute__((address_space(3)))
typedef unsigned short bf16;
typedef unsigned v4u __attribute__((ext_vector_type(4)));
typedef unsigned v2u __attribute__((ext_vector_type(2)));
typedef float f32x4 __attribute__((ext_vector_type(4)));
typedef short bf16x8 __attribute__((ext_vector_type(8)));
typedef GAS unsigned gu32;
#define RLX_AGENT __ATOMIC_RELAXED, __HIP_MEMORY_SCOPE_AGENT
#define LDS_WAIT() asm volatile("s_waitcnt lgkmcnt(0)" ::: "memory")
#define VM_WAIT() asm volatile("s_waitcnt vmcnt(0)" ::: "memory")
__device__ __forceinline__ unsigned f2bf(float f) { unsigned u = __builtin_bit_cast(unsigned, f); return (u + 0x7fffu + ((u >> 16) & 1u)) >> 16; }
__device__ __forceinline__ unsigned pk2(float lo, float hi) { return f2bf(lo) | (f2bf(hi) << 16); }
__device__ __forceinline__ float bf2f(unsigned short b) { return __builtin_bit_cast(float, ((unsigned)b) << 16); }
__device__ __forceinline__ float sigm(float x) { return 1.f / (1.f + __expf(-x)); }
__device__ __forceinline__ float siluf(float x) { return x / (1.f + __expf(-x)); }
__device__ __forceinline__ float softcap15(float z) { return 15.f * tanhf(z * (1.f / 15.f)); }
__device__ __forceinline__ float logsigm(float z) { return fminf(z, 0.f) - log1pf(expf(-fabsf(z))); }
__device__ __forceinline__ float wave_sum(float v) {
#pragma unroll
    for (int o = 1; o < 64; o <<= 1) v += __shfl_xor(v, o);
    return v;
}

#define PHASE_TID() int tid = threadIdx.x; asm volatile("" : "+v"(tid)); const int lane = tid & 63, wave = __builtin_amdgcn_readfirstlane(tid >> 6); (void)lane; (void)wave
#define XB_TMO      128
#define XB_XCNT(j)  (256  + 64 * (j))
#define XB_XSUB(j)  (1280 + 64 * (j))
#define XB_XGEN(j)  (2304 + 64 * (j))
#define XB_TOP      3328
#define XB_TOPGEN   3392
#define XCD_BAR_WORDS 3456
#define XB_SPIN_CAP (1u << 18)

__device__ __forceinline__ unsigned xb_ld(unsigned* p)              { return __hip_atomic_load(p, __ATOMIC_RELAXED, __HIP_MEMORY_SCOPE_AGENT); }
__device__ __forceinline__ unsigned xb_add(unsigned* p, unsigned v) { return __hip_atomic_fetch_add(p, v, __ATOMIC_RELAXED, __HIP_MEMORY_SCOPE_AGENT); }
__device__ __forceinline__ unsigned xb_xcc_id() { return (unsigned)__builtin_amdgcn_s_getreg((3 << 11) | 20) & 0xFu; }
#define XB_SPIN(cond, bar) do { unsigned _sp = 0; while (cond) { __builtin_amdgcn_s_sleep(1); \
    if ((++_sp & 255u) == 0u) { if (xb_ld(&(bar)[XB_TMO])) break; if (_sp > XB_SPIN_CAP) { atomicAdd(&(bar)[XB_TMO], 1u); break; } } } } while (0)

struct XcdBarrier {
    unsigned* bar; unsigned x;
    volatile LAS unsigned* st;
};

__device__ __forceinline__ XcdBarrier xcd_barrier_post(unsigned* bar, volatile LAS unsigned* st) {
    XcdBarrier b; b.bar = bar; b.x = xb_xcc_id(); b.st = st;
    if (threadIdx.x == 0) (void)xb_add(&bar[XB_XCNT(b.x)], 1u);
    return b;
}
__device__ __forceinline__ void xcd_barrier_complete(unsigned* bar, unsigned x, unsigned& nloc, unsigned& nx) {
    const unsigned G = gridDim.x * gridDim.y * gridDim.z;
    unsigned sum, cnt, mine, sp = 0u;
    for (;;) {
        sum = 0u; cnt = 0u; mine = 0u;
#pragma unroll
        for (unsigned j = 0; j < 16; ++j) { const unsigned c = xb_ld(&bar[XB_XCNT(j)]); sum += c; cnt += (c > 0u) ? 1u : 0u; mine = (j == x) ? c : mine; }
        if (sum == G) break;
        __builtin_amdgcn_s_sleep(1);
        if ((++sp & 255u) == 0u) { if (xb_ld(&bar[XB_TMO])) break; if (sp > XB_SPIN_CAP) { atomicAdd(&bar[XB_TMO], 1u); break; } }
    }
    nloc = mine > 0u ? mine : 1u; nx = cnt > 0u ? cnt : 1u;
}

__device__ __forceinline__ void xcd_barrier(const XcdBarrier& b) {
    asm volatile("s_waitcnt vmcnt(0)" ::: "memory");
    __syncthreads();
    if (threadIdx.x == 0) {
        unsigned* bar = b.bar;
        __builtin_amdgcn_s_waitcnt(0);
        unsigned nloc = b.st[0], nx = b.st[1];
        if (nloc == 0u) { xcd_barrier_complete(bar, b.x, nloc, nx); b.st[0] = nloc; b.st[1] = nx; }
        const unsigned old = xb_add(&bar[XB_XSUB(b.x)], 1u);
        const unsigned gen = old / nloc;
        if (old + 1u == (gen + 1u) * nloc) {
            __builtin_amdgcn_fence(__ATOMIC_RELEASE, "agent");
            asm volatile("s_waitcnt vmcnt(0)" ::: "memory");
            const unsigned og = xb_add(&bar[XB_TOP], 1u);
            const unsigned tg = og / nx;
            if (og + 1u == (tg + 1u) * nx) xb_add(&bar[XB_TOPGEN], 1u);
            else XB_SPIN(xb_ld(&bar[XB_TOPGEN]) == tg, bar);
            __builtin_amdgcn_fence(__ATOMIC_ACQUIRE, "agent");
            xb_add(&bar[XB_XGEN(b.x)], 1u);
            asm volatile("s_waitcnt vmcnt(0)" ::: "memory");
        } else {
            XB_SPIN(xb_ld(&bar[XB_XGEN(b.x)]) == gen, bar);
            __builtin_amdgcn_fence(__ATOMIC_ACQUIRE, "agent");
            asm volatile("s_waitcnt vmcnt(0)" ::: "memory");
        }
    }
    __syncthreads();
}

struct Ctx {
    LAS unsigned char* lds;
    int vcu, G;
};
struct Args { const float* in[19]; float* out; unsigned char* ws; };
typedef const Args __attribute__((address_space(4))) CArgs;
__device__ __forceinline__ CArgs& getargs() { CArgs* p = (CArgs*)__builtin_amdgcn_kernarg_segment_ptr(); asm volatile("" : "+s"(p)); return *p; }
#define ARGS() CArgs& A = getargs()

__device__ __forceinline__ void p0_transpose_item(const float* W, int ldw, int srccol0, int k0, bf16* WT, int K, int dstrow0, LAS float* scr, int lane) {
#pragma unroll 8
    for (int i = 0; i < 32; ++i) { const int kk = 2 * i + (lane >> 5); scr[kk * 33 + (lane & 31)] = W[(size_t)(k0 + kk) * ldw + srccol0 + (lane & 31)]; }
    LDS_WAIT(); asm volatile("" ::: "memory");
    const int c = lane & 7;
#pragma unroll
    for (int j = 0; j < 4; ++j) { const int n = (lane >> 3) + 8 * j; const LAS float* s = scr + (8 * c) * 33 + n;
        v4u o; o.x = pk2(s[0 * 33], s[1 * 33]); o.y = pk2(s[2 * 33], s[3 * 33]); o.z = pk2(s[4 * 33], s[5 * 33]); o.w = pk2(s[6 * 33], s[7 * 33]);
        *(GAS v4u*)(WT + (size_t)(dstrow0 + n) * K + k0 + 8 * c) = o; }
    LDS_WAIT(); asm volatile("" ::: "memory");
}
__device__ __forceinline__ int in_src_col(int dstcol) {
    const int h = dstcol / HB, rem = dstcol - h * HB, blk = rem >> 7, j = rem & 127;
    const int base = blk < 4 ? blk * 1024 : 4112 + (blk - 4) * 1024;
    return base + h * 128 + j;
}
__device__ __forceinline__ void p0_prologue(Ctx& F) {
    PHASE_TID();
    ARGS();
    LAS float* scr = (LAS float*)(F.lds + wave * 16384);
    const int gw = F.vcu * NWAVES + wave, NGW = F.G * NWAVES;
    constexpr int I_IN = 320 * 16, I_OUT = 32 * 16, I_UP = 176 * 16, I_DN = 32 * 44, I_L = I_IN + I_OUT + I_UP + I_DN;
    for (int it = gw; it < 2 * I_L; it += NGW) {
        const int l = it / I_L; int r = it - l * I_L;
        if (r < I_IN) { const int rg = r >> 4, kb = r & 15; p0_transpose_item(A.in[5] + (size_t)l * D * PROJW, PROJW, in_src_col(32 * rg), 64 * kb, (bf16*)(A.ws + WS_WIN) + (size_t)l * PW * D, D, 32 * rg, scr, lane); continue; } r -= I_IN;
        if (r < I_OUT) { const int rg = r >> 4, kb = r & 15; p0_transpose_item(A.in[12] + (size_t)l * D * D, D, 32 * rg, 64 * kb, (bf16*)(A.ws + WS_WOUT) + (size_t)l * D * D, D, 32 * rg, scr, lane); continue; } r -= I_OUT;
        if (r < I_UP) { const int rg = r >> 4, kb = r & 15; const int row0 = 32 * rg, pn = row0 >> 8, half = (row0 >> 7) & 1, j0 = row0 & 127;
            p0_transpose_item(A.in[14] + (size_t)l * D * 2 * DFF, 2 * DFF, half * DFF + pn * 128 + j0, 64 * kb, (bf16*)(A.ws + WS_WUP) + (size_t)l * 2 * DFF * D, D, row0, scr, lane); continue; } r -= I_UP;
        { const int rg = r / 44, kb = r - rg * 44; p0_transpose_item(A.in[17] + (size_t)l * DFF * D, D, 32 * rg, 64 * kb, (bf16*)(A.ws + WS_WDN) + (size_t)l * D * DFF, DFF, 32 * rg, scr, lane); }
    }
    const int gt = F.vcu * (NWAVES * 64) + tid, NGT = F.G * NWAVES * 64;
    float* wg = (float*)(A.ws + WS_WG); float* biasp = (float*)(A.ws + WS_BIASP); float* bg = (float*)(A.ws + WS_BG); float* lb = (float*)(A.ws + WS_LB);
    for (int i = gt; i < 2 * D * 16; i += NGT) { const int g = i & 15, k = (i >> 4) & (D - 1), l = i >> 14; wg[(size_t)(l * 16 + g) * D + k] = A.in[5][((size_t)l * D + k) * PROJW + 4096 + g]; }
    for (int i = gt; i < 2 * PW; i += NGT) { const int l = i / PW, c = i - l * PW; biasp[i] = A.in[6][(size_t)l * PROJW + in_src_col(c)]; }
    for (int i = gt; i < 32; i += NGT) { const int l = i >> 4, g = i & 15; bg[i] = A.in[6][(size_t)l * PROJW + 4096 + g]; }
    for (int i = gt; i < D; i += NGT) { const float z0 = A.in[10][i], z1 = A.in[10][D + i]; lb[i] = 1.f / (1.f + expf(z0 - z1)); }
    __syncthreads();
    for (int wgi = F.vcu; wgi < 2 * (MODW / 64); wgi += F.G) {
        LAS float* cact = (LAS float*)F.lds;
        for (int i = tid; i < BATCH * D; i += NWAVES * 64) cact[i] = siluf(A.in[1][i]);
        __syncthreads();
        const int l = wgi / (MODW / 64), cg = wgi - l * (MODW / 64), col = cg * 64 + lane, kb = wave * 128;
        const float* aw = A.in[2] + (size_t)l * D * MODW + col;
        float acc[32];
#pragma unroll
        for (int b = 0; b < 32; ++b) acc[b] = 0.f;
        for (int k4 = 0; k4 < 32; ++k4) {
            const int k = kb + 4 * k4;
            const float w0 = aw[(size_t)k * MODW], w1 = aw[(size_t)(k + 1) * MODW], w2 = aw[(size_t)(k + 2) * MODW], w3 = aw[(size_t)(k + 3) * MODW];
#pragma unroll
            for (int b = 0; b < 32; ++b) { const f32x4 cv = *(const LAS f32x4*)(cact + b * D + k); acc[b] += cv.x * w0 + cv.y * w1 + cv.z * w2 + cv.w * w3; }
        }
        __syncthreads();
        LAS float* part = (LAS float*)F.lds;
#pragma unroll
        for (int b = 0; b < 32; ++b) part[(wave * 32 + b) * 64 + lane] = acc[b];
        __syncthreads();
        float* mod = (float*)(A.ws + WS_MOD);
        for (int o = tid; o < 32 * 64; o += NWAVES * 64) { const int b = o >> 6, c = o & 63; float s = 0.f;
#pragma unroll
            for (int w = 0; w < 8; ++w) s += part[(w * 32 + b) * 64 + c];
            mod[((size_t)l * BATCH + b) * MODW + cg * 64 + c] = s + A.in[3][(size_t)l * MODW + cg * 64 + c]; }
        __syncthreads();
    }
}

__device__ __forceinline__ float reduce16(float (&v)[16], int lane) {
#define R16_STEP(S, MSK) { const bool up = (lane & (MSK)) != 0; _Pragma("unroll") for (int i = 0; i < (S); ++i) { const float keep = up ? v[i + (S)] : v[i], send = up ? v[i] : v[i + (S)]; v[i] = keep + __shfl_xor(send, (MSK)); } }
    R16_STEP(8, 32) R16_STEP(4, 16) R16_STEP(2, 8) R16_STEP(1, 4)
#undef R16_STEP
    float r = v[0]; r += __shfl_xor(r, 1); r += __shfl_xor(r, 2); return r;
}
template <bool GATES>
__device__ __forceinline__ void norm_phase(Ctx& F, const float* src, const float* nw, const float* modl, int shift_off, int scale_off, bf16* hn, float* gates, const float* wgl, const float* bgl) {
    PHASE_TID();
    LAS float* wgs = (LAS float*)F.lds;
    if (GATES) { for (int i = tid; i < 16 * D / 4; i += NWAVES * 64) ((LAS f32x4*)wgs)[i] = ((const f32x4*)wgl)[i]; __syncthreads(); }
    const int gw = F.vcu * NWAVES + wave, NGW = F.G * NWAVES;
    f32x4 w[4];
#pragma unroll
    for (int j = 0; j < 4; ++j) w[j] = *(const f32x4*)(nw + 256 * j + 4 * lane);
    for (int item = gw; item < M / 32; item += NGW) {
        const int row0 = item * 32, b = row0 >> 11;
        f32x4 sc[4], sh[4];
#pragma unroll
        for (int j = 0; j < 4; ++j) { sc[j] = *(const f32x4*)(modl + (size_t)b * MODW + scale_off + 256 * j + 4 * lane); sh[j] = *(const f32x4*)(modl + (size_t)b * MODW + shift_off + 256 * j + 4 * lane);
            sc[j] = (sc[j] + 1.0f) * w[j]; }
        f32x4 xn[4];
#pragma unroll
        for (int j = 0; j < 4; ++j) xn[j] = *(const GAS f32x4*)(src + (size_t)row0 * D + 256 * j + 4 * lane);
        for (int r = 0; r < 32; ++r) {
            asm volatile("" ::: "memory");
            f32x4 x[4];
#pragma unroll
            for (int j = 0; j < 4; ++j) x[j] = xn[j];
            if (r + 1 < 32) {
#pragma unroll
                for (int j = 0; j < 4; ++j) xn[j] = *(const GAS f32x4*)(src + (size_t)(row0 + r + 1) * D + 256 * j + 4 * lane);
            }
            float ss = 0.f;
#pragma unroll
            for (int j = 0; j < 4; ++j) ss += (x[j].x * x[j].x + x[j].y * x[j].y) + (x[j].z * x[j].z + x[j].w * x[j].w);
            const float rstd = rsqrtf(wave_sum(ss) * (1.f / D) + RMS_EPS);
#pragma unroll
            for (int j = 0; j < 4; ++j) x[j] = x[j] * rstd * sc[j] + sh[j];
            GAS unsigned long long* o8 = (GAS unsigned long long*)(hn + (size_t)(row0 + r) * D) + lane;
#pragma unroll
            for (int j = 0; j < 4; ++j) o8[64 * j] = (unsigned long long)pk2(x[j].x, x[j].y) | ((unsigned long long)pk2(x[j].z, x[j].w) << 32);
            if (GATES) {
                float a[16];
#pragma unroll
                for (int g = 0; g < 16; ++g) { float s = 0.f;
#pragma unroll
                    for (int j = 0; j < 4; ++j) { const f32x4 wv = *(const LAS f32x4*)(wgs + g * D + 256 * j + 4 * lane); s += (x[j].x * wv.x + x[j].y * wv.y) + (x[j].z * wv.z + x[j].w * wv.w); }
                    a[g] = s; }
                const float tot = reduce16(a, lane);
                const int g = ((lane >> 5) & 1) * 8 + ((lane >> 4) & 1) * 4 + ((lane >> 3) & 1) * 2 + ((lane >> 2) & 1);
                if ((lane & 3) == 0) gates[(size_t)(row0 + r) * 16 + g] = tot + bgl[g];
            }
        }
    }
}
__device__ __forceinline__ void final_norm_phase(Ctx& F, float* x, const float* nw) {
    PHASE_TID();
    const int gw = F.vcu * NWAVES + wave, NGW = F.G * NWAVES;
    f32x4 w[4];
#pragma unroll
    for (int j = 0; j < 4; ++j) w[j] = *(const f32x4*)(nw + 256 * j + 4 * lane);
    for (int row = gw; row < M; row += NGW) {
        GAS f32x4* xr = (GAS f32x4*)(x + (size_t)row * D) + lane;
        f32x4 v[4]; float ss = 0.f;
#pragma unroll
        for (int j = 0; j < 4; ++j) { v[j] = xr[64 * j]; ss += (v[j].x * v[j].x + v[j].y * v[j].y) + (v[j].z * v[j].z + v[j].w * v[j].w); }
        const float rstd = rsqrtf(wave_sum(ss) * (1.f / D) + RMS_EPS);
#pragma unroll
        for (int j = 0; j < 4; ++j) xr[64 * j] = v[j] * rstd * w[j];
    }
}

__device__ __forceinline__ void ffn_glu_phase(Ctx& F, const bf16* u, bf16* g, const float* cw, const float* cb) {
    PHASE_TID();
    constexpr int RB = 16, NCH = DFF / 8, NRB = FROWS / RB;
    const int gt = F.vcu * (NWAVES * 64) + tid, NGT = F.G * NWAVES * 64;
    for (int it = gt; it < NRB * NCH; it += NGT) {
        const int rb = it / NCH, ch = it - rb * NCH, f0 = ch * 8, row0 = rb * RB;
        const int cg0 = (f0 >> 7) * 256 + (f0 & 127);
        float wg_[3][8], wv_[3][8], bgv[8], bvv[8];
#pragma unroll
        for (int j = 0; j < 3; ++j)
#pragma unroll
            for (int e = 0; e < 8; ++e) { wg_[j][e] = cw[(size_t)j * 2 * DFF + f0 + e]; wv_[j][e] = cw[(size_t)j * 2 * DFF + DFF + f0 + e]; }
#pragma unroll
        for (int e = 0; e < 8; ++e) { bgv[e] = cb[f0 + e]; bvv[e] = cb[DFF + f0 + e]; }
        float g1[8], g2[8], v1[8], v2[8];
        const int t0 = row0 & (SEQ - 1);
#pragma unroll
        for (int e = 0; e < 8; ++e) { g1[e] = g2[e] = v1[e] = v2[e] = 0.f; }
        if (t0 >= 2) {
            const v4u a1 = *(const GAS v4u*)(u + (size_t)(row0 - 1) * 2 * DFF + cg0), a2 = *(const GAS v4u*)(u + (size_t)(row0 - 2) * 2 * DFF + cg0);
            const v4u b1 = *(const GAS v4u*)(u + (size_t)(row0 - 1) * 2 * DFF + cg0 + 128), b2 = *(const GAS v4u*)(u + (size_t)(row0 - 2) * 2 * DFF + cg0 + 128);
#pragma unroll
            for (int e = 0; e < 4; ++e) { g1[2 * e] = bf2f(a1[e] & 0xffff); g1[2 * e + 1] = bf2f(a1[e] >> 16); g2[2 * e] = bf2f(a2[e] & 0xffff); g2[2 * e + 1] = bf2f(a2[e] >> 16);
                v1[2 * e] = bf2f(b1[e] & 0xffff); v1[2 * e + 1] = bf2f(b1[e] >> 16); v2[2 * e] = bf2f(b2[e] & 0xffff); v2[2 * e + 1] = bf2f(b2[e] >> 16); }
        }
        for (int r = 0; r < RB; ++r) {
            const v4u a0 = *(const GAS v4u*)(u + (size_t)(row0 + r) * 2 * DFF + cg0), b0 = *(const GAS v4u*)(u + (size_t)(row0 + r) * 2 * DFF + cg0 + 128);
            float g0[8], v0[8], o[8];
#pragma unroll
            for (int e = 0; e < 4; ++e) { g0[2 * e] = bf2f(a0[e] & 0xffff); g0[2 * e + 1] = bf2f(a0[e] >> 16); v0[2 * e] = bf2f(b0[e] & 0xffff); v0[2 * e + 1] = bf2f(b0[e] >> 16); }
#pragma unroll
            for (int e = 0; e < 8; ++e) { const float cgv = bgv[e] + wg_[2][e] * g0[e] + wg_[1][e] * g1[e] + wg_[0][e] * g2[e]; const float cvv = bvv[e] + wv_[2][e] * v0[e] + wv_[1][e] * v1[e] + wv_[0][e] * v2[e];
                o[e] = siluf(cgv) * cvv; g2[e] = g1[e]; g1[e] = g0[e]; v2[e] = v1[e]; v1[e] = v0[e]; }
            v4u w; w.x = pk2(o[0], o[1]); w.y = pk2(o[2], o[3]); w.z = pk2(o[4], o[5]); w.w = pk2(o[6], o[7]);
            *(GAS v4u*)(g + (size_t)(row0 + r) * DFF + f0) = w;
        }
    }
}

__device__ __forceinline__ void mixer_naive_phase(Ctx& F, int layer, int seg) {
    PHASE_TID();
    ARGS();
    const bf16* Pcur = (const bf16*)(A.ws + WS_P + (size_t)(seg & 1) * P_BYTES);
    const bf16* Pprev = (const bf16*)(A.ws + WS_P + (size_t)((seg & 1) ^ 1) * P_BYTES);
    const float* gates = (const float*)(A.ws + WS_GATES);
    const float* lbp = (const float*)(A.ws + WS_LB);
    bf16* Y = (bf16*)(A.ws + WS_Y);
    float* stC = (float*)(A.ws + WS_STC); float* stS = (float*)(A.ws + WS_STS); float* stN = (float*)(A.ws + WS_STN); float* stM = (float*)(A.ws + WS_STM);
    const float* cw = A.in[7] + (size_t)layer * 4 * 2048; const float* cb = A.in[8] + (size_t)layer * 2048;
    const float* mnw = A.in[9] + (size_t)layer * D; const float* hnw = A.in[11] + (size_t)layer * D;
    LAS float* L = (LAS float*)F.lds;
    LAS float* qm = L, *km = L + 2048, *vm = L + 4096, *hq = L + 6144, *hk = L + 8192, *hf = L + 10240, *hv = L + 12288;
    LAS float* sli = L + 14336, *slf = L + 14352, *flo = L + 14368, *pn = L + 14400;
    LAS float* ph = L + 16384, *po = L + 16384 + 8192;
    const int dv = tid & 127, g4 = tid >> 7;
    for (int bh = blockIdx.x; bh < BATCH * NH; bh += F.G) {
        const int b = bh >> 3, h = bh & 7;
        float Cm[32], Sh[32], nm[32]; float mst;
        if (seg == 0) {
#pragma unroll
            for (int i = 0; i < 32; ++i) { Cm[i] = 0.f; Sh[i] = 0.f; nm[i] = 0.f; }
            mst = 0.f;
        } else {
#pragma unroll
            for (int i = 0; i < 32; ++i) { Cm[i] = stC[((size_t)(bh * 4 + g4) * 32 + i) * 128 + dv]; Sh[i] = stS[((size_t)(bh * 4 + g4) * 32 + i) * 128 + dv]; nm[i] = stN[bh * 128 + 32 * g4 + i]; }
            mst = stM[bh];
        }
        for (int mb = 0; mb < SEGT / 16; ++mb) {
            const int tl0 = 16 * mb;
            for (int e = tid; e < 16 * 128; e += NWAVES * 64) {
                const int tt = e >> 7, col = e & 127, tl = tl0 + tt, ts = seg * SEGT + tl;
                const int ccq = h * 128 + col, cck = 1024 + h * 128 + col;
                float aq = cb[ccq], ak = cb[cck];
#pragma unroll
                for (int j = 0; j < 4; ++j) {
                    const int tq = tl - 3 + j;
                    if (ts - 3 + j >= 0) {
                        const bf16* pr = tq >= 0 ? Pcur + (size_t)(b * SEGT + tq) * PW : Pprev + (size_t)(b * SEGT + SEGT + tq) * PW;
                        aq += cw[(size_t)j * 2048 + ccq] * bf2f(pr[h * HB + col]); ak += cw[(size_t)j * 2048 + cck] * bf2f(pr[h * HB + 128 + col]);
                    }
                }
                qm[e] = siluf(aq); km[e] = siluf(ak) * 0.08838834764831845f;
                const bf16* pr = Pcur + (size_t)(b * SEGT + tl) * PW + h * HB;
                vm[e] = bf2f(pr[256 + col]);
                hq[e] = siluf(bf2f(pr[512 + col]));
                const float lb = layer == 0 ? 0.f : lbp[h * 128 + col];
                const float sg = sigm(bf2f(pr[640 + col]));
                hf[e] = lb + (1.f - lb) * sg; hk[e] = (1.f - lb) * (1.f - sg);
                hv[e] = bf2f(pr[768 + col]);
            }
            if (tid < 16) { const size_t grow = (size_t)b * SEQ + seg * SEGT + tl0 + tid;
                sli[tid] = softcap15(gates[grow * 16 + h]); slf[tid] = logsigm(softcap15(gates[grow * 16 + 8 + h])); }
            __syncthreads();
            for (int tt = 0; tt < 16; ++tt) {
                const float li = sli[tt], lf = slf[tt];
                const float mnew = fmaxf(lf + mst, li), ipv = expf(li - mnew), fpv = expf(lf + mst - mnew); mst = mnew;
                if (tid == 0) flo[tt] = expf(-mnew);
                const float v = vm[tt * 128 + dv], iv = ipv * v;
                float hp = 0.f, nq = 0.f;
#pragma unroll
                for (int i4 = 0; i4 < 8; ++i4) { const f32x4 kk = *(const LAS f32x4*)(km + tt * 128 + 32 * g4 + 4 * i4), qq = *(const LAS f32x4*)(qm + tt * 128 + 32 * g4 + 4 * i4);
#pragma unroll
                    for (int j = 0; j < 4; ++j) { const int i = 4 * i4 + j; Cm[i] = fpv * Cm[i] + iv * kk[j]; nm[i] = fpv * nm[i] + ipv * kk[j]; hp += Cm[i] * qq[j]; nq += nm[i] * qq[j]; } }
                ph[(tt * 4 + g4) * 128 + dv] = hp; if (dv == 0) pn[tt * 4 + g4] = nq;
                const float v2 = hv[tt * 128 + dv]; float op = 0.f;
#pragma unroll
                for (int i4 = 0; i4 < 8; ++i4) { const f32x4 ff = *(const LAS f32x4*)(hf + tt * 128 + 32 * g4 + 4 * i4), k2 = *(const LAS f32x4*)(hk + tt * 128 + 32 * g4 + 4 * i4), q2 = *(const LAS f32x4*)(hq + tt * 128 + 32 * g4 + 4 * i4);
#pragma unroll
                    for (int j = 0; j < 4; ++j) { const int i = 4 * i4 + j; Sh[i] = ff[j] * Sh[i] + k2[j] * v2; op += Sh[i] * q2[j]; } }
                po[(tt * 4 + g4) * 128 + dv] = op;
            }
            __syncthreads();
            {
                const int tt = tid >> 5, dvg = tid & 31;
                const float den = (pn[tt * 4] + pn[tt * 4 + 1]) + (pn[tt * 4 + 2] + pn[tt * 4 + 3]);
                const float sc = 1.f / fmaxf(fabsf(den), flo[tt]);
                float hs[4], os[4]; float ssa = 0.f, ssb = 0.f;
#pragma unroll
                for (int i = 0; i < 4; ++i) { const int d2 = dvg + 32 * i;
                    hs[i] = ((ph[(tt * 4) * 128 + d2] + ph[(tt * 4 + 1) * 128 + d2]) + (ph[(tt * 4 + 2) * 128 + d2] + ph[(tt * 4 + 3) * 128 + d2])) * sc;
                    os[i] = (po[(tt * 4) * 128 + d2] + po[(tt * 4 + 1) * 128 + d2]) + (po[(tt * 4 + 2) * 128 + d2] + po[(tt * 4 + 3) * 128 + d2]);
                    ssa += hs[i] * hs[i]; ssb += os[i] * os[i]; }
#pragma unroll
                for (int o = 1; o < 32; o <<= 1) { ssa += __shfl_xor(ssa, o); ssb += __shfl_xor(ssb, o); }
                const float ra = rsqrtf(ssa * (1.f / 128.f) + RMS_EPS), rb = rsqrtf(ssb * (1.f / 128.f) + RMS_EPS);
                const int tl = tl0 + tt; const size_t grow = (size_t)b * SEQ + seg * SEGT + tl;
                const bf16* pr = Pcur + (size_t)(b * SEGT + tl) * PW + h * HB;
#pragma unroll
                for (int i = 0; i < 4; ++i) { const int d2 = dvg + 32 * i, c = h * 128 + d2;
                    const float ya = hs[i] * ra * mnw[c] * sigm(bf2f(pr[384 + d2]));
                    const float yb = os[i] * rb * hnw[c] * siluf(bf2f(pr[896 + d2]));
                    const float y = sigm(bf2f(pr[1024 + d2])) * ya + sigm(bf2f(pr[1152 + d2])) * yb;
                    Y[grow * D + c] = (bf16)f2bf(y); }
            }
            __syncthreads();
        }
#pragma unroll
        for (int i = 0; i < 32; ++i) { stC[((size_t)(bh * 4 + g4) * 32 + i) * 128 + dv] = Cm[i]; stS[((size_t)(bh * 4 + g4) * 32 + i) * 128 + dv] = Sh[i]; if (dv == 0) stN[bh * 128 + 32 * g4 + i] = nm[i]; }
        if (tid == 0) stM[bh] = mst;
    }
}

__global__ void __launch_bounds__(NWAVES * 64, 2) fwd_kernel(Args kernel_args_unused) {
    extern __shared__ __attribute__((aligned(16))) unsigned char lds[];
    Ctx F;
    F.lds = (LAS unsigned char*)lds;
    F.G = gridDim.x; { const int bx = blockIdx.x; F.vcu = (F.G % 8 == 0) ? (bx % 8) * (F.G / 8) + bx / 8 : bx; }
    volatile LAS unsigned* MISC = (volatile LAS unsigned*)(F.lds + MISC_OFF);
    if (threadIdx.x < 64) MISC[threadIdx.x] = 0u;
    __syncthreads();
    XcdBarrier bar;
    { ARGS(); bar = xcd_barrier_post((unsigned*)((gu32*)(A.ws + WS_CTL) + CW_BAR), MISC + 8); }
#define GRID_BAR() xcd_barrier(bar)

    p0_prologue(F);
    GRID_BAR();

    for (int layer = 0; layer < DEPTH; ++layer) {
#define PHASE_PTRS() ARGS(); const float* src = layer == 0 ? A.in[0] : (const float*)A.out; const float* modl = (const float*)(A.ws + WS_MOD) + (size_t)layer * BATCH * MODW; bf16* hn = (bf16*)(A.ws + WS_HN); (void)src; (void)modl; (void)hn
        { PHASE_PTRS();
        norm_phase<true>(F, src, A.in[4] + (size_t)layer * D, modl, 0, D, hn, (float*)(A.ws + WS_GATES), (const float*)(A.ws + WS_WG) + (size_t)layer * 16 * D, (const float*)(A.ws + WS_BG) + layer * 16); }
        GRID_BAR();
        for (int seg = 0; seg < NSEG; ++seg) {
            {
                PHASE_PTRS();
                pg8::Gemm g{hn, (const bf16*)(A.ws + WS_WIN) + (size_t)layer * PW * D, SEGROWS, PW, D, NSEG, seg};
                pg8::StaticOrder S; S.init(SEGROWS, PW, F.G, (int)blockIdx.x);
                pg8::EpiBf16B E{(bf16*)(A.ws + WS_P + (size_t)(seg & 1) * P_BYTES), PW, (const float*)(A.ws + WS_BIASP) + (size_t)layer * PW};
                pg8::gemm_phase<pg8::EpiBf16B, pg8::StaticOrder, PG8_ALIGN, PG8_SP2>(F.lds + RING_OFF, g, S, E);
            }
            GRID_BAR();
            mixer_naive_phase(F, layer, seg);
            GRID_BAR();
        }
        {
            PHASE_PTRS();
            pg8::Gemm g{(const bf16*)(A.ws + WS_Y), (const bf16*)(A.ws + WS_WOUT) + (size_t)layer * D * D, M, D, D, 1, 0};
            pg8::StaticOrder S; S.init(M, D, F.G, (int)blockIdx.x);
            pg8::EpiResid E{src, A.out, D, modl + 2 * D, MODW, 0};
            pg8::gemm_phase<pg8::EpiResid, pg8::StaticOrder, PG8_ALIGN, PG8_SP2>(F.lds + RING_OFF, g, S, E);
        }
        GRID_BAR();
        { PHASE_PTRS();
        norm_phase<false>(F, (const float*)A.out, A.in[13] + (size_t)layer * D, modl, 3 * D, 4 * D, hn, nullptr, nullptr, nullptr); }
        GRID_BAR();
        for (int fs = 0; fs < FSEG; ++fs) {
            {
                PHASE_PTRS();
                pg8::Gemm g{hn + (size_t)fs * FROWS * D, (const bf16*)(A.ws + WS_WUP) + (size_t)layer * 2 * DFF * D, FROWS, 2 * DFF, D, 1, 0};
                pg8::StaticOrder S; S.init(FROWS, 2 * DFF, F.G, (int)blockIdx.x);
                pg8::EpiBf16B E{(bf16*)(A.ws + WS_U), 2 * DFF, nullptr};
                pg8::gemm_phase<pg8::EpiBf16B, pg8::StaticOrder, PG8_ALIGN, PG8_SP2>(F.lds + RING_OFF, g, S, E);
            }
            GRID_BAR();
            { ARGS(); ffn_glu_phase(F, (const bf16*)(A.ws + WS_U), (bf16*)(A.ws + WS_G), A.in[15] + (size_t)layer * 3 * 2 * DFF, A.in[16] + (size_t)layer * 2 * DFF); }
            GRID_BAR();
            {
                PHASE_PTRS();
                pg8::Gemm g{(const bf16*)(A.ws + WS_G), (const bf16*)(A.ws + WS_WDN) + (size_t)layer * D * DFF, FROWS, D, DFF, 1, 0};
                pg8::StaticOrder S; S.init(FROWS, D, F.G, (int)blockIdx.x);
                pg8::EpiResid E{(const float*)A.out, A.out, D, modl + 5 * D, MODW, fs * FROWS};
                pg8::gemm_phase<pg8::EpiResid, pg8::StaticOrder, PG8_ALIGN, PG8_SP2>(F.lds + RING_OFF, g, S, E);
            }
            GRID_BAR();
        }
    }
    { ARGS(); final_norm_phase(F, A.out, A.in[18]); }
#undef GRID_BAR
}

extern "C" void kernel_launch(void* const* d_in, const int* in_sizes, int n_in, void* d_out, int out_size, void* d_ws, size_t ws_size, hipStream_t stream) {
    static int grid = 0;
    if (grid == 0) {
        if (n_in != 19 || in_sizes[0] != M * D || out_size != M * D || ws_size < WS_END) { fprintf(stderr, "kernel_launch: unexpected shapes (n_in %d, in0 %d, out %d, ws %zu; need ws >= %zu); nothing launched\n", n_in, n_in > 0 ? in_sizes[0] : -1, out_size, ws_size, (size_t)WS_END); grid = -1; return; }
        int dev = 0, cus = 0, per_cu = 0;
        if (hipGetDevice(&dev) != hipSuccess || hipDeviceGetAttribute(&cus, hipDeviceAttributeMultiprocessorCount, dev) != hipSuccess) { grid = -1; return; }
        if (hipFuncSetAttribute((const void*)fwd_kernel, hipFuncAttributeMaxDynamicSharedMemorySize, LDS_BYTES) != hipSuccess) { fprintf(stderr, "kernel_launch: hipFuncSetAttribute failed\n"); grid = -1; return; }
        if (hipOccupancyMaxActiveBlocksPerMultiprocessor(&per_cu, (const void*)fwd_kernel, NWAVES * 64, LDS_BYTES) != hipSuccess || per_cu < 1)
            fprintf(stderr, "kernel_launch: note: occupancy query reports %d workgroups per CU\n", per_cu);
        (void)hipGetLastError();
        grid = cus;
    }
    if (grid < 0) return;
    if (hipMemsetAsync((char*)d_ws + WS_CTL, 0, CTL_ZERO_BYTES, stream) != hipSuccess) return;
    Args a{};
    for (int i = 0; i < 19; ++i) a.in[i] = (const float*)d_in[i];
    a.out = (float*)d_out; a.ws = (unsigned char*)d_ws;
    hipLaunchKernelGGL(fwd_kernel, dim3(grid), dim3(NWAVES * 64), LDS_BYTES, stream, a);
}
```

```cpp
#include <hip/hip_runtime.h>
#include <cstdio>
#include <cstdint>
namespace pg8 {
#define PG8_LAS __attribute__((address_space(3)))
typedef unsigned short bf16_t;
typedef short bf16x8 __attribute__((ext_vector_type(8)));
typedef float f32x4 __attribute__((ext_vector_type(4)));
typedef unsigned u32x4 __attribute__((ext_vector_type(4)));
constexpr int BM = 256, BK = 64, HALF = 128, HTB = HALF * BK * 2  , STAGE_BYTES = 8 * HTB, NXCD = 8, WGM = 8;

__host__ __device__ __forceinline__ int lds_byte(int r, int c) { const int st = (r >> 4) * 2 + (c >> 5), rr = r & 15, cc = c & 31, ob = rr * 64 + cc * 2; return st * 1024 + (ob ^ (((ob >> 9) & 1) << 5)); }
__host__ __device__ __forceinline__ void stage_rc(int b, int& R, int& C) { const int st = b / 1024, sb = b % 1024, swz = sb ^ (((sb >> 9) & 1) << 5); R = (st >> 1) * 16 + swz / 64; C = (st & 1) * 32 + (swz % 64) / 2; }
__host__ __device__ __forceinline__ int perm32(int rho) { const int n = rho >> 4, i = rho & 15; return 8 * (i >> 2) + 4 * n + (i & 3); }

struct Unit { int pm, pn; };
struct Gemm { const bf16_t* A; const bf16_t* Bt; int M, N, K; int a_mul, a_add; };

struct StaticOrder {
    int nM, nN, nwg, G, c;
    __host__ __device__ void init(int M, int N, int G_, int c_) { nM = M / BM; nN = N / BM; nwg = nM * nN; G = G_; c = c_; }
    __host__ __device__ bool next(int i, Unit& u) const {
        const long L = (long)i * G + c; if (L >= nwg) return false;
        int wgid = (int)L; { const int q = nwg / NXCD, r = nwg % NXCD, xcd = wgid % NXCD, off = wgid / NXCD; wgid = (xcd < r ? xcd * (q + 1) : r * (q + 1) + (xcd - r) * q) + off; }
        const int nig = WGM * nN, gid = wgid / nig, fm = gid * WGM, gsz = (nM - fm) < WGM ? (nM - fm) : WGM;
        u.pm = fm + ((wgid % nig) % gsz); u.pn = (wgid % nig) / gsz; return true;
    }
    __device__ __forceinline__ void a_ready(const Unit&) const {}
    __device__ __forceinline__ void done(const Unit&) const {}
};

__device__ __forceinline__ unsigned cvt_pk_bf16(float lo, float hi) { unsigned r; asm volatile("v_cvt_pk_bf16_f32 %0, %1, %2" : "=v"(r) : "v"(lo), "v"(hi)); return r; }

struct EpiBf16B {
    static constexpr bool PERM = true, AFTER_DRAIN = false;
    bf16_t* O; int ldc; const float* bias;
    __device__ __forceinline__ void operator()(const f32x4 (&acc)[2][2][4][2], const Unit& u, int wr, int wc, int fr, int fq) const {
        const int row0 = u.pm * BM + wr * 64 + fr; const int col0 = u.pn * BM + wc * 32 + 8 * fq;
        f32x4 bv[2][2];
#pragma unroll
        for (int bj = 0; bj < 2; ++bj)
#pragma unroll
            for (int n = 0; n < 2; ++n) bv[bj][n] = bias ? *(const f32x4*)(bias + col0 + bj * HALF + 4 * n) : (f32x4){0.f, 0.f, 0.f, 0.f};
#pragma unroll
        for (int ai = 0; ai < 2; ++ai)
#pragma unroll
            for (int m = 0; m < 4; ++m) { bf16_t* rowp = O + (size_t)(row0 + ai * HALF + m * 16) * ldc + col0;
#pragma unroll
                for (int bj = 0; bj < 2; ++bj) { const f32x4 v0 = acc[ai][bj][m][0] + bv[bj][0], v1 = acc[ai][bj][m][1] + bv[bj][1];
                    u32x4 w; w.x = cvt_pk_bf16(v0[0], v0[1]); w.y = cvt_pk_bf16(v0[2], v0[3]); w.z = cvt_pk_bf16(v1[0], v1[1]); w.w = cvt_pk_bf16(v1[2], v1[3]);
                    *(u32x4*)(rowp + bj * HALF) = w; } }
    }
};
struct EpiResid {
    static constexpr bool PERM = false, AFTER_DRAIN = false;
    const float* res; float* out; int ldc; const float* gate; int gstride; int row_off;
    __device__ __forceinline__ void operator()(const f32x4 (&acc)[2][2][4][2], const Unit& u, int wr, int wc, int fr, int fq) const {
        const int rbase = row_off + u.pm * BM; const int b = rbase >> 11;
        const int row0 = rbase + wr * 64 + fr, col0 = u.pn * BM + wc * 32 + 4 * fq;
        const float* gp = gate + (size_t)b * gstride + col0;
        f32x4 gv[2][2];
#pragma unroll
        for (int bj = 0; bj < 2; ++bj)
#pragma unroll
            for (int n = 0; n < 2; ++n) gv[bj][n] = *(const f32x4*)(gp + bj * HALF + n * 16);
#pragma unroll
        for (int ai = 0; ai < 2; ++ai)
#pragma unroll
            for (int m = 0; m < 4; ++m) { const size_t off = (size_t)(row0 + ai * HALF + m * 16) * ldc + col0;
#pragma unroll
                for (int bj = 0; bj < 2; ++bj)
#pragma unroll
                    for (int n = 0; n < 2; ++n) { const f32x4 r = *(const f32x4*)(res + off + bj * HALF + n * 16);
                        *(f32x4*)(out + off + bj * HALF + n * 16) = r + gv[bj][n] * acc[ai][bj][m][n]; } }
    }
};

template <class Epi, class Sched, bool ALIGN_EPI = false, bool SP2 = false>
__device__ __forceinline__ void gemm_phase(PG8_LAS unsigned char* lds, const Gemm g, const Sched& S, const Epi& E, const int wave_id  ) {
    int tid_l = wave_id * 64 + (int)__builtin_amdgcn_mbcnt_hi(~0u, __builtin_amdgcn_mbcnt_lo(~0u, 0u)); asm volatile("" : "+v"(tid_l));
    const int tid = tid_l, wid = __builtin_amdgcn_readfirstlane(tid >> 6), lane = tid & 63, wr = wid >> 2, wc = wid & 3, fr = lane & 15, fq = lane >> 4;
    const int K = g.K, nt = K / BK;
    unsigned voffA[2], voffB[2];
#pragma unroll
    for (int i = 0; i < 2; ++i) { int R, C; stage_rc(tid * 16 + i * 8192, R, C); const int Rb = Epi::PERM ? ((R & ~31) + perm32(R & 31)) : R;
        voffA[i] = (unsigned)(R * K + C) * 2u; voffB[i] = (unsigned)(Rb * K + C) * 2u; }
    const size_t kstep = (size_t)(BK * 2);
    const size_t hstep = (size_t)HALF * K * 2;
    const size_t tstep = 2 * hstep;
    const unsigned ldsw = (unsigned)wid * 1024u;
    const int aoff = lds_byte(wr * 64 + fr, fq * 8), boff = lds_byte(wc * 32 + fr, fq * 8);
#define PG8_SA(b, h) (((b) * 2 + (h)) * HTB)
#define PG8_SB(b, h) ((4 + (b) * 2 + (h)) * HTB)
#define PG8_STAGE(bufoff, gbase, voff) do { _Pragma("unroll") for (int _i = 0; _i < 2; ++_i) \
        __builtin_amdgcn_global_load_lds((const unsigned*)((const char*)(gbase) + (voff)[_i]), (PG8_LAS unsigned*)(lds + (bufoff) + ldsw + _i * 8192), 16, 0, 0); } while (0)
#define PG8_LDA(dst, b, h) do { _Pragma("unroll") for (int m = 0; m < 4; ++m) _Pragma("unroll") for (int k = 0; k < 2; ++k) dst[m][k] = *(const PG8_LAS bf16x8*)(lds + PG8_SA(b, h) + aoff + m * 2048 + k * 1024); } while (0)
#define PG8_LDB(dst, b, h) do { _Pragma("unroll") for (int n = 0; n < 2; ++n) _Pragma("unroll") for (int k = 0; k < 2; ++k) dst[n][k] = *(const PG8_LAS bf16x8*)(lds + PG8_SB(b, h) + boff + n * 2048 + k * 1024); } while (0)
#define PG8_MMA(ai, bj, At, Bt) do { __builtin_amdgcn_s_setprio(1); _Pragma("unroll") for (int m = 0; m < 4; ++m) _Pragma("unroll") for (int n = 0; n < 2; ++n) _Pragma("unroll") for (int k = 0; k < 2; ++k) \
        acc[ai][bj][m][n] = __builtin_amdgcn_mfma_f32_16x16x32_bf16(Bt[n][k], At[m][k], acc[ai][bj][m][n], 0, 0, 0); __builtin_amdgcn_s_setprio(0); } while (0)
#define PG8_WAIT_V(n) asm volatile("s_waitcnt vmcnt(" #n ")" ::: "memory")
#define PG8_WAIT_L(n) asm volatile("s_waitcnt lgkmcnt(" #n ")" ::: "memory")
#define PG8_BAR __builtin_amdgcn_s_barrier()
#define PG8_SCHED __builtin_amdgcn_sched_barrier(0)
    Unit cur, nxt; int ui = 0;
    if (!S.next(0, cur)) return;
    f32x4 acc[2][2][4][2];
#pragma unroll
    for (int a = 0; a < 2; ++a)
#pragma unroll
        for (int b = 0; b < 2; ++b)
#pragma unroll
            for (int m = 0; m < 4; ++m)
#pragma unroll
                for (int n = 0; n < 2; ++n) acc[a][b][m][n] = (f32x4){0.f, 0.f, 0.f, 0.f};
    bf16x8 At[4][2], B0[2][2], B1[2][2];
    const char* cA = (const char*)g.A + (size_t)(cur.pm * g.a_mul + g.a_add) * tstep; const char* cB = (const char*)g.Bt + (size_t)cur.pn * tstep;
    S.a_ready(cur);
    if constexpr (SP2) {
        PG8_STAGE(PG8_SB(0, 0), cB, voffB); PG8_STAGE(PG8_SB(0, 1), cB + hstep, voffB); PG8_STAGE(PG8_SA(0, 0), cA, voffA); PG8_STAGE(PG8_SA(0, 1), cA + hstep, voffA);
        if (wr == 1) PG8_BAR;
        PG8_WAIT_V(2); PG8_BAR;
        PG8_STAGE(PG8_SB(1, 0), cB + kstep, voffB); PG8_STAGE(PG8_SA(1, 0), cA + kstep, voffA); PG8_STAGE(PG8_SB(1, 1), cB + hstep + kstep, voffB);
        PG8_WAIT_V(6); PG8_BAR;
    } else {
        PG8_STAGE(PG8_SB(0, 0), cB, voffB); PG8_STAGE(PG8_SA(0, 0), cA, voffA); PG8_STAGE(PG8_SB(0, 1), cB + hstep, voffB); PG8_STAGE(PG8_SA(0, 1), cA + hstep, voffA);
        if (wr == 1) PG8_BAR;
        PG8_WAIT_V(4); PG8_BAR;
        PG8_STAGE(PG8_SB(1, 0), cB + kstep, voffB); PG8_STAGE(PG8_SA(1, 0), cA + kstep, voffA); PG8_STAGE(PG8_SB(1, 1), cB + hstep + kstep, voffB);
        PG8_WAIT_V(6); PG8_BAR;
    }
    for (;;) {
        const bool has_next = S.next(ui + 1, nxt);
        const char* nA = has_next ? (const char*)g.A + (size_t)(nxt.pm * g.a_mul + g.a_add) * tstep : cA; const char* nB = has_next ? (const char*)g.Bt + (size_t)nxt.pn * tstep : cB;
        for (int t = 0; t < nt; t += 2) {
            const bool last = (t == nt - 2);
            const char* a1 = cA + (size_t)(t + 1) * kstep;
            const char* a2 = last ? nA : cA + (size_t)(t + 2) * kstep; const char* b2 = last ? nB : cB + (size_t)(t + 2) * kstep;
            const char* a3 = a2 + kstep; const char* b3 = b2 + kstep;
            if (last && has_next) S.a_ready(nxt);
            if constexpr (SP2) {
            PG8_LDB(B0, 0, 0); PG8_LDB(B1, 0, 1); PG8_SCHED; PG8_LDA(At, 0, 0); PG8_STAGE(PG8_SA(1, 1), a1 + hstep, voffA);
            PG8_WAIT_V(8); PG8_WAIT_L(0); PG8_BAR; PG8_MMA(0, 0, At, B0); PG8_MMA(0, 1, At, B1); PG8_BAR; PG8_SCHED;
            PG8_LDA(At, 0, 1); PG8_STAGE(PG8_SB(0, 0), b2, voffB); PG8_STAGE(PG8_SB(0, 1), b2 + hstep, voffB); PG8_STAGE(PG8_SA(0, 0), a2, voffA);
            PG8_WAIT_V(8); PG8_WAIT_L(0); PG8_BAR; PG8_MMA(1, 0, At, B0); PG8_MMA(1, 1, At, B1); PG8_BAR; PG8_SCHED;
            PG8_LDB(B0, 1, 0); PG8_LDB(B1, 1, 1); PG8_SCHED; PG8_LDA(At, 1, 0); PG8_STAGE(PG8_SA(0, 1), a2 + hstep, voffA);
            PG8_WAIT_V(8); PG8_WAIT_L(0); PG8_BAR; PG8_MMA(0, 0, At, B0); PG8_MMA(0, 1, At, B1); PG8_BAR; PG8_SCHED;
            PG8_LDA(At, 1, 1); PG8_STAGE(PG8_SB(1, 0), b3, voffB); PG8_STAGE(PG8_SB(1, 1), b3 + hstep, voffB); PG8_STAGE(PG8_SA(1, 0), a3, voffA);
            PG8_WAIT_V(8); PG8_WAIT_L(0); PG8_BAR; PG8_MMA(1, 0, At, B0); PG8_MMA(1, 1, At, B1); PG8_BAR; PG8_SCHED;
            } else {
            PG8_LDB(B0, 0, 0); PG8_SCHED; PG8_LDA(At, 0, 0); PG8_STAGE(PG8_SA(1, 1), a1 + hstep, voffA);
            PG8_WAIT_L(8); PG8_BAR; PG8_WAIT_L(0); PG8_MMA(0, 0, At, B0); PG8_BAR; PG8_SCHED;
            PG8_LDB(B1, 0, 1); PG8_STAGE(PG8_SB(0, 0), b2, voffB);
            PG8_BAR; PG8_WAIT_L(0); PG8_MMA(0, 1, At, B1); PG8_BAR;
            PG8_LDA(At, 0, 1); PG8_STAGE(PG8_SA(0, 0), a2, voffA);
            PG8_BAR; PG8_WAIT_L(0); PG8_MMA(1, 0, At, B0); PG8_BAR; PG8_SCHED;
            PG8_STAGE(PG8_SB(0, 1), b2 + hstep, voffB);
            PG8_WAIT_V(6); PG8_BAR; PG8_MMA(1, 1, At, B1); PG8_BAR;
            PG8_LDB(B0, 1, 0); PG8_SCHED; PG8_LDA(At, 1, 0); PG8_STAGE(PG8_SA(0, 1), a2 + hstep, voffA);
            PG8_WAIT_L(8); PG8_BAR; PG8_WAIT_L(0); PG8_MMA(0, 0, At, B0); PG8_BAR; PG8_SCHED;
            PG8_LDB(B1, 1, 1); PG8_STAGE(PG8_SB(1, 0), b3, voffB);
            PG8_BAR; PG8_WAIT_L(0); PG8_MMA(0, 1, At, B1); PG8_BAR;
            PG8_LDA(At, 1, 1); PG8_STAGE(PG8_SA(1, 0), a3, voffA);
            PG8_BAR; PG8_WAIT_L(0); PG8_MMA(1, 0, At, B0); PG8_BAR; PG8_SCHED;
            PG8_STAGE(PG8_SB(1, 1), b3 + hstep, voffB);
            PG8_WAIT_V(6); PG8_BAR; PG8_MMA(1, 1, At, B1); PG8_BAR;
            }
        }
        if constexpr (ALIGN_EPI) { if (wr == 0) PG8_BAR; }
        if constexpr (!Epi::AFTER_DRAIN) { E(acc, cur, wr, wc, fr, fq); S.done(cur); }
        if (!has_next) break;
#pragma unroll
        for (int a = 0; a < 2; ++a)
#pragma unroll
            for (int b = 0; b < 2; ++b)
#pragma unroll
                for (int m = 0; m < 4; ++m)
#pragma unroll
                    for (int n = 0; n < 2; ++n) acc[a][b][m][n] = (f32x4){0.f, 0.f, 0.f, 0.f};
        cur = nxt; cA = nA; cB = nB; ++ui;
        if constexpr (ALIGN_EPI) { if (wr == 1) PG8_BAR; }
    }
    PG8_WAIT_V(0);
    if constexpr (!ALIGN_EPI) { if (wr == 0) PG8_BAR; }
    PG8_BAR;
    if constexpr (Epi::AFTER_DRAIN) { E.fused(acc, cur, wr, wc, fr, fq, lds, wid, lane); S.done(cur); }
#undef PG8_SA
#undef PG8_SB
#undef PG8_STAGE
#undef PG8_LDA
#undef PG8_LDB
#undef PG8_MMA
#undef PG8_WAIT_V
#undef PG8_WAIT_L
#undef PG8_BAR
#undef PG8_SCHED
}
}

#ifndef PG8_SP2
#define PG8_SP2 true
#endif
#ifndef PG8_ALIGN
#define PG8_ALIGN true
#endif

constexpr int NWAVES = 8;
constexpr int D = 1024, BATCH = 32, SEQ = 2048, M = BATCH * SEQ, DEPTH = 2, NH = 8, HD = 128, DFF = 2816;
constexpr int PROJW = 10256;
constexpr int PW = 10240, HB = 1280;
constexpr int NSEG = 8, SEGT = SEQ / NSEG, SEGROWS = BATCH * SEGT;
constexpr int FSEG = 2, FROWS = M / FSEG;
constexpr float RMS_EPS = 1e-6f;
constexpr int MODW = 6 * D;

constexpr size_t MiB = 1u << 20;
constexpr size_t WS_CTL = 0, CTL_ZERO_BYTES = 1 * MiB;
constexpr size_t WS_WIN = 2 * MiB;
constexpr size_t WS_WOUT = 42 * MiB;
constexpr size_t WS_WUP = 46 * MiB;
constexpr size_t WS_WDN = 68 * MiB;
constexpr size_t WS_WG = 79 * MiB;
constexpr size_t WS_BIASP = 79 * MiB + 256 * 1024;
constexpr size_t WS_BG = 79 * MiB + 512 * 1024;
constexpr size_t WS_LB = 79 * MiB + 768 * 1024;
constexpr size_t WS_MOD = 80 * MiB;
constexpr size_t WS_GATES = 84 * MiB;
constexpr size_t WS_STC = 88 * MiB;
constexpr size_t WS_STS = 104 * MiB;
constexpr size_t WS_STN = 120 * MiB;
constexpr size_t WS_STM = 121 * MiB;
constexpr size_t WS_HN = 122 * MiB;
constexpr size_t WS_Y = 250 * MiB;
constexpr size_t WS_P = 378 * MiB;
constexpr size_t P_BYTES = (size_t)SEGROWS * PW * 2;
constexpr size_t WS_U = 250 * MiB;
constexpr size_t WS_G = 602 * MiB;
constexpr size_t WS_END = 778 * MiB;
static_assert(WS_P + 2 * P_BYTES <= 698 * MiB && WS_U + (size_t)FROWS * 2 * DFF * 2 <= WS_G && WS_G + (size_t)FROWS * DFF * 2 <= WS_END, "ws map");
constexpr int CW_TMO = 0, CW_CODE = 1, CW_BAR = 4096;

constexpr int LDS_BYTES = 160 * 1024;
constexpr int RING_OFF = 0;
constexpr int MISC_OFF = 159 * 1024;

#define GAS __attribute__((address_space(1)))
#define LAS __attribute__((address_space(3)))
typedef unsigned short bf16;
typedef unsigned v4u __attribute__((ext_vector_type(4)));
typedef unsigned v2u __attribute__((ext_vector_type(2)));
typedef float f32x4 __attribute__((ext_vector_type(4)));
typedef short bf16x8 __attribute__((ext_vector_type(8)));
typedef GAS unsigned gu32;
#define RLX_AGENT __ATOMIC_RELAXED, __HIP_MEMORY_SCOPE_AGENT
#define LDS_WAIT() asm volatile("s_waitcnt lgkmcnt(0)" ::: "memory")
#define VM_WAIT() asm volatile("s_waitcnt vmcnt(0)" ::: "memory")
__device__ __forceinline__ unsigned f2bf(float f) { unsigned u = __builtin_bit_cast(unsigned, f); return (u + 0x7fffu + ((u >> 16) & 1u)) >> 16; }
__device__ __forceinline__ unsigned pk2(float lo, float hi) { return f2bf(lo) | (f2bf(hi) << 16); }
__device__ __forceinline__ float bf2f(unsigned short b) { return __builtin_bit_cast(float, ((unsigned)b) << 16); }
__device__ __forceinline__ float sigm(float x) { return 1.f / (1.f + __expf(-x)); }
__device__ __forceinline__ float siluf(float x) { return x / (1.f + __expf(-x)); }
__device__ __forceinline__ float softcap15(float z) { return 15.f * tanhf(z * (1.f / 15.f)); }
__device__ __forceinline__ float logsigm(float z) { return fminf(z, 0.f) - log1pf(expf(-fabsf(z))); }
__device__ __forceinline__ float wave_sum(float v) {
#pragma unroll
    for (int o = 1; o < 64; o <<= 1) v += __shfl_xor(v, o);
    return v;
}

#define PHASE_TID() int tid = F.wave_s * 64 + (int)__builtin_amdgcn_mbcnt_hi(~0u, __builtin_amdgcn_mbcnt_lo(~0u, 0u)); asm volatile("" : "+v"(tid)); const int lane = tid & 63, wave = F.wave_s; (void)lane; (void)wave
#define XB_TMO      128
#define XB_XCNT(j)  (256  + 64 * (j))
#define XB_XSUB(j)  (1280 + 64 * (j))
#define XB_XGEN(j)  (2304 + 64 * (j))
#define XB_TOP      3328
#define XB_TOPGEN   3392
#define XCD_BAR_WORDS 3456
#define XB_SPIN_CAP (1u << 18)

__device__ __forceinline__ unsigned xb_ld(unsigned* p)              { return __hip_atomic_load(p, __ATOMIC_RELAXED, __HIP_MEMORY_SCOPE_AGENT); }
__device__ __forceinline__ unsigned xb_add(unsigned* p, unsigned v) { return __hip_atomic_fetch_add(p, v, __ATOMIC_RELAXED, __HIP_MEMORY_SCOPE_AGENT); }
__device__ __forceinline__ unsigned xb_xcc_id() { return (unsigned)__builtin_amdgcn_s_getreg((3 << 11) | 20) & 0xFu; }
#define XB_SPIN(cond, bar) do { unsigned _sp = 0; while (cond) { __builtin_amdgcn_s_sleep(1); \
    if ((++_sp & 255u) == 0u) { if (xb_ld(&(bar)[XB_TMO])) break; if (_sp > XB_SPIN_CAP) { atomicAdd(&(bar)[XB_TMO], 1u); break; } } } } while (0)

struct XcdBarrier {
    unsigned* bar; unsigned x;
    volatile LAS unsigned* st;
};

__device__ __forceinline__ XcdBarrier xcd_barrier_post(unsigned* bar, volatile LAS unsigned* st) {
    XcdBarrier b; b.bar = bar; b.x = xb_xcc_id(); b.st = st;
    if (threadIdx.x == 0) (void)xb_add(&bar[XB_XCNT(b.x)], 1u);
    return b;
}
__device__ __forceinline__ void xcd_barrier_complete(unsigned* bar, unsigned x, unsigned& nloc, unsigned& nx) {
    const unsigned G = gridDim.x * gridDim.y * gridDim.z;
    unsigned sum, cnt, mine, sp = 0u;
    for (;;) {
        sum = 0u; cnt = 0u; mine = 0u;
#pragma unroll
        for (unsigned j = 0; j < 16; ++j) { const unsigned c = xb_ld(&bar[XB_XCNT(j)]); sum += c; cnt += (c > 0u) ? 1u : 0u; mine = (j == x) ? c : mine; }
        if (sum == G) break;
        __builtin_amdgcn_s_sleep(1);
        if ((++sp & 255u) == 0u) { if (xb_ld(&bar[XB_TMO])) break; if (sp > XB_SPIN_CAP) { atomicAdd(&bar[XB_TMO], 1u); break; } }
    }
    nloc = mine > 0u ? mine : 1u; nx = cnt > 0u ? cnt : 1u;
}

__device__ __forceinline__ void xcd_barrier(const XcdBarrier& b) {
    asm volatile("s_waitcnt vmcnt(0)" ::: "memory");
    __syncthreads();
    if (threadIdx.x == 0) {
        unsigned* bar = b.bar;
        __builtin_amdgcn_s_waitcnt(0);
        unsigned nloc = b.st[0], nx = b.st[1];
        if (nloc == 0u) { xcd_barrier_complete(bar, b.x, nloc, nx); b.st[0] = nloc; b.st[1] = nx; }
        const unsigned old = xb_add(&bar[XB_XSUB(b.x)], 1u);
        const unsigned gen = old / nloc;
        if (old + 1u == (gen + 1u) * nloc) {
            __builtin_amdgcn_fence(__ATOMIC_RELEASE, "agent");
            asm volatile("s_waitcnt vmcnt(0)" ::: "memory");
            const unsigned og = xb_add(&bar[XB_TOP], 1u);
            const unsigned tg = og / nx;
            if (og + 1u == (tg + 1u) * nx) xb_add(&bar[XB_TOPGEN], 1u);
            else XB_SPIN(xb_ld(&bar[XB_TOPGEN]) == tg, bar);
            __builtin_amdgcn_fence(__ATOMIC_ACQUIRE, "agent");
            xb_add(&bar[XB_XGEN(b.x)], 1u);
            asm volatile("s_waitcnt vmcnt(0)" ::: "memory");
        } else {
            XB_SPIN(xb_ld(&bar[XB_XGEN(b.x)]) == gen, bar);
            __builtin_amdgcn_fence(__ATOMIC_ACQUIRE, "agent");
            asm volatile("s_waitcnt vmcnt(0)" ::: "memory");
        }
    }
    __syncthreads();
}

struct Ctx {
    LAS unsigned char* lds;
    int vcu, G, wave_s;
};
struct Args { const float* in[19]; float* out; unsigned char* ws; };
typedef const Args __attribute__((address_space(4))) CArgs;
__device__ __forceinline__ CArgs& getargs() { CArgs* p = (CArgs*)__builtin_amdgcn_kernarg_segment_ptr(); asm volatile("" : "+s"(p)); return *p; }
#define ARGS() CArgs& A = getargs()

__device__ __forceinline__ void p0_transpose_item(const float* W, int ldw, int srccol0, int k0, bf16* WT, int K, int dstrow0, LAS float* scr, int lane) {
#pragma unroll 8
    for (int i = 0; i < 32; ++i) { const int kk = 2 * i + (lane >> 5); scr[kk * 33 + (lane & 31)] = W[(size_t)(k0 + kk) * ldw + srccol0 + (lane & 31)]; }
    LDS_WAIT(); asm volatile("" ::: "memory");
    const int c = lane & 7;
#pragma unroll
    for (int j = 0; j < 4; ++j) { const int n = (lane >> 3) + 8 * j; const LAS float* s = scr + (8 * c) * 33 + n;
        v4u o; o.x = pk2(s[0 * 33], s[1 * 33]); o.y = pk2(s[2 * 33], s[3 * 33]); o.z = pk2(s[4 * 33], s[5 * 33]); o.w = pk2(s[6 * 33], s[7 * 33]);
        *(GAS v4u*)(WT + (size_t)(dstrow0 + n) * K + k0 + 8 * c) = o; }
    LDS_WAIT(); asm volatile("" ::: "memory");
}
__device__ __forceinline__ int in_src_col(int dstcol) {
    const int h = dstcol / HB, rem = dstcol - h * HB, blk = rem >> 7, j = rem & 127;
    const int base = blk < 4 ? blk * 1024 : 4112 + (blk - 4) * 1024;
    return base + h * 128 + j;
}
__device__ __forceinline__ void p0_prologue(Ctx& F) {
    PHASE_TID();
    ARGS();
    LAS float* scr = (LAS float*)(F.lds + wave * 16384);
    const int gw = F.vcu * NWAVES + wave, NGW = F.G * NWAVES;
    constexpr int I_IN = 320 * 16, I_OUT = 32 * 16, I_UP = 176 * 16, I_DN = 32 * 44, I_L = I_IN + I_OUT + I_UP + I_DN;
    for (int it = gw; it < 2 * I_L; it += NGW) {
        const int l = it / I_L; int r = it - l * I_L;
        if (r < I_IN) { const int rg = r >> 4, kb = r & 15; p0_transpose_item(A.in[5] + (size_t)l * D * PROJW, PROJW, in_src_col(32 * rg), 64 * kb, (bf16*)(A.ws + WS_WIN) + (size_t)l * PW * D, D, 32 * rg, scr, lane); continue; } r -= I_IN;
        if (r < I_OUT) { const int rg = r >> 4, kb = r & 15; p0_transpose_item(A.in[12] + (size_t)l * D * D, D, 32 * rg, 64 * kb, (bf16*)(A.ws + WS_WOUT) + (size_t)l * D * D, D, 32 * rg, scr, lane); continue; } r -= I_OUT;
        if (r < I_UP) { const int rg = r >> 4, kb = r & 15; const int row0 = 32 * rg, pn = row0 >> 8, half = (row0 >> 7) & 1, j0 = row0 & 127;
            p0_transpose_item(A.in[14] + (size_t)l * D * 2 * DFF, 2 * DFF, half * DFF + pn * 128 + j0, 64 * kb, (bf16*)(A.ws + WS_WUP) + (size_t)l * 2 * DFF * D, D, row0, scr, lane); continue; } r -= I_UP;
        { const int rg = r / 44, kb = r - rg * 44; p0_transpose_item(A.in[17] + (size_t)l * DFF * D, D, 32 * rg, 64 * kb, (bf16*)(A.ws + WS_WDN) + (size_t)l * D * DFF, DFF, 32 * rg, scr, lane); }
    }
    const int gt = F.vcu * (NWAVES * 64) + tid, NGT = F.G * NWAVES * 64;
    float* wg = (float*)(A.ws + WS_WG); float* biasp = (float*)(A.ws + WS_BIASP); float* bg = (float*)(A.ws + WS_BG); float* lb = (float*)(A.ws + WS_LB);
    for (int i = gt; i < 2 * D * 16; i += NGT) { const int g = i & 15, k = (i >> 4) & (D - 1), l = i >> 14; wg[(size_t)(l * 16 + g) * D + k] = A.in[5][((size_t)l * D + k) * PROJW + 4096 + g]; }
    for (int i = gt; i < 2 * PW; i += NGT) { const int l = i / PW, c = i - l * PW; biasp[i] = A.in[6][(size_t)l * PROJW + in_src_col(c)]; }
    for (int i = gt; i < 32; i += NGT) { const int l = i >> 4, g = i & 15; bg[i] = A.in[6][(size_t)l * PROJW + 4096 + g]; }
    for (int i = gt; i < D; i += NGT) { const float z0 = A.in[10][i], z1 = A.in[10][D + i]; lb[i] = 1.f / (1.f + expf(z0 - z1)); }
    __syncthreads();
    for (int wgi = F.vcu; wgi < 2 * (MODW / 64); wgi += F.G) {
        LAS float* cact = (LAS float*)F.lds;
        for (int i = tid; i < BATCH * D; i += NWAVES * 64) cact[i] = siluf(A.in[1][i]);
        __syncthreads();
        const int l = wgi / (MODW / 64), cg = wgi - l * (MODW / 64), col = cg * 64 + lane, kb = wave * 128;
        const float* aw = A.in[2] + (size_t)l * D * MODW + col;
        float acc[32];
#pragma unroll
        for (int b = 0; b < 32; ++b) acc[b] = 0.f;
        for (int k4 = 0; k4 < 32; ++k4) {
            const int k = kb + 4 * k4;
            const float w0 = aw[(size_t)k * MODW], w1 = aw[(size_t)(k + 1) * MODW], w2 = aw[(size_t)(k + 2) * MODW], w3 = aw[(size_t)(k + 3) * MODW];
#pragma unroll
            for (int b = 0; b < 32; ++b) { const f32x4 cv = *(const LAS f32x4*)(cact + b * D + k); acc[b] += cv.x * w0 + cv.y * w1 + cv.z * w2 + cv.w * w3; }
        }
        __syncthreads();
        LAS float* part = (LAS float*)F.lds;
#pragma unroll
        for (int b = 0; b < 32; ++b) part[(wave * 32 + b) * 64 + lane] = acc[b];
        __syncthreads();
        float* mod = (float*)(A.ws + WS_MOD);
        for (int o = tid; o < 32 * 64; o += NWAVES * 64) { const int b = o >> 6, c = o & 63; float s = 0.f;
#pragma unroll
            for (int w = 0; w < 8; ++w) s += part[(w * 32 + b) * 64 + c];
            mod[((size_t)l * BATCH + b) * MODW + cg * 64 + c] = s + A.in[3][(size_t)l * MODW + cg * 64 + c]; }
        __syncthreads();
    }
}

__device__ __forceinline__ float reduce16(float (&v)[16], int lane) {
#define R16_STEP(S, MSK) { const bool up = (lane & (MSK)) != 0; _Pragma("unroll") for (int i = 0; i < (S); ++i) { const float keep = up ? v[i + (S)] : v[i], send = up ? v[i] : v[i + (S)]; v[i] = keep + __shfl_xor(send, (MSK)); } }
    R16_STEP(8, 32) R16_STEP(4, 16) R16_STEP(2, 8) R16_STEP(1, 4)
#undef R16_STEP
    float r = v[0]; r += __shfl_xor(r, 1); r += __shfl_xor(r, 2); return r;
}
template <bool GATES>
__device__ __forceinline__ void norm_phase(Ctx& F, const float* src, const float* nw, const float* modl, int shift_off, int scale_off, bf16* hn, float* gates, const float* wgl, const float* bgl) {
    PHASE_TID();
    LAS float* wgs = (LAS float*)F.lds;
    if (GATES) { for (int i = tid; i < 16 * D / 4; i += NWAVES * 64) ((LAS f32x4*)wgs)[i] = ((const f32x4*)wgl)[i]; __syncthreads(); }
    const int gw = F.vcu * NWAVES + wave, NGW = F.G * NWAVES;
    f32x4 w[4];
#pragma unroll
    for (int j = 0; j < 4; ++j) w[j] = *(const f32x4*)(nw + 256 * j + 4 * lane);
    for (int item = gw; item < M / 32; item += NGW) {
        const int row0 = item * 32, b = row0 >> 11;
        f32x4 sc[4], sh[4];
#pragma unroll
        for (int j = 0; j < 4; ++j) { sc[j] = *(const f32x4*)(modl + (size_t)b * MODW + scale_off + 256 * j + 4 * lane); sh[j] = *(const f32x4*)(modl + (size_t)b * MODW + shift_off + 256 * j + 4 * lane);
            sc[j] = (sc[j] + 1.0f) * w[j]; }
        f32x4 xn[4];
#pragma unroll
        for (int j = 0; j < 4; ++j) xn[j] = *(const GAS f32x4*)(src + (size_t)row0 * D + 256 * j + 4 * lane);
        for (int r = 0; r < 32; ++r) {
            asm volatile("" ::: "memory");
            f32x4 x[4];
#pragma unroll
            for (int j = 0; j < 4; ++j) x[j] = xn[j];
            if (r + 1 < 32) {
#pragma unroll
                for (int j = 0; j < 4; ++j) xn[j] = *(const GAS f32x4*)(src + (size_t)(row0 + r + 1) * D + 256 * j + 4 * lane);
            }
            float ss = 0.f;
#pragma unroll
            for (int j = 0; j < 4; ++j) ss += (x[j].x * x[j].x + x[j].y * x[j].y) + (x[j].z * x[j].z + x[j].w * x[j].w);
            const float rstd = rsqrtf(wave_sum(ss) * (1.f / D) + RMS_EPS);
#pragma unroll
            for (int j = 0; j < 4; ++j) x[j] = x[j] * rstd * sc[j] + sh[j];
            GAS unsigned long long* o8 = (GAS unsigned long long*)(hn + (size_t)(row0 + r) * D) + lane;
#pragma unroll
            for (int j = 0; j < 4; ++j) o8[64 * j] = (unsigned long long)pk2(x[j].x, x[j].y) | ((unsigned long long)pk2(x[j].z, x[j].w) << 32);
            if (GATES) {
                float a[16];
#pragma unroll
                for (int g = 0; g < 16; ++g) { float s = 0.f;
#pragma unroll
                    for (int j = 0; j < 4; ++j) { const f32x4 wv = *(const LAS f32x4*)(wgs + g * D + 256 * j + 4 * lane); s += (x[j].x * wv.x + x[j].y * wv.y) + (x[j].z * wv.z + x[j].w * wv.w); }
                    a[g] = s; }
                const float tot = reduce16(a, lane);
                const int g = ((lane >> 5) & 1) * 8 + ((lane >> 4) & 1) * 4 + ((lane >> 3) & 1) * 2 + ((lane >> 2) & 1);
                if ((lane & 3) == 0) gates[(size_t)(row0 + r) * 16 + g] = tot + bgl[g];
            }
        }
    }
}
__device__ __forceinline__ void final_norm_phase(Ctx& F, float* x, const float* nw) {
    PHASE_TID();
    const int gw = F.vcu * NWAVES + wave, NGW = F.G * NWAVES;
    f32x4 w[4];
#pragma unroll
    for (int j = 0; j < 4; ++j) w[j] = *(const f32x4*)(nw + 256 * j + 4 * lane);
    for (int row = gw; row < M; row += NGW) {
        GAS f32x4* xr = (GAS f32x4*)(x + (size_t)row * D) + lane;
        f32x4 v[4]; float ss = 0.f;
#pragma unroll
        for (int j = 0; j < 4; ++j) { v[j] = xr[64 * j]; ss += (v[j].x * v[j].x + v[j].y * v[j].y) + (v[j].z * v[j].z + v[j].w * v[j].w); }
        const float rstd = rsqrtf(wave_sum(ss) * (1.f / D) + RMS_EPS);
#pragma unroll
        for (int j = 0; j < 4; ++j) xr[64 * j] = v[j] * rstd * w[j];
    }
}

__device__ __forceinline__ void ffn_glu_phase(Ctx& F, const bf16* u, bf16* g, const float* cw, const float* cb) {
    PHASE_TID();
    constexpr int RB = 16, NCH = DFF / 8, NRB = FROWS / RB;
    const int gt = F.vcu * (NWAVES * 64) + tid, NGT = F.G * NWAVES * 64;
    for (int it = gt; it < NRB * NCH; it += NGT) {
        const int rb = it / NCH, ch = it - rb * NCH, f0 = ch * 8, row0 = rb * RB;
        const int cg0 = (f0 >> 7) * 256 + (f0 & 127);
        float wg_[3][8], wv_[3][8], bgv[8], bvv[8];
#pragma unroll
        for (int j = 0; j < 3; ++j)
#pragma unroll
            for (int e = 0; e < 8; ++e) { wg_[j][e] = cw[(size_t)j * 2 * DFF + f0 + e]; wv_[j][e] = cw[(size_t)j * 2 * DFF + DFF + f0 + e]; }
#pragma unroll
        for (int e = 0; e < 8; ++e) { bgv[e] = cb[f0 + e]; bvv[e] = cb[DFF + f0 + e]; }
        float g1[8], g2[8], v1[8], v2[8];
        const int t0 = row0 & (SEQ - 1);
#pragma unroll
        for (int e = 0; e < 8; ++e) { g1[e] = g2[e] = v1[e] = v2[e] = 0.f; }
        if (t0 >= 2) {
            const v4u a1 = *(const GAS v4u*)(u + (size_t)(row0 - 1) * 2 * DFF + cg0), a2 = *(const GAS v4u*)(u + (size_t)(row0 - 2) * 2 * DFF + cg0);
            const v4u b1 = *(const GAS v4u*)(u + (size_t)(row0 - 1) * 2 * DFF + cg0 + 128), b2 = *(const GAS v4u*)(u + (size_t)(row0 - 2) * 2 * DFF + cg0 + 128);
#pragma unroll
            for (int e = 0; e < 4; ++e) { g1[2 * e] = bf2f(a1[e] & 0xffff); g1[2 * e + 1] = bf2f(a1[e] >> 16); g2[2 * e] = bf2f(a2[e] & 0xffff); g2[2 * e + 1] = bf2f(a2[e] >> 16);
                v1[2 * e] = bf2f(b1[e] & 0xffff); v1[2 * e + 1] = bf2f(b1[e] >> 16); v2[2 * e] = bf2f(b2[e] & 0xffff); v2[2 * e + 1] = bf2f(b2[e] >> 16); }
        }
        for (int r = 0; r < RB; ++r) {
            const v4u a0 = *(const GAS v4u*)(u + (size_t)(row0 + r) * 2 * DFF + cg0), b0 = *(const GAS v4u*)(u + (size_t)(row0 + r) * 2 * DFF + cg0 + 128);
            float g0[8], v0[8], o[8];
#pragma unroll
            for (int e = 0; e < 4; ++e) { g0[2 * e] = bf2f(a0[e] & 0xffff); g0[2 * e + 1] = bf2f(a0[e] >> 16); v0[2 * e] = bf2f(b0[e] & 0xffff); v0[2 * e + 1] = bf2f(b0[e] >> 16); }
#pragma unroll
            for (int e = 0; e < 8; ++e) { const float cgv = bgv[e] + wg_[2][e] * g0[e] + wg_[1][e] * g1[e] + wg_[0][e] * g2[e]; const float cvv = bvv[e] + wv_[2][e] * v0[e] + wv_[1][e] * v1[e] + wv_[0][e] * v2[e];
                o[e] = siluf(cgv) * cvv; g2[e] = g1[e]; g1[e] = g0[e]; v2[e] = v1[e]; v1[e] = v0[e]; }
            v4u w; w.x = pk2(o[0], o[1]); w.y = pk2(o[2], o[3]); w.z = pk2(o[4], o[5]); w.w = pk2(o[6], o[7]);
            *(GAS v4u*)(g + (size_t)(row0 + r) * DFF + f0) = w;
        }
    }
}

constexpr int IMG_QM = 0, IMG_KM = 16384, IMG_VM = 32768, IMG_P = 49152, IMG_HQT = 57344, IMG_HKT = 73728, IMG_HQE = 90112, IMG_HKD = 106496, IMG_HV = 122880, PH_OFF = 139264, MF_OFF = 143360;
constexpr int MF_N = 0, MF_DFL = 128, MF_QN = 192, MF_RS = 256, MF_SSA = 384, MF_SSB = 896, MF_NRED = 1408, MF_DECH = 2432, MF_CW = 2944, MF_END = 4224;
static_assert(MF_OFF + MF_END * 4 <= MISC_OFF, "mixer LDS map");
typedef short s16x4 __attribute__((ext_vector_type(4)));
typedef short v4i16_t __attribute__((ext_vector_type(4)));
__device__ __forceinline__ unsigned offb(unsigned row, unsigned ch) { return 256u * row + 16u * (ch ^ (((row & 3u) << 2) | ((row >> 2) & 3u))); }
__device__ __forceinline__ bf16x8 ld16(LAS unsigned char* p) { return *(const LAS bf16x8*)p; }
__device__ __forceinline__ s16x4 ld8(LAS unsigned char* p) { return *(const LAS s16x4*)p; }
__device__ __forceinline__ s16x4 ldtr(LAS unsigned char* p) { return __builtin_bit_cast(s16x4, __builtin_amdgcn_ds_read_tr16_b64_v4i16((LAS v4i16_t*)p)); }
__device__ __forceinline__ bf16x8 cat8(s16x4 a, s16x4 b) { bf16x8 r; r[0] = a[0]; r[1] = a[1]; r[2] = a[2]; r[3] = a[3]; r[4] = b[0]; r[5] = b[1]; r[6] = b[2]; r[7] = b[3]; return r; }
__device__ __forceinline__ bf16x8 frag_row(LAS unsigned char* img, int row0, int ks, int lane) { return ld16(img + offb(row0 + (lane & 15), 4 * ks + (lane >> 4))); }
__device__ __forceinline__ bf16x8 frag_tr(LAS unsigned char* img, int row0, int c, int lane, int rmask) {
    const int g = lane >> 4, qq = (lane & 15) >> 2, p = lane & 3;
    const int r0 = row0 + ((8 * g + qq) & rmask), r1 = row0 + ((8 * g + 4 + qq) & rmask);
    return cat8(ldtr(img + offb(r0, 2 * c + (p >> 1)) + 8 * (p & 1)), ldtr(img + offb(r1, 2 * c + (p >> 1)) + 8 * (p & 1)));
}
__device__ __forceinline__ bf16x8 frag_q2(LAS unsigned char* img, int row0, int ks, int lane) {
    const int r = lane & 15, q = lane >> 4;
    return cat8(ld8(img + offb(row0 + r, 4 * ks + (q >> 1)) + 8 * (q & 1)), ld8(img + offb(row0 + r, 4 * ks + 2 + (q >> 1)) + 8 * (q & 1)));
}
__device__ __forceinline__ bf16x8 pack_acc(const f32x4& lo, const f32x4& hi) {
    v4u w; w.x = pg8::cvt_pk_bf16(lo[0], lo[1]); w.y = pg8::cvt_pk_bf16(lo[2], lo[3]); w.z = pg8::cvt_pk_bf16(hi[0], hi[1]); w.w = pg8::cvt_pk_bf16(hi[2], hi[3]);
    return __builtin_bit_cast(bf16x8, w);
}
__device__ __forceinline__ f32x4 mfma16(const bf16x8& a, const bf16x8& b, const f32x4& c) { return __builtin_amdgcn_mfma_f32_16x16x32_bf16(a, b, c, 0, 0, 0); }
__device__ __forceinline__ void unpack8(const v4u& v, float (&o)[8]) {
#pragma unroll
    for (int e = 0; e < 4; ++e) { o[2 * e] = bf2f((unsigned short)(v[e] & 0xffffu)); o[2 * e + 1] = bf2f((unsigned short)(v[e] >> 16)); }
}

#define LN_FRESH(name) int name = lane; asm volatile("" : "+v"(name))
__device__ __forceinline__ void mixer_fast_phase(Ctx& F, int layer, int seg) {
    PHASE_TID(); const int tid_p = tid, lane_p = lane;
    ARGS();
    const bf16* Pcur = (const bf16*)(A.ws + WS_P + (size_t)(seg & 1) * P_BYTES);
    const bf16* Pprev = (const bf16*)(A.ws + WS_P + (size_t)((seg & 1) ^ 1) * P_BYTES);
    const float* gates = (const float*)(A.ws + WS_GATES);
    const float* lbp = (const float*)(A.ws + WS_LB);
    bf16* Y = (bf16*)(A.ws + WS_Y);
    float* stC = (float*)(A.ws + WS_STC); float* stS = (float*)(A.ws + WS_STS); float* stN = (float*)(A.ws + WS_STN); float* stM = (float*)(A.ws + WS_STM);
    const float* cw = A.in[7] + (size_t)layer * 4 * 2048; const float* cb = A.in[8] + (size_t)layer * 2048;
    LAS unsigned char* L = F.lds;
    LAS float* MF = (LAS float*)(L + MF_OFF);
    for (int bh = blockIdx.x; bh < BATCH * NH; bh += F.G) {
        const int b = bh >> 3, h = bh & 7;
        const int r0_ = lane & 15;
        const float mnw_r = A.in[9][(size_t)layer * D + h * 128 + 16 * wave + r0_], hnw_r = A.in[11][(size_t)layer * D + h * 128 + 16 * wave + r0_];
        for (int i = tid; i < 1280; i += NWAVES * 64) { const int blk = i / 640, j = (i % 640) >> 7, e = i & 127; MF[MF_CW + i] = j < 4 ? cw[(size_t)j * 2048 + blk * 1024 + h * 128 + e] : cb[blk * 1024 + h * 128 + e]; }
        for (int i = tid; i < 1024; i += NWAVES * 64) ((LAS unsigned*)(L + PH_OFF))[i] = 0u;
        f32x4 Cacc[8], Sacc[8]; float mst;
        if (seg == 0) {
#pragma unroll
            for (int mb = 0; mb < 8; ++mb) { Cacc[mb] = (f32x4){0.f, 0.f, 0.f, 0.f}; Sacc[mb] = (f32x4){0.f, 0.f, 0.f, 0.f}; }
            mst = 0.f; if (tid < 128) MF[MF_N + tid] = 0.f;
        } else {
#pragma unroll
            for (int mb = 0; mb < 8; ++mb)
#pragma unroll
                for (int e = 0; e < 4; ++e) { Cacc[mb][e] = stC[((size_t)(bh * 8 + wave) * 32 + mb * 4 + e) * 64 + lane]; Sacc[mb][e] = stS[((size_t)(bh * 8 + wave) * 32 + mb * 4 + e) * 64 + lane]; }
            mst = stM[bh]; if (tid < 128) MF[MF_N + tid] = stN[bh * 128 + tid];
        }
        __syncthreads();
        for (int c = 0; c < SEGT / 64; ++c) {
            const int tl0 = 64 * c; const size_t grow0 = (size_t)b * SEQ + seg * SEGT + tl0;
            int tid = tid_p, lane = lane_p; asm volatile("" : "+v"(tid), "+v"(lane));
            const int r = lane & 15, q = lane >> 4;
            float rowfac, decay, mnext;
            {
                const float li = softcap15(gates[(grow0 + lane) * 16 + h]), lf = logsigm(softcap15(gates[(grow0 + lane) * 16 + 8 + h]));
                float bc = lf;
#pragma unroll
                for (int d = 1; d < 64; d <<= 1) { const float t = __shfl_up(bc, d); if (lane >= d) bc += t; }
                const float a = li - bc; float am = a;
#pragma unroll
                for (int o = 1; o < 64; o <<= 1) am = fmaxf(am, __shfl_xor(am, o));
                const float abar = fmaxf(mst, am);
                rowfac = expf(a - abar) * 0.08838834764831845f;
                decay = expf(mst - abar); mnext = __shfl(bc, 63) + abar;
                if (wave == 0) MF[MF_DFL + lane] = expf(-(bc + abar));
            }
#pragma unroll
            for (int pass = 0; pass < 2; ++pass) {
                const int t = (tid >> 4) + 32 * pass, ch = tid & 15, tl = tl0 + t;
                const float rf = __shfl(rowfac, t);
                const bf16* pr0 = Pcur + (size_t)(b * SEGT + tl) * PW + h * HB + ch * 8;
#pragma unroll
                for (int blk = 0; blk < 2; ++blk) {
                    float acc[8];
                    { const f32x4 b0 = *(const LAS f32x4*)(MF + MF_CW + blk * 640 + 512 + ch * 8), b1 = *(const LAS f32x4*)(MF + MF_CW + blk * 640 + 512 + ch * 8 + 4);
                      acc[0] = b0[0]; acc[1] = b0[1]; acc[2] = b0[2]; acc[3] = b0[3]; acc[4] = b1[0]; acc[5] = b1[1]; acc[6] = b1[2]; acc[7] = b1[3]; }
#pragma unroll
                    for (int j = 0; j < 4; ++j) {
                        const int tq = tl - 3 + j;
                        if (seg * SEGT + tq >= 0) {
                            const bf16* prj = tq >= 0 ? Pcur + (size_t)(b * SEGT + tq) * PW : Pprev + (size_t)(b * SEGT + SEGT + tq) * PW;
                            const v4u raw = *(const GAS v4u*)(prj + h * HB + blk * 128 + ch * 8);
                            float x[8]; unpack8(raw, x);
                            const f32x4 w0 = *(const LAS f32x4*)(MF + MF_CW + blk * 640 + j * 128 + ch * 8), w1 = *(const LAS f32x4*)(MF + MF_CW + blk * 640 + j * 128 + ch * 8 + 4);
#pragma unroll
                            for (int e = 0; e < 4; ++e) { acc[e] += w0[e] * x[e]; acc[4 + e] += w1[e] * x[4 + e]; }
                        }
                    }
                    const float sc = blk == 0 ? 1.f : rf;
                    v4u o; o.x = pk2(siluf(acc[0]) * sc, siluf(acc[1]) * sc); o.y = pk2(siluf(acc[2]) * sc, siluf(acc[3]) * sc); o.z = pk2(siluf(acc[4]) * sc, siluf(acc[5]) * sc); o.w = pk2(siluf(acc[6]) * sc, siluf(acc[7]) * sc);
                    *(LAS v4u*)(L + (blk == 0 ? IMG_QM : IMG_KM) + offb(t, ch)) = o;
                }
                *(LAS v4u*)(L + IMG_VM + offb(t, ch)) = *(const GAS v4u*)(pr0 + 256);
                *(LAS v4u*)(L + IMG_HV + offb(t, ch)) = *(const GAS v4u*)(pr0 + 768);
                asm volatile("" ::: "memory");
            }
            {
                const int k = tid & 127, j = tid >> 7;
                const bf16* pr = Pcur + (size_t)(b * SEGT + tl0 + 16 * j) * PW + h * HB + k;
                unsigned short hqr[16], hfr[16];
#pragma unroll
                for (int tt = 0; tt < 16; ++tt) { hqr[tt] = pr[(size_t)tt * PW + 512]; hfr[tt] = pr[(size_t)tt * PW + 640]; }
                const float lb = layer == 0 ? 0.f : lbp[h * 128 + k];
                float ac[16], kkv[16], qv[16]; float run = 0.f;
#pragma unroll
                for (int tt = 0; tt < 16; ++tt) { const float sg = sigm(bf2f(hfr[tt])); run += __logf(lb + (1.f - lb) * sg); ac[tt] = run; kkv[tt] = (1.f - lb) * (1.f - sg); qv[tt] = siluf(bf2f(hqr[tt])); }
                const float A7 = ac[7], A15 = ac[15], E7 = __expf(A7), E157 = __expf(A15 - A7);
                const unsigned cb2 = 2 * (k & 7);
#pragma unroll
                for (int tt = 0; tt < 16; ++tt) {
                    const float qt = qv[tt] * __expf(ac[tt] - A7), kt = kkv[tt] * __expf(A7 - ac[tt]);
                    const unsigned o = offb(16 * j + tt, k >> 3) + cb2;
                    *(LAS unsigned short*)(L + IMG_HQT + o) = (unsigned short)f2bf(qt); *(LAS unsigned short*)(L + IMG_HKT + o) = (unsigned short)f2bf(kt);
                    *(LAS unsigned short*)(L + IMG_HQE + o) = (unsigned short)f2bf(qt * E7); *(LAS unsigned short*)(L + IMG_HKD + o) = (unsigned short)f2bf(kt * E157);
                }
                MF[MF_DECH + j * 128 + k] = __expf(A15);
            }
            __syncthreads();
            {
                const int tb = wave >> 1; float psum = 0.f;
#pragma unroll
                for (int s2 = 0; s2 < 2; ++s2) {
                    const int sb = 2 * (wave & 1) + s2; LN_FRESH(ln);
                    f32x4 acc = (f32x4){0.f, 0.f, 0.f, 0.f};
#pragma unroll
                    for (int ks = 0; ks < 4; ++ks) acc = mfma16(frag_row(L + IMG_KM, 16 * sb, ks, ln), frag_row(L + IMG_QM, 16 * tb, ks, ln), acc);
                    const int t = 16 * tb + r, s0 = 16 * sb + 4 * q;
                    float v[4];
#pragma unroll
                    for (int e = 0; e < 4; ++e) { v[e] = (s0 + e <= t) ? acc[e] : 0.f; psum += v[e]; }
                    v2u w; w.x = pk2(v[0], v[1]); w.y = pk2(v[2], v[3]);
                    *(LAS v2u*)(L + IMG_P + 128 * t + 16 * ((2 * sb + (q >> 1)) ^ (t & 7)) + 8 * (q & 1)) = w;
                }
                psum += __shfl_xor(psum, 16); psum += __shfl_xor(psum, 32);
                if (q == 0) MF[MF_RS + 2 * (16 * tb + r) + (wave & 1)] = psum;
            }
            {
                const int t = tid >> 3, part = tid & 7;
                const v4u a0 = *(const LAS v4u*)(L + IMG_QM + offb(t, 2 * part)), a1 = *(const LAS v4u*)(L + IMG_QM + offb(t, 2 * part + 1));
                float x0[8], x1[8]; unpack8(a0, x0); unpack8(a1, x1);
                float d = 0.f;
#pragma unroll
                for (int e4 = 0; e4 < 2; ++e4) { const f32x4 n0 = *(const LAS f32x4*)(MF + MF_N + 16 * part + 4 * e4), n1 = *(const LAS f32x4*)(MF + MF_N + 16 * part + 8 + 4 * e4);
#pragma unroll
                    for (int e = 0; e < 4; ++e) { d += x0[4 * e4 + e] * n0[e]; d += x1[4 * e4 + e] * n1[e]; } }
                d += __shfl_xor(d, 1); d += __shfl_xor(d, 2); d += __shfl_xor(d, 4);
                if (part == 0) MF[MF_QN + t] = d;
            }
            if (wave >= 4) {
                const int j = wave - 4; LN_FRESH(ln);
                f32x4 acc = (f32x4){0.f, 0.f, 0.f, 0.f};
#pragma unroll
                for (int ks = 0; ks < 4; ++ks) acc = mfma16(frag_row(L + IMG_HKT, 16 * j, ks, ln), frag_row(L + IMG_HQT, 16 * j, ks, ln), acc);
                float v[4];
#pragma unroll
                for (int e = 0; e < 4; ++e) v[e] = (4 * q + e <= r) ? acc[e] : 0.f;
                v2u w; w.x = pk2(v[0], v[1]); w.y = pk2(v[2], v[3]);
                *(LAS v2u*)(L + PH_OFF + j * 1024 + r * 64 + 8 * q) = w;
            }
            __syncthreads();
            f32x4 hval[4], oacc[4];
            {
                f32x4 Cd[8];
#pragma unroll
                for (int mb = 0; mb < 8; ++mb) Cd[mb] = Cacc[mb] * decay;
                bf16x8 bC[4], bV[2];
#pragma unroll
                for (int ks = 0; ks < 4; ++ks) bC[ks] = pack_acc(Cd[2 * ks], Cd[2 * ks + 1]);
#pragma unroll
                for (int ks = 0; ks < 2; ++ks) { LN_FRESH(ln); bV[ks] = frag_tr(L + IMG_VM, 32 * ks, wave, ln, 31); }
#pragma unroll
                for (int mt = 0; mt < 4; ++mt) {
                    f32x4 acc = (f32x4){0.f, 0.f, 0.f, 0.f}; LN_FRESH(ln);
#pragma unroll
                    for (int ks = 0; ks < 4; ++ks) acc = mfma16(frag_q2(L + IMG_QM, 16 * mt, ks, ln), bC[ks], acc);
#pragma unroll
                    for (int ks = 0; ks < 2; ++ks) { const int t = 16 * mt + r; acc = mfma16(ld16(L + IMG_P + 128 * t + 16 * ((4 * ks + q) ^ (t & 7))), bV[ks], acc); }
                    const int t0 = 16 * mt + 4 * q;
                    const f32x4 r0 = *(const LAS f32x4*)(MF + MF_RS + 2 * t0), r1 = *(const LAS f32x4*)(MF + MF_RS + 2 * t0 + 4), qn4 = *(const LAS f32x4*)(MF + MF_QN + t0), df4 = *(const LAS f32x4*)(MF + MF_DFL + t0);
                    const float den0 = r0[0] + r0[1] + decay * qn4[0], den1 = r0[2] + r0[3] + decay * qn4[1], den2 = r1[0] + r1[1] + decay * qn4[2], den3 = r1[2] + r1[3] + decay * qn4[3];
                    hval[mt][0] = acc[0] / fmaxf(fabsf(den0), df4[0]); hval[mt][1] = acc[1] / fmaxf(fabsf(den1), df4[1]); hval[mt][2] = acc[2] / fmaxf(fabsf(den2), df4[2]); hval[mt][3] = acc[3] / fmaxf(fabsf(den3), df4[3]);
                }
#pragma unroll
                for (int mb = 0; mb < 8; ++mb) {
                    f32x4 acc = Cd[mb]; LN_FRESH(ln);
#pragma unroll
                    for (int ks = 0; ks < 2; ++ks) acc = mfma16(frag_tr(L + IMG_KM, 32 * ks, mb, ln, 31), bV[ks], acc);
                    Cacc[mb] = acc;
                }
                {
                    const int ch = tid & 15, sg = tid >> 4;
                    const v4u a0 = *(const LAS v4u*)(L + IMG_KM + offb(2 * sg, ch)), a1 = *(const LAS v4u*)(L + IMG_KM + offb(2 * sg + 1, ch));
                    float x0[8], x1[8]; unpack8(a0, x0); unpack8(a1, x1);
                    float ps[8];
#pragma unroll
                    for (int e = 0; e < 8; ++e) { ps[e] = x0[e] + x1[e]; ps[e] += __shfl_xor(ps[e], 16); ps[e] += __shfl_xor(ps[e], 32); }
                    if (lane < 16) { *(LAS f32x4*)(MF + MF_NRED + wave * 128 + 8 * ch) = (f32x4){ps[0], ps[1], ps[2], ps[3]}; *(LAS f32x4*)(MF + MF_NRED + wave * 128 + 8 * ch + 4) = (f32x4){ps[4], ps[5], ps[6], ps[7]}; }
                }
            }
#pragma unroll
            for (int j = 0; j < 4; ++j) {
                bf16x8 bS[4];
#pragma unroll
                for (int ks = 0; ks < 4; ++ks) bS[ks] = pack_acc(Sacc[2 * ks], Sacc[2 * ks + 1]);
#pragma unroll
                for (int mb = 0; mb < 8; ++mb) Sacc[mb] = Sacc[mb] * *(const LAS f32x4*)(MF + MF_DECH + j * 128 + 16 * mb + 4 * q);
                f32x4 acc = (f32x4){0.f, 0.f, 0.f, 0.f};
                { LN_FRESH(ln);
#pragma unroll
                for (int ks = 0; ks < 4; ++ks) acc = mfma16(frag_q2(L + IMG_HQE, 16 * j, ks, ln), bS[ks], acc); }
                LN_FRESH(ln2);
                const bf16x8 bVh = frag_tr(L + IMG_HV, 16 * j, wave, ln2, 15);
                acc = mfma16(ld16(L + PH_OFF + j * 1024 + r * 64 + 16 * q), bVh, acc);
                oacc[j] = acc;
#pragma unroll
                for (int mb = 0; mb < 8; ++mb) {
                    LN_FRESH(ln3);
                    bf16x8 aK = frag_tr(L + IMG_HKD, 16 * j, mb, ln3, 15);
                    if (q >= 2) aK = (bf16x8){0, 0, 0, 0, 0, 0, 0, 0};
                    Sacc[mb] = mfma16(aK, bVh, Sacc[mb]);
                }
            }
            {
#pragma unroll
                for (int mt = 0; mt < 4; ++mt)
#pragma unroll
                    for (int e = 0; e < 4; ++e) {
                        float sa = hval[mt][e] * hval[mt][e], sb = oacc[mt][e] * oacc[mt][e];
#pragma unroll
                        for (int o = 1; o < 16; o <<= 1) { sa += __shfl_xor(sa, o); sb += __shfl_xor(sb, o); }
                        if (r == 0) { MF[MF_SSA + (16 * mt + 4 * q + e) * 8 + wave] = sa; MF[MF_SSB + (16 * mt + 4 * q + e) * 8 + wave] = sb; }
                    }
            }
            __syncthreads();
            if (tid < 128) { float s = decay * MF[MF_N + tid];
#pragma unroll
                for (int w = 0; w < 8; ++w) s += MF[MF_NRED + w * 128 + tid];
                MF[MF_N + tid] = s; }
#pragma unroll
            for (int mt = 0; mt < 4; ++mt)
#pragma unroll
                for (int e = 0; e < 4; ++e) {
                    const int t = 16 * mt + 4 * q + e, dvc = 16 * wave + r;
                    const f32x4 a0 = *(const LAS f32x4*)(MF + MF_SSA + t * 8), a1 = *(const LAS f32x4*)(MF + MF_SSA + t * 8 + 4), b0 = *(const LAS f32x4*)(MF + MF_SSB + t * 8), b1 = *(const LAS f32x4*)(MF + MF_SSB + t * 8 + 4);
                    const float ra = rsqrtf(((a0[0] + a0[1]) + (a0[2] + a0[3]) + (a1[0] + a1[1]) + (a1[2] + a1[3])) * (1.f / 128.f) + RMS_EPS);
                    const float rb = rsqrtf(((b0[0] + b0[1]) + (b0[2] + b0[3]) + (b1[0] + b1[1]) + (b1[2] + b1[3])) * (1.f / 128.f) + RMS_EPS);
                    const bf16* pr = Pcur + (size_t)(b * SEGT + tl0 + t) * PW + h * HB + dvc;
                    const float ya = hval[mt][e] * ra * mnw_r * sigm(bf2f(pr[384]));
                    const float yb = oacc[mt][e] * rb * hnw_r * siluf(bf2f(pr[896]));
                    const float y = sigm(bf2f(pr[1024])) * ya + sigm(bf2f(pr[1152])) * yb;
                    Y[(grow0 + t) * D + h * 128 + dvc] = (bf16)f2bf(y);
                    if (e == 3) asm volatile("" ::: "memory");
                }
            mst = mnext;
        }
        int lane_s = lane_p; asm volatile("" : "+v"(lane_s));
#pragma unroll
        for (int mb = 0; mb < 8; ++mb)
#pragma unroll
            for (int e = 0; e < 4; ++e) { stC[((size_t)(bh * 8 + wave) * 32 + mb * 4 + e) * 64 + lane_s] = Cacc[mb][e]; stS[((size_t)(bh * 8 + wave) * 32 + mb * 4 + e) * 64 + lane_s] = Sacc[mb][e]; }
        __syncthreads();
        if (tid < 128) stN[bh * 128 + tid] = MF[MF_N + tid];
        if (tid == 0) stM[bh] = mst;
        __syncthreads();
    }
}

__global__ void __launch_bounds__(NWAVES * 64, 2) fwd_kernel(Args kernel_args_unused) {
    extern __shared__ __attribute__((aligned(16))) unsigned char lds[];
    Ctx F;
    F.lds = (LAS unsigned char*)lds;
    F.wave_s = __builtin_amdgcn_readfirstlane(threadIdx.x >> 6);
    F.G = gridDim.x; { const int bx = blockIdx.x; F.vcu = (F.G % 8 == 0) ? (bx % 8) * (F.G / 8) + bx / 8 : bx; }
    volatile LAS unsigned* MISC = (volatile LAS unsigned*)(F.lds + MISC_OFF);
    if (threadIdx.x < 64) MISC[threadIdx.x] = 0u;
    __syncthreads();
    unsigned bar_x;
    { ARGS(); const XcdBarrier b0 = xcd_barrier_post((unsigned*)((gu32*)(A.ws + WS_CTL) + CW_BAR), MISC + 8); bar_x = b0.x; }
#define GRID_BAR() do { ARGS(); XcdBarrier bb; bb.bar = (unsigned*)((gu32*)(A.ws + WS_CTL) + CW_BAR); bb.x = bar_x; asm volatile("" : "+s"(bb.x)); bb.st = (volatile LAS unsigned*)(F.lds + MISC_OFF) + 8; xcd_barrier(bb); } while (0)

    p0_prologue(F);
    GRID_BAR();

    for (int layer = 0; layer < DEPTH; ++layer) {
#define PHASE_PTRS() ARGS(); const float* src = layer == 0 ? A.in[0] : (const float*)A.out; const float* modl = (const float*)(A.ws + WS_MOD) + (size_t)layer * BATCH * MODW; bf16* hn = (bf16*)(A.ws + WS_HN); (void)src; (void)modl; (void)hn
        { PHASE_PTRS();
        norm_phase<true>(F, src, A.in[4] + (size_t)layer * D, modl, 0, D, hn, (float*)(A.ws + WS_GATES), (const float*)(A.ws + WS_WG) + (size_t)layer * 16 * D, (const float*)(A.ws + WS_BG) + layer * 16); }
        GRID_BAR();
        for (int seg = 0; seg < NSEG; ++seg) {
            {
                PHASE_PTRS();
                pg8::Gemm g{hn, (const bf16*)(A.ws + WS_WIN) + (size_t)layer * PW * D, SEGROWS, PW, D, NSEG, seg};
                pg8::StaticOrder S; S.init(SEGROWS, PW, F.G, (int)blockIdx.x);
                pg8::EpiBf16B E{(bf16*)(A.ws + WS_P + (size_t)(seg & 1) * P_BYTES), PW, (const float*)(A.ws + WS_BIASP) + (size_t)layer * PW};
                pg8::gemm_phase<pg8::EpiBf16B, pg8::StaticOrder, PG8_ALIGN, PG8_SP2>(F.lds + RING_OFF, g, S, E, F.wave_s);
            }
            GRID_BAR();
            mixer_fast_phase(F, layer, seg);
            GRID_BAR();
        }
        {
            PHASE_PTRS();
            pg8::Gemm g{(const bf16*)(A.ws + WS_Y), (const bf16*)(A.ws + WS_WOUT) + (size_t)layer * D * D, M, D, D, 1, 0};
            pg8::StaticOrder S; S.init(M, D, F.G, (int)blockIdx.x);
            pg8::EpiResid E{src, A.out, D, modl + 2 * D, MODW, 0};
            pg8::gemm_phase<pg8::EpiResid, pg8::StaticOrder, PG8_ALIGN, PG8_SP2>(F.lds + RING_OFF, g, S, E, F.wave_s);
        }
        GRID_BAR();
        { PHASE_PTRS();
        norm_phase<false>(F, (const float*)A.out, A.in[13] + (size_t)layer * D, modl, 3 * D, 4 * D, hn, nullptr, nullptr, nullptr); }
        GRID_BAR();
        for (int fs = 0; fs < FSEG; ++fs) {
            {
                PHASE_PTRS();
                pg8::Gemm g{hn + (size_t)fs * FROWS * D, (const bf16*)(A.ws + WS_WUP) + (size_t)layer * 2 * DFF * D, FROWS, 2 * DFF, D, 1, 0};
                pg8::StaticOrder S; S.init(FROWS, 2 * DFF, F.G, (int)blockIdx.x);
                pg8::EpiBf16B E{(bf16*)(A.ws + WS_U), 2 * DFF, nullptr};
                pg8::gemm_phase<pg8::EpiBf16B, pg8::StaticOrder, PG8_ALIGN, PG8_SP2>(F.lds + RING_OFF, g, S, E, F.wave_s);
            }
            GRID_BAR();
            { ARGS(); ffn_glu_phase(F, (const bf16*)(A.ws + WS_U), (bf16*)(A.ws + WS_G), A.in[15] + (size_t)layer * 3 * 2 * DFF, A.in[16] + (size_t)layer * 2 * DFF); }
            GRID_BAR();
            {
                PHASE_PTRS();
                pg8::Gemm g{(const bf16*)(A.ws + WS_G), (const bf16*)(A.ws + WS_WDN) + (size_t)layer * D * DFF, FROWS, D, DFF, 1, 0};
                pg8::StaticOrder S; S.init(FROWS, D, F.G, (int)blockIdx.x);
                pg8::EpiResid E{(const float*)A.out, A.out, D, modl + 5 * D, MODW, fs * FROWS};
                pg8::gemm_phase<pg8::EpiResid, pg8::StaticOrder, PG8_ALIGN, PG8_SP2>(F.lds + RING_OFF, g, S, E, F.wave_s);
            }
            GRID_BAR();
        }
    }
    { ARGS(); final_norm_phase(F, A.out, A.in[18]); }
#undef GRID_BAR
}

extern "C" void kernel_launch(void* const* d_in, const int* in_sizes, int n_in, void* d_out, int out_size, void* d_ws, size_t ws_size, hipStream_t stream) {
    static int grid = 0;
    if (grid == 0) {
        if (n_in != 19 || in_sizes[0] != M * D || out_size != M * D || ws_size < WS_END) { fprintf(stderr, "kernel_launch: unexpected shapes (n_in %d, in0 %d, out %d, ws %zu; need ws >= %zu); nothing launched\n", n_in, n_in > 0 ? in_sizes[0] : -1, out_size, ws_size, (size_t)WS_END); grid = -1; return; }
        int dev = 0, cus = 0, per_cu = 0;
        if (hipGetDevice(&dev) != hipSuccess || hipDeviceGetAttribute(&cus, hipDeviceAttributeMultiprocessorCount, dev) != hipSuccess) { grid = -1; return; }
        if (hipFuncSetAttribute((const void*)fwd_kernel, hipFuncAttributeMaxDynamicSharedMemorySize, LDS_BYTES) != hipSuccess) { fprintf(stderr, "kernel_launch: hipFuncSetAttribute failed\n"); grid = -1; return; }
        if (hipOccupancyMaxActiveBlocksPerMultiprocessor(&per_cu, (const void*)fwd_kernel, NWAVES * 64, LDS_BYTES) != hipSuccess || per_cu < 1)
            fprintf(stderr, "kernel_launch: note: occupancy query reports %d workgroups per CU\n", per_cu);
        (void)hipGetLastError();
        grid = cus;
    }
    if (grid < 0) return;
    if (hipMemsetAsync((char*)d_ws + WS_CTL, 0, CTL_ZERO_BYTES, stream) != hipSuccess) return;
    Args a{};
    for (int i = 0; i < 19; ++i) a.in[i] = (const float*)d_in[i];
    a.out = (float*)d_out; a.ws = (unsigned char*)d_ws;
    hipLaunchKernelGGL(fwd_kernel, dim3(grid), dim3(NWAVES * 64), LDS_BYTES, stream, a);
}
```

```cpp
#include <hip/hip_runtime.h>
#include <cstdio>
#include <cstdint>
namespace pg8 {
#define PG8_LAS __attribute__((address_space(3)))
typedef unsigned short bf16_t;
typedef short bf16x8 __attribute__((ext_vector_type(8)));
typedef float f32x4 __attribute__((ext_vector_type(4)));
typedef unsigned u32x4 __attribute__((ext_vector_type(4)));
constexpr int BM = 256, BK = 64, HALF = 128, HTB = HALF * BK * 2  , STAGE_BYTES = 8 * HTB, NXCD = 8, WGM = 8;

__host__ __device__ __forceinline__ int lds_byte(int r, int c) { const int st = (r >> 4) * 2 + (c >> 5), rr = r & 15, cc = c & 31, ob = rr * 64 + cc * 2; return st * 1024 + (ob ^ (((ob >> 9) & 1) << 5)); }
__host__ __device__ __forceinline__ void stage_rc(int b, int& R, int& C) { const int st = b / 1024, sb = b % 1024, swz = sb ^ (((sb >> 9) & 1) << 5); R = (st >> 1) * 16 + swz / 64; C = (st & 1) * 32 + (swz % 64) / 2; }
__host__ __device__ __forceinline__ int perm32(int rho) { const int n = rho >> 4, i = rho & 15; return 8 * (i >> 2) + 4 * n + (i & 3); }

struct Unit { int pm, pn; };
struct Gemm { const bf16_t* A; const bf16_t* Bt; int M, N, K; int a_mul, a_add; };

struct StaticOrder {
    int nM, nN, nwg, G, c;
    __host__ __device__ void init(int M, int N, int G_, int c_) { nM = M / BM; nN = N / BM; nwg = nM * nN; G = G_; c = c_; }
    __host__ __device__ bool next(int i, Unit& u) const {
        const long L = (long)i * G + c; if (L >= nwg) return false;
        int wgid = (int)L; { const int q = nwg / NXCD, r = nwg % NXCD, xcd = wgid % NXCD, off = wgid / NXCD; wgid = (xcd < r ? xcd * (q + 1) : r * (q + 1) + (xcd - r) * q) + off; }
        const int nig = WGM * nN, gid = wgid / nig, fm = gid * WGM, gsz = (nM - fm) < WGM ? (nM - fm) : WGM;
        u.pm = fm + ((wgid % nig) % gsz); u.pn = (wgid % nig) / gsz; return true;
    }
    __device__ __forceinline__ void a_ready(const Unit&) const {}
    __device__ __forceinline__ void done(const Unit&) const {}
};

__device__ __forceinline__ unsigned cvt_pk_bf16(float lo, float hi) { unsigned r; asm volatile("v_cvt_pk_bf16_f32 %0, %1, %2" : "=v"(r) : "v"(lo), "v"(hi)); return r; }

struct EpiBf16B {
    static constexpr bool PERM = true, AFTER_DRAIN = false;
    bf16_t* O; int ldc; const float* bias;
    __device__ __forceinline__ void operator()(const f32x4 (&acc)[2][2][4][2], const Unit& u, int wr, int wc, int fr, int fq) const {
        const int row0 = u.pm * BM + wr * 64 + fr; const int col0 = u.pn * BM + wc * 32 + 8 * fq;
        f32x4 bv[2][2];
#pragma unroll
        for (int bj = 0; bj < 2; ++bj)
#pragma unroll
            for (int n = 0; n < 2; ++n) bv[bj][n] = bias ? *(const f32x4*)(bias + col0 + bj * HALF + 4 * n) : (f32x4){0.f, 0.f, 0.f, 0.f};
#pragma unroll
        for (int ai = 0; ai < 2; ++ai)
#pragma unroll
            for (int m = 0; m < 4; ++m) { bf16_t* rowp = O + (size_t)(row0 + ai * HALF + m * 16) * ldc + col0;
#pragma unroll
                for (int bj = 0; bj < 2; ++bj) { const f32x4 v0 = acc[ai][bj][m][0] + bv[bj][0], v1 = acc[ai][bj][m][1] + bv[bj][1];
                    u32x4 w; w.x = cvt_pk_bf16(v0[0], v0[1]); w.y = cvt_pk_bf16(v0[2], v0[3]); w.z = cvt_pk_bf16(v1[0], v1[1]); w.w = cvt_pk_bf16(v1[2], v1[3]);
                    *(u32x4*)(rowp + bj * HALF) = w; } }
    }
};
struct EpiResid {
    static constexpr bool PERM = false, AFTER_DRAIN = false;
    const float* res; float* out; int ldc; const float* gate; int gstride; int row_off;
    __device__ __forceinline__ void operator()(const f32x4 (&acc)[2][2][4][2], const Unit& u, int wr, int wc, int fr, int fq) const {
        const int rbase = row_off + u.pm * BM; const int b = rbase >> 11;
        const int row0 = rbase + wr * 64 + fr, col0 = u.pn * BM + wc * 32 + 4 * fq;
        const float* gp = gate + (size_t)b * gstride + col0;
        f32x4 gv[2][2];
#pragma unroll
        for (int bj = 0; bj < 2; ++bj)
#pragma unroll
            for (int n = 0; n < 2; ++n) gv[bj][n] = *(const f32x4*)(gp + bj * HALF + n * 16);
#pragma unroll
        for (int ai = 0; ai < 2; ++ai)
#pragma unroll
            for (int m = 0; m < 4; ++m) { const size_t off = (size_t)(row0 + ai * HALF + m * 16) * ldc + col0;
#pragma unroll
                for (int bj = 0; bj < 2; ++bj)
#pragma unroll
                    for (int n = 0; n < 2; ++n) { const f32x4 r = *(const f32x4*)(res + off + bj * HALF + n * 16);
                        *(f32x4*)(out + off + bj * HALF + n * 16) = r + gv[bj][n] * acc[ai][bj][m][n]; } }
    }
};


struct EpiInProj {
    static constexpr bool PERM = true, AFTER_DRAIN = false;
    bf16_t* O; int ldc; const float* bias;
    __device__ __forceinline__ void operator()(const f32x4 (&acc)[2][2][4][2], const Unit& u, int wr, int wc, int fr, int fq) const {
        const int head = u.pn / 5, part = u.pn - 5 * head;
        const int row0 = u.pm * BM + wr * 64 + fr, cin = wc * 32 + 8 * fq;
        f32x4 bv[2][2];
#pragma unroll
        for (int bj = 0; bj < 2; ++bj)
#pragma unroll
            for (int n = 0; n < 2; ++n) bv[bj][n] = *(const f32x4*)(bias + u.pn * BM + bj * HALF + cin + 4 * n);
        if (part < 3) {
#pragma unroll
            for (int ai = 0; ai < 2; ++ai)
#pragma unroll
                for (int m = 0; m < 4; ++m) { bf16_t* rowp = O + (size_t)(row0 + ai * HALF + m * 16) * ldc + head * 1024 + part * 256 + cin;
#pragma unroll
                    for (int bj = 0; bj < 2; ++bj) { const f32x4 v0 = acc[ai][bj][m][0] + bv[bj][0], v1 = acc[ai][bj][m][1] + bv[bj][1];
                        u32x4 w; w.x = cvt_pk_bf16(v0[0], v0[1]); w.y = cvt_pk_bf16(v0[2], v0[3]); w.z = cvt_pk_bf16(v1[0], v1[1]); w.w = cvt_pk_bf16(v1[2], v1[3]);
                        *(u32x4*)(rowp + bj * HALF) = w; } }
        } else {
            const bool silu0 = part == 4;
#pragma unroll
            for (int ai = 0; ai < 2; ++ai)
#pragma unroll
                for (int m = 0; m < 4; ++m) { bf16_t* rowp = O + (size_t)(row0 + ai * HALF + m * 16) * ldc + head * 1024 + 768 + (part - 3) * 128 + cin;
                    float c[8];
#pragma unroll
                    for (int n = 0; n < 2; ++n) { const f32x4 x0 = acc[ai][0][m][n] + bv[0][n], x1 = acc[ai][1][m][n] + bv[1][n];
#pragma unroll
                        for (int e = 0; e < 4; ++e) { const float s0 = __builtin_amdgcn_rcpf(1.f + __expf(-x0[e])), s1 = __builtin_amdgcn_rcpf(1.f + __expf(-x1[e])); c[4 * n + e] = (silu0 ? x0[e] * s0 : s0) * s1; } }
                    u32x4 w; w.x = cvt_pk_bf16(c[0], c[1]); w.y = cvt_pk_bf16(c[2], c[3]); w.z = cvt_pk_bf16(c[4], c[5]); w.w = cvt_pk_bf16(c[6], c[7]);
                    *(u32x4*)rowp = w; }
        }
    }
};
template <class Epi, class Sched, bool ALIGN_EPI = false, bool SP2 = false>
__device__ __forceinline__ void gemm_phase(PG8_LAS unsigned char* lds, const Gemm g, const Sched& S, const Epi& E, const int wave_id  ) {
    int tid_l; asm volatile("v_mbcnt_lo_u32_b32 %0, -1, 0\n\tv_mbcnt_hi_u32_b32 %0, -1, %0" : "=v"(tid_l)); tid_l += wave_id * 64;
    const int tid = tid_l, wid = __builtin_amdgcn_readfirstlane(tid >> 6), lane = tid & 63, wr = wid >> 2, wc = wid & 3, fr = lane & 15, fq = lane >> 4;
    const int K = g.K, nt = K / BK;
    unsigned voffA[2], voffB[2];
#pragma unroll
    for (int i = 0; i < 2; ++i) { int R, C; stage_rc(tid * 16 + i * 8192, R, C); const int Rb = Epi::PERM ? ((R & ~31) + perm32(R & 31)) : R;
        voffA[i] = (unsigned)(R * K + C) * 2u; voffB[i] = (unsigned)(Rb * K + C) * 2u; }
    const size_t kstep = (size_t)(BK * 2);
    const size_t hstep = (size_t)HALF * K * 2;
    const size_t tstep = 2 * hstep;
    const unsigned ldsw = (unsigned)wid * 1024u;
    const int aoff = lds_byte(wr * 64 + fr, fq * 8), boff = lds_byte(wc * 32 + fr, fq * 8);
#define PG8_SA(b, h) (((b) * 2 + (h)) * HTB)
#define PG8_SB(b, h) ((4 + (b) * 2 + (h)) * HTB)
#define PG8_STAGE(bufoff, gbase, voff) do { _Pragma("unroll") for (int _i = 0; _i < 2; ++_i) \
        __builtin_amdgcn_global_load_lds((const unsigned*)((const char*)(gbase) + (voff)[_i]), (PG8_LAS unsigned*)(lds + (bufoff) + ldsw + _i * 8192), 16, 0, 0); } while (0)
#define PG8_LDA(dst, b, h) do { _Pragma("unroll") for (int m = 0; m < 4; ++m) _Pragma("unroll") for (int k = 0; k < 2; ++k) dst[m][k] = *(const PG8_LAS bf16x8*)(lds + PG8_SA(b, h) + aoff + m * 2048 + k * 1024); } while (0)
#define PG8_LDB(dst, b, h) do { _Pragma("unroll") for (int n = 0; n < 2; ++n) _Pragma("unroll") for (int k = 0; k < 2; ++k) dst[n][k] = *(const PG8_LAS bf16x8*)(lds + PG8_SB(b, h) + boff + n * 2048 + k * 1024); } while (0)
#define PG8_MMA(ai, bj, At, Bt) do { __builtin_amdgcn_s_setprio(1); _Pragma("unroll") for (int m = 0; m < 4; ++m) _Pragma("unroll") for (int n = 0; n < 2; ++n) _Pragma("unroll") for (int k = 0; k < 2; ++k) \
        acc[ai][bj][m][n] = __builtin_amdgcn_mfma_f32_16x16x32_bf16(Bt[n][k], At[m][k], acc[ai][bj][m][n], 0, 0, 0); __builtin_amdgcn_s_setprio(0); } while (0)
#define PG8_WAIT_V(n) asm volatile("s_waitcnt vmcnt(" #n ")" ::: "memory")
#define PG8_WAIT_L(n) asm volatile("s_waitcnt lgkmcnt(" #n ")" ::: "memory")
#define PG8_BAR __builtin_amdgcn_s_barrier()
#define PG8_SCHED __builtin_amdgcn_sched_barrier(0)
    Unit cur, nxt; int ui = 0;
    if (!S.next(0, cur)) return;
    f32x4 acc[2][2][4][2];
#pragma unroll
    for (int a = 0; a < 2; ++a)
#pragma unroll
        for (int b = 0; b < 2; ++b)
#pragma unroll
            for (int m = 0; m < 4; ++m)
#pragma unroll
                for (int n = 0; n < 2; ++n) acc[a][b][m][n] = (f32x4){0.f, 0.f, 0.f, 0.f};
    bf16x8 At[4][2], B0[2][2], B1[2][2];
    const char* cA = (const char*)g.A + (size_t)(cur.pm * g.a_mul + g.a_add) * tstep; const char* cB = (const char*)g.Bt + (size_t)cur.pn * tstep;
    S.a_ready(cur);
    if constexpr (SP2) {
        PG8_STAGE(PG8_SB(0, 0), cB, voffB); PG8_STAGE(PG8_SB(0, 1), cB + hstep, voffB); PG8_STAGE(PG8_SA(0, 0), cA, voffA); PG8_STAGE(PG8_SA(0, 1), cA + hstep, voffA);
        if (wr == 1) PG8_BAR;
        PG8_WAIT_V(2); PG8_BAR;
        PG8_STAGE(PG8_SB(1, 0), cB + kstep, voffB); PG8_STAGE(PG8_SA(1, 0), cA + kstep, voffA); PG8_STAGE(PG8_SB(1, 1), cB + hstep + kstep, voffB);
        PG8_WAIT_V(6); PG8_BAR;
    } else {
        PG8_STAGE(PG8_SB(0, 0), cB, voffB); PG8_STAGE(PG8_SA(0, 0), cA, voffA); PG8_STAGE(PG8_SB(0, 1), cB + hstep, voffB); PG8_STAGE(PG8_SA(0, 1), cA + hstep, voffA);
        if (wr == 1) PG8_BAR;
        PG8_WAIT_V(4); PG8_BAR;
        PG8_STAGE(PG8_SB(1, 0), cB + kstep, voffB); PG8_STAGE(PG8_SA(1, 0), cA + kstep, voffA); PG8_STAGE(PG8_SB(1, 1), cB + hstep + kstep, voffB);
        PG8_WAIT_V(6); PG8_BAR;
    }
    for (;;) {
        const bool has_next = S.next(ui + 1, nxt);
        const char* nA = has_next ? (const char*)g.A + (size_t)(nxt.pm * g.a_mul + g.a_add) * tstep : cA; const char* nB = has_next ? (const char*)g.Bt + (size_t)nxt.pn * tstep : cB;
        for (int t = 0; t < nt; t += 2) {
            const bool last = (t == nt - 2);
            const char* a1 = cA + (size_t)(t + 1) * kstep;
            const char* a2 = last ? nA : cA + (size_t)(t + 2) * kstep; const char* b2 = last ? nB : cB + (size_t)(t + 2) * kstep;
            const char* a3 = a2 + kstep; const char* b3 = b2 + kstep;
            if (last && has_next) S.a_ready(nxt);
            if constexpr (SP2) {
            PG8_LDB(B0, 0, 0); PG8_LDB(B1, 0, 1); PG8_SCHED; PG8_LDA(At, 0, 0); PG8_STAGE(PG8_SA(1, 1), a1 + hstep, voffA);
            PG8_WAIT_V(8); PG8_WAIT_L(0); PG8_BAR; PG8_MMA(0, 0, At, B0); PG8_MMA(0, 1, At, B1); PG8_BAR; PG8_SCHED;
            PG8_LDA(At, 0, 1); PG8_STAGE(PG8_SB(0, 0), b2, voffB); PG8_STAGE(PG8_SB(0, 1), b2 + hstep, voffB); PG8_STAGE(PG8_SA(0, 0), a2, voffA);
            PG8_WAIT_V(8); PG8_WAIT_L(0); PG8_BAR; PG8_MMA(1, 0, At, B0); PG8_MMA(1, 1, At, B1); PG8_BAR; PG8_SCHED;
            PG8_LDB(B0, 1, 0); PG8_LDB(B1, 1, 1); PG8_SCHED; PG8_LDA(At, 1, 0); PG8_STAGE(PG8_SA(0, 1), a2 + hstep, voffA);
            PG8_WAIT_V(8); PG8_WAIT_L(0); PG8_BAR; PG8_MMA(0, 0, At, B0); PG8_MMA(0, 1, At, B1); PG8_BAR; PG8_SCHED;
            PG8_LDA(At, 1, 1); PG8_STAGE(PG8_SB(1, 0), b3, voffB); PG8_STAGE(PG8_SB(1, 1), b3 + hstep, voffB); PG8_STAGE(PG8_SA(1, 0), a3, voffA);
            PG8_WAIT_V(8); PG8_WAIT_L(0); PG8_BAR; PG8_MMA(1, 0, At, B0); PG8_MMA(1, 1, At, B1); PG8_BAR; PG8_SCHED;
            } else {
            PG8_LDB(B0, 0, 0); PG8_SCHED; PG8_LDA(At, 0, 0); PG8_STAGE(PG8_SA(1, 1), a1 + hstep, voffA);
            PG8_WAIT_L(8); PG8_BAR; PG8_WAIT_L(0); PG8_MMA(0, 0, At, B0); PG8_BAR; PG8_SCHED;
            PG8_LDB(B1, 0, 1); PG8_STAGE(PG8_SB(0, 0), b2, voffB);
            PG8_BAR; PG8_WAIT_L(0); PG8_MMA(0, 1, At, B1); PG8_BAR;
            PG8_LDA(At, 0, 1); PG8_STAGE(PG8_SA(0, 0), a2, voffA);
            PG8_BAR; PG8_WAIT_L(0); PG8_MMA(1, 0, At, B0); PG8_BAR; PG8_SCHED;
            PG8_STAGE(PG8_SB(0, 1), b2 + hstep, voffB);
            PG8_WAIT_V(6); PG8_BAR; PG8_MMA(1, 1, At, B1); PG8_BAR;
            PG8_LDB(B0, 1, 0); PG8_SCHED; PG8_LDA(At, 1, 0); PG8_STAGE(PG8_SA(0, 1), a2 + hstep, voffA);
            PG8_WAIT_L(8); PG8_BAR; PG8_WAIT_L(0); PG8_MMA(0, 0, At, B0); PG8_BAR; PG8_SCHED;
            PG8_LDB(B1, 1, 1); PG8_STAGE(PG8_SB(1, 0), b3, voffB);
            PG8_BAR; PG8_WAIT_L(0); PG8_MMA(0, 1, At, B1); PG8_BAR;
            PG8_LDA(At, 1, 1); PG8_STAGE(PG8_SA(1, 0), a3, voffA);
            PG8_BAR; PG8_WAIT_L(0); PG8_MMA(1, 0, At, B0); PG8_BAR; PG8_SCHED;
            PG8_STAGE(PG8_SB(1, 1), b3 + hstep, voffB);
            PG8_WAIT_V(6); PG8_BAR; PG8_MMA(1, 1, At, B1); PG8_BAR;
            }
        }
        if constexpr (ALIGN_EPI) { if (wr == 0) PG8_BAR; }
        if constexpr (!Epi::AFTER_DRAIN) { E(acc, cur, wr, wc, fr, fq); S.done(cur); }
        if (!has_next) break;
#pragma unroll
        for (int a = 0; a < 2; ++a)
#pragma unroll
            for (int b = 0; b < 2; ++b)
#pragma unroll
                for (int m = 0; m < 4; ++m)
#pragma unroll
                    for (int n = 0; n < 2; ++n) acc[a][b][m][n] = (f32x4){0.f, 0.f, 0.f, 0.f};
        cur = nxt; cA = nA; cB = nB; ++ui;
        if constexpr (ALIGN_EPI) { if (wr == 1) PG8_BAR; }
    }
    PG8_WAIT_V(0);
    if constexpr (!ALIGN_EPI) { if (wr == 0) PG8_BAR; }
    PG8_BAR;
    if constexpr (Epi::AFTER_DRAIN) { E.fused(acc, cur, wr, wc, fr, fq, lds, wid, lane); S.done(cur); }
#undef PG8_SA
#undef PG8_SB
#undef PG8_STAGE
#undef PG8_LDA
#undef PG8_LDB
#undef PG8_MMA
#undef PG8_WAIT_V
#undef PG8_WAIT_L
#undef PG8_BAR
#undef PG8_SCHED
}
}

#ifndef PG8_SP2
#define PG8_SP2 true
#endif
#ifndef PG8_ALIGN
#define PG8_ALIGN true
#endif

constexpr int NWAVES = 8;
constexpr int D = 1024, BATCH = 32, SEQ = 2048, M = BATCH * SEQ, DEPTH = 2, NH = 8, HD = 128, DFF = 2816;
constexpr int PROJW = 10256;
constexpr int NPROJ = 10240, WHB = 1280;
constexpr int PW = 8192, HB = 1024;
constexpr int NSEG = 8, SEGT = SEQ / NSEG, SEGROWS = BATCH * SEGT;
constexpr int FSEG = 2, FROWS = M / FSEG;
constexpr float RMS_EPS = 1e-6f;
constexpr int MODW = 6 * D;

constexpr size_t MiB = 1u << 20;
constexpr size_t WS_CTL = 0, CTL_ZERO_BYTES = 1 * MiB;
constexpr size_t WS_WIN = 2 * MiB;
constexpr size_t WS_WOUT = 42 * MiB;
constexpr size_t WS_WUP = 46 * MiB;
constexpr size_t WS_WDN = 68 * MiB;
constexpr size_t WS_WG = 79 * MiB;
constexpr size_t WS_BIASP = 79 * MiB + 256 * 1024;
constexpr size_t WS_BG = 79 * MiB + 512 * 1024;
constexpr size_t WS_LB = 79 * MiB + 768 * 1024;
constexpr size_t WS_MOD = 80 * MiB;
constexpr size_t WS_GATES = 84 * MiB;
constexpr size_t WS_STC = 88 * MiB;
constexpr size_t WS_STS = 104 * MiB;
constexpr size_t WS_STN = 120 * MiB;
constexpr size_t WS_STM = 121 * MiB;
constexpr size_t WS_HN = 122 * MiB;
constexpr size_t WS_Y = 250 * MiB;
constexpr size_t WS_P = 378 * MiB;
constexpr size_t P_BYTES = (size_t)SEGROWS * PW * 2;
constexpr size_t WS_U = 250 * MiB;
constexpr size_t WS_G = 602 * MiB;
constexpr size_t WS_END = 778 * MiB;
static_assert(WS_P + 2 * P_BYTES <= 634 * MiB && WS_U + (size_t)FROWS * 2 * DFF * 2 <= WS_G && WS_G + (size_t)FROWS * DFF * 2 <= WS_END, "ws map");
constexpr int CW_TMO = 0, CW_CODE = 1, CW_BAR = 4096;

constexpr int LDS_BYTES = 160 * 1024;
constexpr int RING_OFF = 0;
constexpr int MISC_OFF = 159 * 1024;

#define GAS __attribute__((address_space(1)))
#define LAS __attribute__((address_space(3)))
typedef unsigned short bf16;
typedef unsigned v4u __attribute__((ext_vector_type(4)));
typedef unsigned v2u __attribute__((ext_vector_type(2)));
typedef float f32x4 __attribute__((ext_vector_type(4)));
typedef short bf16x8 __attribute__((ext_vector_type(8)));
typedef GAS unsigned gu32;
#define RLX_AGENT __ATOMIC_RELAXED, __HIP_MEMORY_SCOPE_AGENT
#define LDS_WAIT() asm volatile("s_waitcnt lgkmcnt(0)" ::: "memory")
#define VM_WAIT() asm volatile("s_waitcnt vmcnt(0)" ::: "memory")
__device__ __forceinline__ unsigned f2bf(float f) { unsigned u = __builtin_bit_cast(unsigned, f); return (u + 0x7fffu + ((u >> 16) & 1u)) >> 16; }
__device__ __forceinline__ unsigned pk2(float lo, float hi) { return f2bf(lo) | (f2bf(hi) << 16); }
__device__ __forceinline__ float bf2f(unsigned short b) { return __builtin_bit_cast(float, ((unsigned)b) << 16); }
__device__ __forceinline__ float sigm(float x) { return 1.f / (1.f + __expf(-x)); }
__device__ __forceinline__ float siluf(float x) { return x / (1.f + __expf(-x)); }
__device__ __forceinline__ float softcap15(float z) { return 15.f * tanhf(z * (1.f / 15.f)); }
__device__ __forceinline__ float logsigm(float z) { return fminf(z, 0.f) - log1pf(expf(-fabsf(z))); }
__device__ __forceinline__ float wave_sum(float v) {
#pragma unroll
    for (int o = 1; o < 64; o <<= 1) v += __shfl_xor(v, o);
    return v;
}

#define PHASE_TID() int tid; asm volatile("v_mbcnt_lo_u32_b32 %0, -1, 0\n\tv_mbcnt_hi_u32_b32 %0, -1, %0" : "=v"(tid)); tid += F.wave_s * 64; const int lane = tid & 63, wave = F.wave_s; (void)lane; (void)wave
#define XB_TMO      128
#define XB_XCNT(j)  (256  + 64 * (j))
#define XB_XSUB(j)  (1280 + 64 * (j))
#define XB_XGEN(j)  (2304 + 64 * (j))
#define XB_TOP      3328
#define XB_TOPGEN   3392
#define XCD_BAR_WORDS 3456
#define XB_SPIN_CAP (1u << 18)

__device__ __forceinline__ unsigned xb_ld(unsigned* p)              { return __hip_atomic_load(p, __ATOMIC_RELAXED, __HIP_MEMORY_SCOPE_AGENT); }
__device__ __forceinline__ unsigned xb_add(unsigned* p, unsigned v) { return __hip_atomic_fetch_add(p, v, __ATOMIC_RELAXED, __HIP_MEMORY_SCOPE_AGENT); }
__device__ __forceinline__ unsigned xb_xcc_id() { return (unsigned)__builtin_amdgcn_s_getreg((3 << 11) | 20) & 0xFu; }
#define XB_SPIN(cond, bar) do { unsigned _sp = 0; while (cond) { __builtin_amdgcn_s_sleep(1); \
    if ((++_sp & 255u) == 0u) { if (xb_ld(&(bar)[XB_TMO])) break; if (_sp > XB_SPIN_CAP) { atomicAdd(&(bar)[XB_TMO], 1u); break; } } } } while (0)

struct XcdBarrier {
    unsigned* bar; unsigned x;
    volatile LAS unsigned* st;
};

__device__ __forceinline__ XcdBarrier xcd_barrier_post(unsigned* bar, volatile LAS unsigned* st) {
    XcdBarrier b; b.bar = bar; b.x = xb_xcc_id(); b.st = st;
    if (threadIdx.x == 0) (void)xb_add(&bar[XB_XCNT(b.x)], 1u);
    return b;
}
__device__ __forceinline__ void xcd_barrier_complete(unsigned* bar, unsigned x, unsigned& nloc, unsigned& nx) {
    const unsigned G = gridDim.x * gridDim.y * gridDim.z;
    unsigned sum, cnt, mine, sp = 0u;
    for (;;) {
        sum = 0u; cnt = 0u; mine = 0u;
#pragma unroll
        for (unsigned j = 0; j < 16; ++j) { const unsigned c = xb_ld(&bar[XB_XCNT(j)]); sum += c; cnt += (c > 0u) ? 1u : 0u; mine = (j == x) ? c : mine; }
        if (sum == G) break;
        __builtin_amdgcn_s_sleep(1);
        if ((++sp & 255u) == 0u) { if (xb_ld(&bar[XB_TMO])) break; if (sp > XB_SPIN_CAP) { atomicAdd(&bar[XB_TMO], 1u); break; } }
    }
    nloc = mine > 0u ? mine : 1u; nx = cnt > 0u ? cnt : 1u;
}

__device__ __forceinline__ void xcd_barrier(const XcdBarrier& b) {
    asm volatile("s_waitcnt vmcnt(0)" ::: "memory");
    __syncthreads();
    if (threadIdx.x == 0) {
        unsigned* bar = b.bar;
        __builtin_amdgcn_s_waitcnt(0);
        unsigned nloc = b.st[0], nx = b.st[1];
        if (nloc == 0u) { xcd_barrier_complete(bar, b.x, nloc, nx); b.st[0] = nloc; b.st[1] = nx; }
        const unsigned old = xb_add(&bar[XB_XSUB(b.x)], 1u);
        const unsigned gen = old / nloc;
        if (old + 1u == (gen + 1u) * nloc) {
            __builtin_amdgcn_fence(__ATOMIC_RELEASE, "agent");
            asm volatile("s_waitcnt vmcnt(0)" ::: "memory");
            const unsigned og = xb_add(&bar[XB_TOP], 1u);
            const unsigned tg = og / nx;
            if (og + 1u == (tg + 1u) * nx) xb_add(&bar[XB_TOPGEN], 1u);
            else XB_SPIN(xb_ld(&bar[XB_TOPGEN]) == tg, bar);
            __builtin_amdgcn_fence(__ATOMIC_ACQUIRE, "agent");
            xb_add(&bar[XB_XGEN(b.x)], 1u);
            asm volatile("s_waitcnt vmcnt(0)" ::: "memory");
        } else {
            XB_SPIN(xb_ld(&bar[XB_XGEN(b.x)]) == gen, bar);
            __builtin_amdgcn_fence(__ATOMIC_ACQUIRE, "agent");
            asm volatile("s_waitcnt vmcnt(0)" ::: "memory");
        }
    }
    __syncthreads();
}

struct Ctx {
    LAS unsigned char* lds;
    int vcu, G, wave_s;
};
struct Args { const float* in[19]; float* out; unsigned char* ws; };
typedef const Args __attribute__((address_space(4))) CArgs;
__device__ __forceinline__ CArgs& getargs() { CArgs* p = (CArgs*)__builtin_amdgcn_kernarg_segment_ptr(); asm volatile("" : "+s"(p)); return *p; }
#define ARGS() CArgs& A = getargs()

__device__ __forceinline__ void p0_transpose_item(const float* W, int ldw, int srccol0, int k0, bf16* WT, int K, int dstrow0, LAS float* scr, int lane) {
#pragma unroll 8
    for (int i = 0; i < 32; ++i) { const int kk = 2 * i + (lane >> 5); scr[kk * 33 + (lane & 31)] = W[(size_t)(k0 + kk) * ldw + srccol0 + (lane & 31)]; }
    LDS_WAIT(); asm volatile("" ::: "memory");
    const int c = lane & 7;
#pragma unroll
    for (int j = 0; j < 4; ++j) { const int n = (lane >> 3) + 8 * j; const LAS float* s = scr + (8 * c) * 33 + n;
        v4u o; o.x = pk2(s[0 * 33], s[1 * 33]); o.y = pk2(s[2 * 33], s[3 * 33]); o.z = pk2(s[4 * 33], s[5 * 33]); o.w = pk2(s[6 * 33], s[7 * 33]);
        *(GAS v4u*)(WT + (size_t)(dstrow0 + n) * K + k0 + 8 * c) = o; }
    LDS_WAIT(); asm volatile("" ::: "memory");
}
__device__ __forceinline__ int in_src_col(int dstrow) {
    const int h = dstrow / WHB, rem = dstrow - h * WHB, blk = rem >> 7, j = rem & 127;
    int base;
    switch (blk) { case 0: base = 0; break; case 1: base = 1024; break; case 2: base = 2048; break; case 3: base = 6160; break; case 4: base = 4112; break;
                   case 5: base = 5136; break; case 6: base = 3072; break; case 7: base = 8208; break; case 8: base = 7184; break; default: base = 9232; break; }
    return base + h * 128 + j;
}
__device__ __forceinline__ void p0_prologue(Ctx& F) {
    PHASE_TID();
    ARGS();
    LAS float* scr = (LAS float*)(F.lds + wave * 16384);
    const int gw = F.vcu * NWAVES + wave, NGW = F.G * NWAVES;
    constexpr int I_IN = 320 * 16, I_OUT = 32 * 16, I_UP = 176 * 16, I_DN = 32 * 44, I_L = I_IN + I_OUT + I_UP + I_DN;
    for (int it = gw; it < 2 * I_L; it += NGW) {
        const int l = it / I_L; int r = it - l * I_L;
        if (r < I_IN) { const int rg = r >> 4, kb = r & 15; p0_transpose_item(A.in[5] + (size_t)l * D * PROJW, PROJW, in_src_col(32 * rg), 64 * kb, (bf16*)(A.ws + WS_WIN) + (size_t)l * NPROJ * D, D, 32 * rg, scr, lane); continue; } r -= I_IN;
        if (r < I_OUT) { const int rg = r >> 4, kb = r & 15; p0_transpose_item(A.in[12] + (size_t)l * D * D, D, 32 * rg, 64 * kb, (bf16*)(A.ws + WS_WOUT) + (size_t)l * D * D, D, 32 * rg, scr, lane); continue; } r -= I_OUT;
        if (r < I_UP) { const int rg = r >> 4, kb = r & 15; const int row0 = 32 * rg, pn = row0 >> 8, half = (row0 >> 7) & 1, j0 = row0 & 127;
            p0_transpose_item(A.in[14] + (size_t)l * D * 2 * DFF, 2 * DFF, half * DFF + pn * 128 + j0, 64 * kb, (bf16*)(A.ws + WS_WUP) + (size_t)l * 2 * DFF * D, D, row0, scr, lane); continue; } r -= I_UP;
        { const int rg = r / 44, kb = r - rg * 44; p0_transpose_item(A.in[17] + (size_t)l * DFF * D, D, 32 * rg, 64 * kb, (bf16*)(A.ws + WS_WDN) + (size_t)l * D * DFF, DFF, 32 * rg, scr, lane); }
    }
    const int gt = F.vcu * (NWAVES * 64) + tid, NGT = F.G * NWAVES * 64;
    float* wg = (float*)(A.ws + WS_WG); float* biasp = (float*)(A.ws + WS_BIASP); float* bg = (float*)(A.ws + WS_BG); float* lb = (float*)(A.ws + WS_LB);
    for (int i = gt; i < 2 * D * 16; i += NGT) { const int g = i & 15, k = (i >> 4) & (D - 1), l = i >> 14; wg[(size_t)(l * 16 + g) * D + k] = A.in[5][((size_t)l * D + k) * PROJW + 4096 + g]; }
    for (int i = gt; i < 2 * NPROJ; i += NGT) { const int l = i / NPROJ, c = i - l * NPROJ; biasp[i] = A.in[6][(size_t)l * PROJW + in_src_col(c)]; }
    for (int i = gt; i < 32; i += NGT) { const int l = i >> 4, g = i & 15; bg[i] = A.in[6][(size_t)l * PROJW + 4096 + g]; }
    for (int i = gt; i < D; i += NGT) { const float z0 = A.in[10][i], z1 = A.in[10][D + i]; lb[i] = 1.f / (1.f + expf(z0 - z1)); }
    __syncthreads();
    for (int wgi = F.vcu; wgi < 2 * (MODW / 64); wgi += F.G) {
        LAS float* cact = (LAS float*)F.lds;
        for (int i = tid; i < BATCH * D; i += NWAVES * 64) cact[i] = siluf(A.in[1][i]);
        __syncthreads();
        const int l = wgi / (MODW / 64), cg = wgi - l * (MODW / 64), col = cg * 64 + lane, kb = wave * 128;
        const float* aw = A.in[2] + (size_t)l * D * MODW + col;
        float acc[32];
#pragma unroll
        for (int b = 0; b < 32; ++b) acc[b] = 0.f;
        for (int k4 = 0; k4 < 32; ++k4) {
            const int k = kb + 4 * k4;
            const float w0 = aw[(size_t)k * MODW], w1 = aw[(size_t)(k + 1) * MODW], w2 = aw[(size_t)(k + 2) * MODW], w3 = aw[(size_t)(k + 3) * MODW];
#pragma unroll
            for (int b = 0; b < 32; ++b) { const f32x4 cv = *(const LAS f32x4*)(cact + b * D + k); acc[b] += cv.x * w0 + cv.y * w1 + cv.z * w2 + cv.w * w3; }
        }
        __syncthreads();
        LAS float* part = (LAS float*)F.lds;
#pragma unroll
        for (int b = 0; b < 32; ++b) part[(wave * 32 + b) * 64 + lane] = acc[b];
        __syncthreads();
        float* mod = (float*)(A.ws + WS_MOD);
        for (int o = tid; o < 32 * 64; o += NWAVES * 64) { const int b = o >> 6, c = o & 63; float s = 0.f;
#pragma unroll
            for (int w = 0; w < 8; ++w) s += part[(w * 32 + b) * 64 + c];
            mod[((size_t)l * BATCH + b) * MODW + cg * 64 + c] = s + A.in[3][(size_t)l * MODW + cg * 64 + c]; }
        __syncthreads();
    }
}

__device__ __forceinline__ float reduce16(float (&v)[16], int lane) {
#define R16_STEP(S, MSK) { const bool up = (lane & (MSK)) != 0; _Pragma("unroll") for (int i = 0; i < (S); ++i) { const float keep = up ? v[i + (S)] : v[i], send = up ? v[i] : v[i + (S)]; v[i] = keep + __shfl_xor(send, (MSK)); } }
    R16_STEP(8, 32) R16_STEP(4, 16) R16_STEP(2, 8) R16_STEP(1, 4)
#undef R16_STEP
    float r = v[0]; r += __shfl_xor(r, 1); r += __shfl_xor(r, 2); return r;
}
template <bool GATES>
__device__ __forceinline__ void norm_phase(Ctx& F, const float* src, const float* nw, const float* modl, int shift_off, int scale_off, bf16* hn, float* gates, const float* wgl, const float* bgl) {
    PHASE_TID();
    LAS float* wgs = (LAS float*)F.lds;
    if (GATES) { for (int i = tid; i < 16 * D / 4; i += NWAVES * 64) ((LAS f32x4*)wgs)[i] = ((const f32x4*)wgl)[i]; __syncthreads(); }
    const int gw = F.vcu * NWAVES + wave, NGW = F.G * NWAVES;
    f32x4 w[4];
#pragma unroll
    for (int j = 0; j < 4; ++j) w[j] = *(const f32x4*)(nw + 256 * j + 4 * lane);
    for (int item = gw; item < M / 32; item += NGW) {
        const int row0 = item * 32, b = row0 >> 11;
        f32x4 sc[4], sh[4];
#pragma unroll
        for (int j = 0; j < 4; ++j) { sc[j] = *(const f32x4*)(modl + (size_t)b * MODW + scale_off + 256 * j + 4 * lane); sh[j] = *(const f32x4*)(modl + (size_t)b * MODW + shift_off + 256 * j + 4 * lane);
            sc[j] = (sc[j] + 1.0f) * w[j]; }
        f32x4 xn[4];
#pragma unroll
        for (int j = 0; j < 4; ++j) xn[j] = *(const GAS f32x4*)(src + (size_t)row0 * D + 256 * j + 4 * lane);
        for (int r = 0; r < 32; ++r) {
            asm volatile("" ::: "memory");
            f32x4 x[4];
#pragma unroll
            for (int j = 0; j < 4; ++j) x[j] = xn[j];
            if (r + 1 < 32) {
#pragma unroll
                for (int j = 0; j < 4; ++j) xn[j] = *(const GAS f32x4*)(src + (size_t)(row0 + r + 1) * D + 256 * j + 4 * lane);
            }
            float ss = 0.f;
#pragma unroll
            for (int j = 0; j < 4; ++j) ss += (x[j].x * x[j].x + x[j].y * x[j].y) + (x[j].z * x[j].z + x[j].w * x[j].w);
            const float rstd = rsqrtf(wave_sum(ss) * (1.f / D) + RMS_EPS);
#pragma unroll
            for (int j = 0; j < 4; ++j) x[j] = x[j] * rstd * sc[j] + sh[j];
            GAS unsigned long long* o8 = (GAS unsigned long long*)(hn + (size_t)(row0 + r) * D) + lane;
#pragma unroll
            for (int j = 0; j < 4; ++j) o8[64 * j] = (unsigned long long)pk2(x[j].x, x[j].y) | ((unsigned long long)pk2(x[j].z, x[j].w) << 32);
            if (GATES) {
                float a[16];
#pragma unroll
                for (int g = 0; g < 16; ++g) { float s = 0.f;
#pragma unroll
                    for (int j = 0; j < 4; ++j) { const f32x4 wv = *(const LAS f32x4*)(wgs + g * D + 256 * j + 4 * lane); s += (x[j].x * wv.x + x[j].y * wv.y) + (x[j].z * wv.z + x[j].w * wv.w); }
                    a[g] = s; }
                const float tot = reduce16(a, lane);
                const int g = ((lane >> 5) & 1) * 8 + ((lane >> 4) & 1) * 4 + ((lane >> 3) & 1) * 2 + ((lane >> 2) & 1);
                if ((lane & 3) == 0) gates[(size_t)(row0 + r) * 16 + g] = tot + bgl[g];
            }
        }
    }
}
__device__ __forceinline__ void final_norm_phase(Ctx& F, float* x, const float* nw) {
    PHASE_TID();
    const int gw = F.vcu * NWAVES + wave, NGW = F.G * NWAVES;
    f32x4 w[4];
#pragma unroll
    for (int j = 0; j < 4; ++j) w[j] = *(const f32x4*)(nw + 256 * j + 4 * lane);
    for (int row = gw; row < M; row += NGW) {
        GAS f32x4* xr = (GAS f32x4*)(x + (size_t)row * D) + lane;
        f32x4 v[4]; float ss = 0.f;
#pragma unroll
        for (int j = 0; j < 4; ++j) { v[j] = xr[64 * j]; ss += (v[j].x * v[j].x + v[j].y * v[j].y) + (v[j].z * v[j].z + v[j].w * v[j].w); }
        const float rstd = rsqrtf(wave_sum(ss) * (1.f / D) + RMS_EPS);
#pragma unroll
        for (int j = 0; j < 4; ++j) xr[64 * j] = v[j] * rstd * w[j];
    }
}

__device__ __forceinline__ void ffn_glu_phase(Ctx& F, const bf16* u, bf16* g, const float* cw, const float* cb) {
    PHASE_TID();
    constexpr int RB = 16, NCH = DFF / 8, NRB = FROWS / RB;
    const int gt = F.vcu * (NWAVES * 64) + tid, NGT = F.G * NWAVES * 64;
    for (int it = gt; it < NRB * NCH; it += NGT) {
        const int rb = it / NCH, ch = it - rb * NCH, f0 = ch * 8, row0 = rb * RB;
        const int cg0 = (f0 >> 7) * 256 + (f0 & 127);
        float wg_[3][8], wv_[3][8], bgv[8], bvv[8];
#pragma unroll
        for (int j = 0; j < 3; ++j)
#pragma unroll
            for (int e = 0; e < 8; ++e) { wg_[j][e] = cw[(size_t)j * 2 * DFF + f0 + e]; wv_[j][e] = cw[(size_t)j * 2 * DFF + DFF + f0 + e]; }
#pragma unroll
        for (int e = 0; e < 8; ++e) { bgv[e] = cb[f0 + e]; bvv[e] = cb[DFF + f0 + e]; }
        float g1[8], g2[8], v1[8], v2[8];
        const int t0 = row0 & (SEQ - 1);
#pragma unroll
        for (int e = 0; e < 8; ++e) { g1[e] = g2[e] = v1[e] = v2[e] = 0.f; }
        if (t0 >= 2) {
            const v4u a1 = *(const GAS v4u*)(u + (size_t)(row0 - 1) * 2 * DFF + cg0), a2 = *(const GAS v4u*)(u + (size_t)(row0 - 2) * 2 * DFF + cg0);
            const v4u b1 = *(const GAS v4u*)(u + (size_t)(row0 - 1) * 2 * DFF + cg0 + 128), b2 = *(const GAS v4u*)(u + (size_t)(row0 - 2) * 2 * DFF + cg0 + 128);
#pragma unroll
            for (int e = 0; e < 4; ++e) { g1[2 * e] = bf2f(a1[e] & 0xffff); g1[2 * e + 1] = bf2f(a1[e] >> 16); g2[2 * e] = bf2f(a2[e] & 0xffff); g2[2 * e + 1] = bf2f(a2[e] >> 16);
                v1[2 * e] = bf2f(b1[e] & 0xffff); v1[2 * e + 1] = bf2f(b1[e] >> 16); v2[2 * e] = bf2f(b2[e] & 0xffff); v2[2 * e + 1] = bf2f(b2[e] >> 16); }
        }
        for (int r = 0; r < RB; ++r) {
            const v4u a0 = *(const GAS v4u*)(u + (size_t)(row0 + r) * 2 * DFF + cg0), b0 = *(const GAS v4u*)(u + (size_t)(row0 + r) * 2 * DFF + cg0 + 128);
            float g0[8], v0[8], o[8];
#pragma unroll
            for (int e = 0; e < 4; ++e) { g0[2 * e] = bf2f(a0[e] & 0xffff); g0[2 * e + 1] = bf2f(a0[e] >> 16); v0[2 * e] = bf2f(b0[e] & 0xffff); v0[2 * e + 1] = bf2f(b0[e] >> 16); }
#pragma unroll
            for (int e = 0; e < 8; ++e) { const float cgv = bgv[e] + wg_[2][e] * g0[e] + wg_[1][e] * g1[e] + wg_[0][e] * g2[e]; const float cvv = bvv[e] + wv_[2][e] * v0[e] + wv_[1][e] * v1[e] + wv_[0][e] * v2[e];
                o[e] = siluf(cgv) * cvv; g2[e] = g1[e]; g1[e] = g0[e]; v2[e] = v1[e]; v1[e] = v0[e]; }
            v4u w; w.x = pk2(o[0], o[1]); w.y = pk2(o[2], o[3]); w.z = pk2(o[4], o[5]); w.w = pk2(o[6], o[7]);
            *(GAS v4u*)(g + (size_t)(row0 + r) * DFF + f0) = w;
        }
    }
}

constexpr int IMG_QM = 0, IMG_KM = 16384, IMG_VM = 32768, IMG_P = 49152, IMG_HQT = 57344, IMG_HKT = 73728, IMG_HV = 90112, PH_OFF = 106496, MF_OFF = 110592, HAB_OFF = 130048, OBB_OFF = 146432;
constexpr int MF_N = 0, MF_DFL = 128, MF_QN = 192, MF_RS = 256, MF_NRED = 384, MF_E7 = 1408, MF_E157 = 1920, MF_CW = 2432, MF_WN = 3712, MF_END = 3968;
static_assert(MF_OFF + MF_END * 4 <= HAB_OFF && OBB_OFF + 16384 <= MISC_OFF, "mixer LDS map");
constexpr int PO_MQ = 0, PO_MK = 128, PO_MV = 256, PO_HI = 384, PO_HQ = 512, PO_HF = 640, PO_CA = 768, PO_CB = 896;
typedef short s16x4 __attribute__((ext_vector_type(4)));
typedef short v4i16_t __attribute__((ext_vector_type(4)));
__device__ __forceinline__ unsigned offb(unsigned row, unsigned ch) { return 256u * row + 16u * (ch ^ (((row & 3u) << 2) | ((row >> 2) & 3u))); }
__device__ __forceinline__ bf16x8 ld16(LAS unsigned char* p) { return *(const LAS bf16x8*)p; }
__device__ __forceinline__ s16x4 ld8(LAS unsigned char* p) { return *(const LAS s16x4*)p; }
__device__ __forceinline__ s16x4 ldtr(LAS unsigned char* p) { return __builtin_bit_cast(s16x4, __builtin_amdgcn_ds_read_tr16_b64_v4i16((LAS v4i16_t*)p)); }
__device__ __forceinline__ bf16x8 cat8(s16x4 a, s16x4 b) { bf16x8 r; r[0] = a[0]; r[1] = a[1]; r[2] = a[2]; r[3] = a[3]; r[4] = b[0]; r[5] = b[1]; r[6] = b[2]; r[7] = b[3]; return r; }
__device__ __forceinline__ bf16x8 frag_row(LAS unsigned char* img, int row0, int ks, int lane) { return ld16(img + offb(row0 + (lane & 15), 4 * ks + (lane >> 4))); }
__device__ __forceinline__ bf16x8 frag_tr(LAS unsigned char* img, int row0, int c, int lane, int rmask) {
    const int g = lane >> 4, qq = (lane & 15) >> 2, p = lane & 3;
    const int r0 = row0 + ((8 * g + qq) & rmask), r1 = row0 + ((8 * g + 4 + qq) & rmask);
    return cat8(ldtr(img + offb(r0, 2 * c + (p >> 1)) + 8 * (p & 1)), ldtr(img + offb(r1, 2 * c + (p >> 1)) + 8 * (p & 1)));
}
__device__ __forceinline__ bf16x8 frag_q2(LAS unsigned char* img, int row0, int ks, int lane) {
    const int r = lane & 15, q = lane >> 4;
    return cat8(ld8(img + offb(row0 + r, 4 * ks + (q >> 1)) + 8 * (q & 1)), ld8(img + offb(row0 + r, 4 * ks + 2 + (q >> 1)) + 8 * (q & 1)));
}
__device__ __forceinline__ bf16x8 pack_acc(const f32x4& lo, const f32x4& hi) {
    v4u w; w.x = pg8::cvt_pk_bf16(lo[0], lo[1]); w.y = pg8::cvt_pk_bf16(lo[2], lo[3]); w.z = pg8::cvt_pk_bf16(hi[0], hi[1]); w.w = pg8::cvt_pk_bf16(hi[2], hi[3]);
    return __builtin_bit_cast(bf16x8, w);
}
__device__ __forceinline__ f32x4 mfma16(const bf16x8& a, const bf16x8& b, const f32x4& c) { return __builtin_amdgcn_mfma_f32_16x16x32_bf16(a, b, c, 0, 0, 0); }
__device__ __forceinline__ float rcpf_(float x) { return __builtin_amdgcn_rcpf(x); }
__device__ __forceinline__ float sigf(float x) { return rcpf_(1.f + __expf(-x)); }
__device__ __forceinline__ float silf(float x) { return x * rcpf_(1.f + __expf(-x)); }
__device__ __forceinline__ unsigned pkbf(float lo, float hi) { return pg8::cvt_pk_bf16(lo, hi); }
__device__ __forceinline__ void unpack8(const v4u& v, float (&o)[8]) {
#pragma unroll
    for (int e = 0; e < 4; ++e) { o[2 * e] = bf2f((unsigned short)(v[e] & 0xffffu)); o[2 * e + 1] = bf2f((unsigned short)(v[e] >> 16)); }
}

#define LN_FRESH(name) int name = lane; asm volatile("" : "+v"(name))
__device__ __forceinline__ void mixer_fast_phase(Ctx& F, int layer, int seg) {
    PHASE_TID();
    ARGS();
    const bf16* Pcur = (const bf16*)(A.ws + WS_P + (size_t)(seg & 1) * P_BYTES);
    const bf16* Pprev = (const bf16*)(A.ws + WS_P + (size_t)((seg & 1) ^ 1) * P_BYTES);
    const float* gates = (const float*)(A.ws + WS_GATES);
    const float* lbp = (const float*)(A.ws + WS_LB);
    bf16* Y = (bf16*)(A.ws + WS_Y);
    float* stC = (float*)(A.ws + WS_STC); float* stS = (float*)(A.ws + WS_STS); float* stN = (float*)(A.ws + WS_STN); float* stM = (float*)(A.ws + WS_STM);
    const float* cw = A.in[7] + (size_t)layer * 4 * 2048; const float* cb = A.in[8] + (size_t)layer * 2048;
    LAS unsigned char* L = F.lds;
    LAS float* MF = (LAS float*)(L + MF_OFF);
    for (int bh = blockIdx.x; bh < BATCH * NH; bh += F.G) {
        const int b = bh >> 3, h = bh & 7;
        for (int i = tid; i < 1280; i += NWAVES * 64) { const int blk = i / 640, j = (i % 640) >> 7, e = i & 127; MF[MF_CW + i] = j < 4 ? cw[(size_t)j * 2048 + blk * 1024 + h * 128 + e] : cb[blk * 1024 + h * 128 + e]; }
        for (int i = tid; i < 1024; i += NWAVES * 64) ((LAS unsigned*)(L + PH_OFF))[i] = 0u;
        if (tid < 256) MF[MF_WN + tid] = tid < 128 ? A.in[9][(size_t)layer * D + h * 128 + tid] : A.in[11][(size_t)layer * D + h * 128 + tid - 128];
        f32x4 Cacc[8], Sacc[8]; float mst;
        if (seg == 0) {
#pragma unroll
            for (int mb = 0; mb < 8; ++mb) { Cacc[mb] = (f32x4){0.f, 0.f, 0.f, 0.f}; Sacc[mb] = (f32x4){0.f, 0.f, 0.f, 0.f}; }
            mst = 0.f; if (tid < 128) MF[MF_N + tid] = 0.f;
        } else {
#pragma unroll
            for (int mb = 0; mb < 8; ++mb)
#pragma unroll
                for (int e = 0; e < 4; ++e) { Cacc[mb][e] = stC[((size_t)(bh * 8 + wave) * 32 + mb * 4 + e) * 64 + lane]; Sacc[mb][e] = stS[((size_t)(bh * 8 + wave) * 32 + mb * 4 + e) * 64 + lane]; }
            mst = stM[bh]; if (tid < 128) MF[MF_N + tid] = stN[bh * 128 + tid];
        }
        __syncthreads();
        for (int c = 0; c < SEGT / 64; ++c) {
            const int tl0 = 64 * c; const size_t grow0 = (size_t)b * SEQ + seg * SEGT + tl0;
            int lane; asm volatile("v_mbcnt_lo_u32_b32 %0, -1, 0\n\tv_mbcnt_hi_u32_b32 %0, -1, %0" : "=v"(lane)); const int tid = wave * 64 + lane;
            const int r = lane & 15, q = lane >> 4;
            float rowfac, decay, mnext;
            {
                const float gi = gates[(grow0 + lane) * 16 + h] * (2.f / 15.f), gf = gates[(grow0 + lane) * 16 + 8 + h] * (2.f / 15.f);
                const float li = 15.f - 30.f * rcpf_(1.f + __expf(gi));
                const float zf = 15.f - 30.f * rcpf_(1.f + __expf(gf));
                const float lf = fminf(zf, 0.f) - __logf(1.f + __expf(-fabsf(zf)));
                float bc = lf;
#pragma unroll
                for (int d = 1; d < 64; d <<= 1) { const float t = __shfl_up(bc, d); if (lane >= d) bc += t; }
                const float a = li - bc; float am = a;
#pragma unroll
                for (int o = 1; o < 64; o <<= 1) am = fmaxf(am, __shfl_xor(am, o));
                const float abar = fmaxf(mst, am);
                rowfac = __expf(a - abar) * 0.08838834764831845f;
                decay = __expf(mst - abar); mnext = __shfl(bc, 63) + abar;
                if (wave == 0) MF[MF_DFL + lane] = __expf(-(bc + abar));
            }
#pragma unroll
            for (int pass = 0; pass < 2; ++pass) {
                const int t = (tid >> 4) + 32 * pass, ch = tid & 15, tl = tl0 + t;
                const float rf = __shfl(rowfac, t);
                const bf16* pr0 = Pcur + (size_t)(b * SEGT + tl) * PW + h * HB + ch * 8;
#pragma unroll
                for (int blk = 0; blk < 2; ++blk) {
                    float acc[8];
                    { const f32x4 b0 = *(const LAS f32x4*)(MF + MF_CW + blk * 640 + 512 + ch * 8), b1 = *(const LAS f32x4*)(MF + MF_CW + blk * 640 + 512 + ch * 8 + 4);
                      acc[0] = b0[0]; acc[1] = b0[1]; acc[2] = b0[2]; acc[3] = b0[3]; acc[4] = b1[0]; acc[5] = b1[1]; acc[6] = b1[2]; acc[7] = b1[3]; }
#pragma unroll
                    for (int j = 0; j < 4; ++j) {
                        const int tq = tl - 3 + j;
                        if (seg * SEGT + tq >= 0) {
                            const bf16* prj = tq >= 0 ? Pcur + (size_t)(b * SEGT + tq) * PW : Pprev + (size_t)(b * SEGT + SEGT + tq) * PW;
                            const v4u raw = *(const GAS v4u*)(prj + h * HB + (blk == 0 ? PO_MQ : PO_MK) + ch * 8);
                            float x[8]; unpack8(raw, x);
                            const f32x4 w0 = *(const LAS f32x4*)(MF + MF_CW + blk * 640 + j * 128 + ch * 8), w1 = *(const LAS f32x4*)(MF + MF_CW + blk * 640 + j * 128 + ch * 8 + 4);
#pragma unroll
                            for (int e = 0; e < 4; ++e) { acc[e] += w0[e] * x[e]; acc[4 + e] += w1[e] * x[4 + e]; }
                        }
                    }
                    const float sc = blk == 0 ? 1.f : rf;
                    v4u o; o.x = pkbf(silf(acc[0]) * sc, silf(acc[1]) * sc); o.y = pkbf(silf(acc[2]) * sc, silf(acc[3]) * sc); o.z = pkbf(silf(acc[4]) * sc, silf(acc[5]) * sc); o.w = pkbf(silf(acc[6]) * sc, silf(acc[7]) * sc);
                    *(LAS v4u*)(L + (blk == 0 ? IMG_QM : IMG_KM) + offb(t, ch)) = o;
                }
                *(LAS v4u*)(L + IMG_VM + offb(t, ch)) = *(const GAS v4u*)(pr0 + PO_MV);
                *(LAS v4u*)(L + IMG_HV + offb(t, ch)) = *(const GAS v4u*)(pr0 + PO_HI);
            }
            {
                const int j = wave & 3, hh = wave >> 2, trow = 16 * j + 8 * hh;
                const bf16* pr = Pcur + (size_t)(b * SEGT + tl0 + trow) * PW + h * HB + 2 * lane;
                unsigned rq[8], rf[8];
#pragma unroll
                for (int i = 0; i < 8; ++i) { rq[i] = *(const GAS unsigned*)(pr + (size_t)i * PW + PO_HQ); rf[i] = *(const GAS unsigned*)(pr + (size_t)i * PW + PO_HF); }
                float lb0 = 0.f, lb1 = 0.f; if (layer != 0) { lb0 = lbp[h * 128 + 2 * lane]; lb1 = lbp[h * 128 + 2 * lane + 1]; }
                float l0[8], l1[8], k0[8], k1[8], q0[8], q1[8];
#pragma unroll
                for (int i = 0; i < 8; ++i) {
                    const float s0 = sigf(bf2f((unsigned short)(rf[i] & 0xffffu))), s1 = sigf(bf2f((unsigned short)(rf[i] >> 16)));
                    l0[i] = __logf(lb0 + (1.f - lb0) * s0); l1[i] = __logf(lb1 + (1.f - lb1) * s1);
                    k0[i] = (1.f - lb0) * (1.f - s0); k1[i] = (1.f - lb1) * (1.f - s1);
                    q0[i] = silf(bf2f((unsigned short)(rq[i] & 0xffffu))); q1[i] = silf(bf2f((unsigned short)(rq[i] >> 16)));
                }
                float run0 = 0.f, run1 = 0.f;
#pragma unroll
                for (int ii = 0; ii < 8; ++ii) {
                    const int i = hh ? ii : 7 - ii;
                    if (hh) { run0 += l0[i]; run1 += l1[i]; }
                    const float e0 = hh ? run0 : -run0, e1 = hh ? run1 : -run1;
                    const unsigned o = offb(trow + i, lane >> 2) + 4 * (lane & 3);
                    *(LAS unsigned*)(L + IMG_HQT + o) = pkbf(q0[i] * __expf(e0), q1[i] * __expf(e1));
                    *(LAS unsigned*)(L + IMG_HKT + o) = pkbf(k0[i] * __expf(-e0), k1[i] * __expf(-e1));
                    if (!hh) { run0 += l0[i]; run1 += l1[i]; }
                }
                typedef float f32x2 __attribute__((ext_vector_type(2)));
                *(LAS f32x2*)(MF + (hh ? MF_E157 : MF_E7) + j * 128 + 2 * lane) = (f32x2){__expf(run0), __expf(run1)};
            }
            __syncthreads();
            {
                const int tb = wave >> 1; float psum = 0.f;
#pragma unroll
                for (int s2 = 0; s2 < 2; ++s2) {
                    const int sb = 2 * (wave & 1) + s2; LN_FRESH(ln);
                    f32x4 acc = (f32x4){0.f, 0.f, 0.f, 0.f};
#pragma unroll
                    for (int ks = 0; ks < 4; ++ks) acc = mfma16(frag_row(L + IMG_KM, 16 * sb, ks, ln), frag_row(L + IMG_QM, 16 * tb, ks, ln), acc);
                    const int t = 16 * tb + r, s0 = 16 * sb + 4 * q;
                    float v[4];
#pragma unroll
                    for (int e = 0; e < 4; ++e) { v[e] = (s0 + e <= t) ? acc[e] : 0.f; psum += v[e]; }
                    v2u w; w.x = pkbf(v[0], v[1]); w.y = pkbf(v[2], v[3]);
                    *(LAS v2u*)(L + IMG_P + 128 * t + 16 * ((2 * sb + (q >> 1)) ^ (t & 7)) + 8 * (q & 1)) = w;
                }
                psum += __shfl_xor(psum, 16); psum += __shfl_xor(psum, 32);
                if (q == 0) MF[MF_RS + 2 * (16 * tb + r) + (wave & 1)] = psum;
            }
            {
                const int t = tid >> 3, part = tid & 7;
                const v4u a0 = *(const LAS v4u*)(L + IMG_QM + offb(t, 2 * part)), a1 = *(const LAS v4u*)(L + IMG_QM + offb(t, 2 * part + 1));
                float x0[8], x1[8]; unpack8(a0, x0); unpack8(a1, x1);
                float d = 0.f;
#pragma unroll
                for (int e4 = 0; e4 < 2; ++e4) { const f32x4 n0 = *(const LAS f32x4*)(MF + MF_N + 16 * part + 4 * e4), n1 = *(const LAS f32x4*)(MF + MF_N + 16 * part + 8 + 4 * e4);
#pragma unroll
                    for (int e = 0; e < 4; ++e) { d += x0[4 * e4 + e] * n0[e]; d += x1[4 * e4 + e] * n1[e]; } }
                d += __shfl_xor(d, 1); d += __shfl_xor(d, 2); d += __shfl_xor(d, 4);
                if (part == 0) MF[MF_QN + t] = d;
            }
            if (wave >= 4) {
                const int j = wave - 4; LN_FRESH(ln);
                f32x4 acc = (f32x4){0.f, 0.f, 0.f, 0.f};
#pragma unroll
                for (int ks = 0; ks < 4; ++ks) acc = mfma16(frag_row(L + IMG_HKT, 16 * j, ks, ln), frag_row(L + IMG_HQT, 16 * j, ks, ln), acc);
                float v[4];
#pragma unroll
                for (int e = 0; e < 4; ++e) v[e] = (4 * q + e <= r) ? acc[e] : 0.f;
                v2u w; w.x = pkbf(v[0], v[1]); w.y = pkbf(v[2], v[3]);
                *(LAS v2u*)(L + PH_OFF + j * 1024 + r * 64 + 8 * q) = w;
            }
            __syncthreads();
            f32x4 hval[4], oacc[4];
            {
                f32x4 Cd[8];
#pragma unroll
                for (int mb = 0; mb < 8; ++mb) Cd[mb] = Cacc[mb] * decay;
                bf16x8 bC[4], bV[2];
#pragma unroll
                for (int ks = 0; ks < 4; ++ks) bC[ks] = pack_acc(Cd[2 * ks], Cd[2 * ks + 1]);
#pragma unroll
                for (int ks = 0; ks < 2; ++ks) { LN_FRESH(ln); bV[ks] = frag_tr(L + IMG_VM, 32 * ks, wave, ln, 31); }
#pragma unroll
                for (int mt = 0; mt < 4; ++mt) {
                    f32x4 acc = (f32x4){0.f, 0.f, 0.f, 0.f}; LN_FRESH(ln);
#pragma unroll
                    for (int ks = 0; ks < 4; ++ks) acc = mfma16(frag_q2(L + IMG_QM, 16 * mt, ks, ln), bC[ks], acc);
#pragma unroll
                    for (int ks = 0; ks < 2; ++ks) { const int t = 16 * mt + r; acc = mfma16(ld16(L + IMG_P + 128 * t + 16 * ((4 * ks + q) ^ (t & 7))), bV[ks], acc); }
                    const int t0 = 16 * mt + 4 * q;
                    const f32x4 r0 = *(const LAS f32x4*)(MF + MF_RS + 2 * t0), r1 = *(const LAS f32x4*)(MF + MF_RS + 2 * t0 + 4), qn4 = *(const LAS f32x4*)(MF + MF_QN + t0), df4 = *(const LAS f32x4*)(MF + MF_DFL + t0);
                    const float den0 = r0[0] + r0[1] + decay * qn4[0], den1 = r0[2] + r0[3] + decay * qn4[1], den2 = r1[0] + r1[1] + decay * qn4[2], den3 = r1[2] + r1[3] + decay * qn4[3];
                    hval[mt][0] = acc[0] * rcpf_(fmaxf(fabsf(den0), df4[0])); hval[mt][1] = acc[1] * rcpf_(fmaxf(fabsf(den1), df4[1])); hval[mt][2] = acc[2] * rcpf_(fmaxf(fabsf(den2), df4[2])); hval[mt][3] = acc[3] * rcpf_(fmaxf(fabsf(den3), df4[3]));
                }
#pragma unroll
                for (int mb = 0; mb < 8; ++mb) {
                    f32x4 acc = Cd[mb]; LN_FRESH(ln);
#pragma unroll
                    for (int ks = 0; ks < 2; ++ks) acc = mfma16(frag_tr(L + IMG_KM, 32 * ks, mb, ln, 31), bV[ks], acc);
                    Cacc[mb] = acc;
                }
                {
                    const int ch = tid & 15, sg = tid >> 4;
                    const v4u a0 = *(const LAS v4u*)(L + IMG_KM + offb(2 * sg, ch)), a1 = *(const LAS v4u*)(L + IMG_KM + offb(2 * sg + 1, ch));
                    float x0[8], x1[8]; unpack8(a0, x0); unpack8(a1, x1);
                    float ps[8];
#pragma unroll
                    for (int e = 0; e < 8; ++e) { ps[e] = x0[e] + x1[e]; ps[e] += __shfl_xor(ps[e], 16); ps[e] += __shfl_xor(ps[e], 32); }
                    if (lane < 16) { *(LAS f32x4*)(MF + MF_NRED + wave * 128 + 8 * ch) = (f32x4){ps[0], ps[1], ps[2], ps[3]}; *(LAS f32x4*)(MF + MF_NRED + wave * 128 + 8 * ch + 4) = (f32x4){ps[4], ps[5], ps[6], ps[7]}; }
                }
            }
#pragma unroll
            for (int j = 0; j < 4; ++j) {
                f32x4 T[8];
#pragma unroll
                for (int mb = 0; mb < 8; ++mb) T[mb] = Sacc[mb] * *(const LAS f32x4*)(MF + MF_E7 + j * 128 + 16 * mb + 4 * q);
                bf16x8 bS[4];
#pragma unroll
                for (int ks = 0; ks < 4; ++ks) bS[ks] = pack_acc(T[2 * ks], T[2 * ks + 1]);
                f32x4 acc = (f32x4){0.f, 0.f, 0.f, 0.f};
                { LN_FRESH(ln);
#pragma unroll
                for (int ks = 0; ks < 4; ++ks) acc = mfma16(frag_q2(L + IMG_HQT, 16 * j, ks, ln), bS[ks], acc); }
                LN_FRESH(ln2);
                const bf16x8 bVh = frag_tr(L + IMG_HV, 16 * j, wave, ln2, 15);
                acc = mfma16(ld16(L + PH_OFF + j * 1024 + r * 64 + 16 * q), bVh, acc);
                oacc[j] = acc;
#pragma unroll
                for (int mb = 0; mb < 8; ++mb) {
                    LN_FRESH(ln3);
                    bf16x8 aK = frag_tr(L + IMG_HKT, 16 * j, mb, ln3, 15);
                    if (q >= 2) aK = (bf16x8){0, 0, 0, 0, 0, 0, 0, 0};
                    Sacc[mb] = mfma16(aK, bVh, T[mb]) * *(const LAS f32x4*)(MF + MF_E157 + j * 128 + 16 * mb + 4 * q);
                }
            }
            __syncthreads();
            const int t4 = tid >> 3, c8 = tid & 7;
            const bf16* pc = Pcur + (size_t)(b * SEGT + tl0 + t4) * PW + h * HB + 16 * c8;
            const v4u ca0 = *(const GAS v4u*)(pc + PO_CA), ca1 = *(const GAS v4u*)(pc + PO_CA + 8), cb0 = *(const GAS v4u*)(pc + PO_CB), cb1 = *(const GAS v4u*)(pc + PO_CB + 8);
#pragma unroll
            for (int mt = 0; mt < 4; ++mt)
#pragma unroll
                for (int e = 0; e < 4; ++e) { const int tt = 16 * mt + 4 * q + e, dvc = 16 * wave + r; const unsigned o = offb(tt, dvc >> 3) + 2 * (dvc & 7);
                    *(LAS unsigned short*)(L + HAB_OFF + o) = (unsigned short)(pkbf(hval[mt][e], hval[mt][e]) & 0xffffu); *(LAS unsigned short*)(L + OBB_OFF + o) = (unsigned short)(pkbf(oacc[mt][e], oacc[mt][e]) & 0xffffu); }
            if (tid < 128) { float s = decay * MF[MF_N + tid];
#pragma unroll
                for (int w = 0; w < 8; ++w) s += MF[MF_NRED + w * 128 + tid];
                MF[MF_N + tid] = s; }
            __syncthreads();
            {
                float ha[16], ob[16], ca[16], cb[16];
                { const v4u a0 = *(const LAS v4u*)(L + HAB_OFF + offb(t4, 2 * c8)), a1 = *(const LAS v4u*)(L + HAB_OFF + offb(t4, 2 * c8 + 1)), b0 = *(const LAS v4u*)(L + OBB_OFF + offb(t4, 2 * c8)), b1 = *(const LAS v4u*)(L + OBB_OFF + offb(t4, 2 * c8 + 1));
                  float x[8]; unpack8(a0, x);
#pragma unroll
                  for (int e = 0; e < 8; ++e) ha[e] = x[e];
                  unpack8(a1, x);
#pragma unroll
                  for (int e = 0; e < 8; ++e) ha[8 + e] = x[e];
                  unpack8(b0, x);
#pragma unroll
                  for (int e = 0; e < 8; ++e) ob[e] = x[e];
                  unpack8(b1, x);
#pragma unroll
                  for (int e = 0; e < 8; ++e) ob[8 + e] = x[e];
                  unpack8(ca0, x);
#pragma unroll
                  for (int e = 0; e < 8; ++e) ca[e] = x[e];
                  unpack8(ca1, x);
#pragma unroll
                  for (int e = 0; e < 8; ++e) ca[8 + e] = x[e];
                  unpack8(cb0, x);
#pragma unroll
                  for (int e = 0; e < 8; ++e) cb[e] = x[e];
                  unpack8(cb1, x);
#pragma unroll
                  for (int e = 0; e < 8; ++e) cb[8 + e] = x[e]; }
                float ssa = 0.f, ssb = 0.f;
#pragma unroll
                for (int e = 0; e < 16; ++e) { ssa += ha[e] * ha[e]; ssb += ob[e] * ob[e]; }
#pragma unroll
                for (int o = 1; o < 8; o <<= 1) { ssa += __shfl_xor(ssa, o); ssb += __shfl_xor(ssb, o); }
                const float ra = rsqrtf(ssa * (1.f / 128.f) + RMS_EPS), rb = rsqrtf(ssb * (1.f / 128.f) + RMS_EPS);
                float y[16];
#pragma unroll
                for (int e4 = 0; e4 < 4; ++e4) { const f32x4 wa = *(const LAS f32x4*)(MF + MF_WN + 16 * c8 + 4 * e4), wb = *(const LAS f32x4*)(MF + MF_WN + 128 + 16 * c8 + 4 * e4);
#pragma unroll
                    for (int e = 0; e < 4; ++e) y[4 * e4 + e] = ca[4 * e4 + e] * (ha[4 * e4 + e] * ra * wa[e]) + cb[4 * e4 + e] * (ob[4 * e4 + e] * rb * wb[e]); }
                v4u o0, o1; o0.x = pkbf(y[0], y[1]); o0.y = pkbf(y[2], y[3]); o0.z = pkbf(y[4], y[5]); o0.w = pkbf(y[6], y[7]); o1.x = pkbf(y[8], y[9]); o1.y = pkbf(y[10], y[11]); o1.z = pkbf(y[12], y[13]); o1.w = pkbf(y[14], y[15]);
                bf16* yp = Y + (grow0 + t4) * D + h * 128 + 16 * c8;
                *(GAS v4u*)yp = o0; *(GAS v4u*)(yp + 8) = o1;
            }
            mst = mnext;
        }
        int lane_s; asm volatile("v_mbcnt_lo_u32_b32 %0, -1, 0\n\tv_mbcnt_hi_u32_b32 %0, -1, %0" : "=v"(lane_s));
#pragma unroll
        for (int mb = 0; mb < 8; ++mb)
#pragma unroll
            for (int e = 0; e < 4; ++e) { stC[((size_t)(bh * 8 + wave) * 32 + mb * 4 + e) * 64 + lane_s] = Cacc[mb][e]; stS[((size_t)(bh * 8 + wave) * 32 + mb * 4 + e) * 64 + lane_s] = Sacc[mb][e]; }
        __syncthreads();
        if (tid < 128) stN[bh * 128 + tid] = MF[MF_N + tid];
        if (tid == 0) stM[bh] = mst;
        __syncthreads();
    }
}

__global__ void __launch_bounds__(NWAVES * 64, 2) fwd_kernel(Args kernel_args_unused) {
    extern __shared__ __attribute__((aligned(16))) unsigned char lds[];
    Ctx F;
    F.lds = (LAS unsigned char*)lds;
    F.wave_s = __builtin_amdgcn_readfirstlane(threadIdx.x >> 6);
    F.G = gridDim.x; { const int bx = blockIdx.x; F.vcu = (F.G % 8 == 0) ? (bx % 8) * (F.G / 8) + bx / 8 : bx; }
    volatile LAS unsigned* MISC = (volatile LAS unsigned*)(F.lds + MISC_OFF);
    if (threadIdx.x < 64) MISC[threadIdx.x] = 0u;
    __syncthreads();
    unsigned bar_x;
    { ARGS(); const XcdBarrier b0 = xcd_barrier_post((unsigned*)((gu32*)(A.ws + WS_CTL) + CW_BAR), MISC + 8); bar_x = b0.x; }
#define GRID_BAR() do { ARGS(); XcdBarrier bb; bb.bar = (unsigned*)((gu32*)(A.ws + WS_CTL) + CW_BAR); bb.x = bar_x; asm volatile("" : "+s"(bb.x)); bb.st = (volatile LAS unsigned*)(F.lds + MISC_OFF) + 8; xcd_barrier(bb); } while (0)

    p0_prologue(F);
    GRID_BAR();

    for (int layer = 0; layer < DEPTH; ++layer) {
#define PHASE_PTRS() ARGS(); const float* src = layer == 0 ? A.in[0] : (const float*)A.out; const float* modl = (const float*)(A.ws + WS_MOD) + (size_t)layer * BATCH * MODW; bf16* hn = (bf16*)(A.ws + WS_HN); (void)src; (void)modl; (void)hn
#ifdef PROBE_EW2
        { PHASE_PTRS();
        norm_phase<true>(F, src, A.in[4] + (size_t)layer * D, modl, 0, D, hn, (float*)(A.ws + WS_GATES), (const float*)(A.ws + WS_WG) + (size_t)layer * 16 * D, (const float*)(A.ws + WS_BG) + layer * 16); __syncthreads(); }
#endif
        { PHASE_PTRS();
        norm_phase<true>(F, src, A.in[4] + (size_t)layer * D, modl, 0, D, hn, (float*)(A.ws + WS_GATES), (const float*)(A.ws + WS_WG) + (size_t)layer * 16 * D, (const float*)(A.ws + WS_BG) + layer * 16); }
        GRID_BAR();
        for (int seg = 0; seg < NSEG; ++seg) {
            {
                PHASE_PTRS();
                pg8::Gemm g{hn, (const bf16*)(A.ws + WS_WIN) + (size_t)layer * NPROJ * D, SEGROWS, NPROJ, D, NSEG, seg};
                pg8::StaticOrder S; S.init(SEGROWS, NPROJ, F.G, (int)blockIdx.x);
                pg8::EpiInProj E{(bf16*)(A.ws + WS_P + (size_t)(seg & 1) * P_BYTES), PW, (const float*)(A.ws + WS_BIASP) + (size_t)layer * NPROJ};
                pg8::gemm_phase<pg8::EpiInProj, pg8::StaticOrder, PG8_ALIGN, PG8_SP2>(F.lds + RING_OFF, g, S, E, F.wave_s);
            }
            GRID_BAR();
            mixer_fast_phase(F, layer, seg);
            GRID_BAR();
        }
        {
            PHASE_PTRS();
            pg8::Gemm g{(const bf16*)(A.ws + WS_Y), (const bf16*)(A.ws + WS_WOUT) + (size_t)layer * D * D, M, D, D, 1, 0};
            pg8::StaticOrder S; S.init(M, D, F.G, (int)blockIdx.x);
            pg8::EpiResid E{src, A.out, D, modl + 2 * D, MODW, 0};
#ifdef PROBE_GEMM2
            { pg8::EpiResid E2 = E; E2.out = (float*)(A.ws + WS_P); pg8::gemm_phase<pg8::EpiResid, pg8::StaticOrder, PG8_ALIGN, PG8_SP2>(F.lds + RING_OFF, g, S, E2, F.wave_s); __syncthreads(); }
#endif
            pg8::gemm_phase<pg8::EpiResid, pg8::StaticOrder, PG8_ALIGN, PG8_SP2>(F.lds + RING_OFF, g, S, E, F.wave_s);
        }
        GRID_BAR();
#ifdef PROBE_EW2
        { PHASE_PTRS();
        norm_phase<false>(F, (const float*)A.out, A.in[13] + (size_t)layer * D, modl, 3 * D, 4 * D, hn, nullptr, nullptr, nullptr); __syncthreads(); }
#endif
        { PHASE_PTRS();
        norm_phase<false>(F, (const float*)A.out, A.in[13] + (size_t)layer * D, modl, 3 * D, 4 * D, hn, nullptr, nullptr, nullptr); }
        GRID_BAR();
        for (int fs = 0; fs < FSEG; ++fs) {
            {
                PHASE_PTRS();
                pg8::Gemm g{hn + (size_t)fs * FROWS * D, (const bf16*)(A.ws + WS_WUP) + (size_t)layer * 2 * DFF * D, FROWS, 2 * DFF, D, 1, 0};
                pg8::StaticOrder S; S.init(FROWS, 2 * DFF, F.G, (int)blockIdx.x);
                pg8::EpiBf16B E{(bf16*)(A.ws + WS_U), 2 * DFF, nullptr};
#ifdef PROBE_GEMM2
                { pg8::EpiBf16B E2 = E; E2.O = (bf16*)(A.ws + WS_G); pg8::gemm_phase<pg8::EpiBf16B, pg8::StaticOrder, PG8_ALIGN, PG8_SP2>(F.lds + RING_OFF, g, S, E2, F.wave_s); __syncthreads(); }
#endif
                pg8::gemm_phase<pg8::EpiBf16B, pg8::StaticOrder, PG8_ALIGN, PG8_SP2>(F.lds + RING_OFF, g, S, E, F.wave_s);
            }
            GRID_BAR();
#ifdef PROBE_EW2
            { ARGS(); ffn_glu_phase(F, (const bf16*)(A.ws + WS_U), (bf16*)(A.ws + WS_G), A.in[15] + (size_t)layer * 3 * 2 * DFF, A.in[16] + (size_t)layer * 2 * DFF); __syncthreads(); }
#endif
            { ARGS(); ffn_glu_phase(F, (const bf16*)(A.ws + WS_U), (bf16*)(A.ws + WS_G), A.in[15] + (size_t)layer * 3 * 2 * DFF, A.in[16] + (size_t)layer * 2 * DFF); }
            GRID_BAR();
            {
                PHASE_PTRS();
                pg8::Gemm g{(const bf16*)(A.ws + WS_G), (const bf16*)(A.ws + WS_WDN) + (size_t)layer * D * DFF, FROWS, D, DFF, 1, 0};
                pg8::StaticOrder S; S.init(FROWS, D, F.G, (int)blockIdx.x);
                pg8::EpiResid E{(const float*)A.out, A.out, D, modl + 5 * D, MODW, fs * FROWS};
#ifdef PROBE_GEMM2
                { pg8::EpiResid E2 = E; E2.out = (float*)(A.ws + 778 * MiB) - (size_t)fs * FROWS * D; pg8::gemm_phase<pg8::EpiResid, pg8::StaticOrder, PG8_ALIGN, PG8_SP2>(F.lds + RING_OFF, g, S, E2, F.wave_s); __syncthreads(); }
#endif
                pg8::gemm_phase<pg8::EpiResid, pg8::StaticOrder, PG8_ALIGN, PG8_SP2>(F.lds + RING_OFF, g, S, E, F.wave_s);
            }
            GRID_BAR();
        }
    }
    { ARGS(); final_norm_phase(F, A.out, A.in[18]); }
#undef GRID_BAR
}

extern "C" void kernel_launch(void* const* d_in, const int* in_sizes, int n_in, void* d_out, int out_size, void* d_ws, size_t ws_size, hipStream_t stream) {
    static int grid = 0;
    if (grid == 0) {
        if (n_in != 19 || in_sizes[0] != M * D || out_size != M * D || ws_size < WS_END) { fprintf(stderr, "kernel_launch: unexpected shapes (n_in %d, in0 %d, out %d, ws %zu; need ws >= %zu); nothing launched\n", n_in, n_in > 0 ? in_sizes[0] : -1, out_size, ws_size, (size_t)WS_END); grid = -1; return; }
        int dev = 0, cus = 0, per_cu = 0;
        if (hipGetDevice(&dev) != hipSuccess || hipDeviceGetAttribute(&cus, hipDeviceAttributeMultiprocessorCount, dev) != hipSuccess) { grid = -1; return; }
        if (hipFuncSetAttribute((const void*)fwd_kernel, hipFuncAttributeMaxDynamicSharedMemorySize, LDS_BYTES) != hipSuccess) { fprintf(stderr, "kernel_launch: hipFuncSetAttribute failed\n"); grid = -1; return; }
        if (hipOccupancyMaxActiveBlocksPerMultiprocessor(&per_cu, (const void*)fwd_kernel, NWAVES * 64, LDS_BYTES) != hipSuccess || per_cu < 1)
            fprintf(stderr, "kernel_launch: note: occupancy query reports %d workgroups per CU\n", per_cu);
        (void)hipGetLastError();
        grid = cus;
    }
    if (grid < 0) return;
    if (hipMemsetAsync((char*)d_ws + WS_CTL, 0, CTL_ZERO_BYTES, stream) != hipSuccess) return;
    Args a{};
    for (int i = 0; i < 19; ++i) a.in[i] = (const float*)d_in[i];
    a.out = (float*)d_out; a.ws = (unsigned char*)d_ws;
    hipLaunchKernelGGL(fwd_kernel, dim3(grid), dim3(NWAVES * 64), LDS_BYTES, stream, a);
}
```

```cpp
#include <hip/hip_runtime.h>
#include <cstdio>
#include <cstdint>
namespace pg8 {
#define PG8_LAS __attribute__((address_space(3)))
typedef unsigned short bf16_t;
typedef short bf16x8 __attribute__((ext_vector_type(8)));
typedef float f32x4 __attribute__((ext_vector_type(4)));
typedef unsigned u32x4 __attribute__((ext_vector_type(4)));
constexpr int BM = 256, BK = 64, HALF = 128, HTB = HALF * BK * 2  , STAGE_BYTES = 8 * HTB, NXCD = 8, WGM = 8;

__host__ __device__ __forceinline__ int lds_byte(int r, int c) { const int st = (r >> 4) * 2 + (c >> 5), rr = r & 15, cc = c & 31, ob = rr * 64 + cc * 2; return st * 1024 + (ob ^ (((ob >> 9) & 1) << 5)); }
__host__ __device__ __forceinline__ void stage_rc(int b, int& R, int& C) { const int st = b / 1024, sb = b % 1024, swz = sb ^ (((sb >> 9) & 1) << 5); R = (st >> 1) * 16 + swz / 64; C = (st & 1) * 32 + (swz % 64) / 2; }
__host__ __device__ __forceinline__ int perm32(int rho) { const int n = rho >> 4, i = rho & 15; return 8 * (i >> 2) + 4 * n + (i & 3); }

struct Unit { int pm, pn; };
struct Gemm { const bf16_t* A; const bf16_t* Bt; int M, N, K; int a_sh, a_mul, a_add, a_mask;
    __device__ __forceinline__ int atile(int pm) const { return (pm >> a_sh) * a_mul + a_add + (pm & a_mask); } };

struct StaticOrder {
    int nM, nN, nwg, G, c;
    __host__ __device__ void init(int M, int N, int G_, int c_) { nM = M / BM; nN = N / BM; nwg = nM * nN; G = G_; c = c_; }
    __host__ __device__ bool next(int i, Unit& u) const {
        const long L = (long)i * G + c; if (L >= nwg) return false;
        int wgid = (int)L; { const int q = nwg / NXCD, r = nwg % NXCD, xcd = wgid % NXCD, off = wgid / NXCD; wgid = (xcd < r ? xcd * (q + 1) : r * (q + 1) + (xcd - r) * q) + off; }
        const int nig = WGM * nN, gid = wgid / nig, fm = gid * WGM, gsz = (nM - fm) < WGM ? (nM - fm) : WGM;
        u.pm = fm + ((wgid % nig) % gsz); u.pn = (wgid % nig) / gsz; return true;
    }
    __device__ __forceinline__ void a_ready(const Unit&) const {}
    __device__ __forceinline__ void done(const Unit&) const {}
};

__device__ __forceinline__ unsigned cvt_pk_bf16(float lo, float hi) { unsigned r; asm volatile("v_cvt_pk_bf16_f32 %0, %1, %2" : "=v"(r) : "v"(lo), "v"(hi)); return r; }

struct EpiBf16B {
    static constexpr bool PERM = true, AFTER_DRAIN = false;
    bf16_t* O; int ldc; const float* bias;
    __device__ __forceinline__ void operator()(const f32x4 (&acc)[2][2][4][2], const Unit& u, int wr, int wc, int fr, int fq) const {
        const int row0 = u.pm * BM + wr * 64 + fr; const int col0 = u.pn * BM + wc * 32 + 8 * fq;
        f32x4 bv[2][2];
#pragma unroll
        for (int bj = 0; bj < 2; ++bj)
#pragma unroll
            for (int n = 0; n < 2; ++n) bv[bj][n] = bias ? *(const f32x4*)(bias + col0 + bj * HALF + 4 * n) : (f32x4){0.f, 0.f, 0.f, 0.f};
#pragma unroll
        for (int ai = 0; ai < 2; ++ai)
#pragma unroll
            for (int m = 0; m < 4; ++m) { bf16_t* rowp = O + (size_t)(row0 + ai * HALF + m * 16) * ldc + col0;
#pragma unroll
                for (int bj = 0; bj < 2; ++bj) { const f32x4 v0 = acc[ai][bj][m][0] + bv[bj][0], v1 = acc[ai][bj][m][1] + bv[bj][1];
                    u32x4 w; w.x = cvt_pk_bf16(v0[0], v0[1]); w.y = cvt_pk_bf16(v0[2], v0[3]); w.z = cvt_pk_bf16(v1[0], v1[1]); w.w = cvt_pk_bf16(v1[2], v1[3]);
                    *(u32x4*)(rowp + bj * HALF) = w; } }
    }
};
struct EpiResid {
    static constexpr bool PERM = false, AFTER_DRAIN = false;
    const float* res; float* out; int ldc; const float* gate; int gstride; int row_off;
    __device__ __forceinline__ void operator()(const f32x4 (&acc)[2][2][4][2], const Unit& u, int wr, int wc, int fr, int fq) const {
        const int rbase = row_off + u.pm * BM; const int b = rbase >> 11;
        const int row0 = rbase + wr * 64 + fr, col0 = u.pn * BM + wc * 32 + 4 * fq;
        const float* gp = gate + (size_t)b * gstride + col0;
        f32x4 gv[2][2];
#pragma unroll
        for (int bj = 0; bj < 2; ++bj)
#pragma unroll
            for (int n = 0; n < 2; ++n) gv[bj][n] = *(const f32x4*)(gp + bj * HALF + n * 16);
#pragma unroll
        for (int ai = 0; ai < 2; ++ai)
#pragma unroll
            for (int m = 0; m < 4; ++m) { const size_t off = (size_t)(row0 + ai * HALF + m * 16) * ldc + col0;
#pragma unroll
                for (int bj = 0; bj < 2; ++bj)
#pragma unroll
                    for (int n = 0; n < 2; ++n) { const f32x4 r = *(const f32x4*)(res + off + bj * HALF + n * 16);
                        *(f32x4*)(out + off + bj * HALF + n * 16) = r + gv[bj][n] * acc[ai][bj][m][n]; } }
    }
};


struct EpiInProj {
    static constexpr bool PERM = true, AFTER_DRAIN = false;
    bf16_t* O; int ldc; const float* bias;
    __device__ __forceinline__ void operator()(const f32x4 (&acc)[2][2][4][2], const Unit& u, int wr, int wc, int fr, int fq) const {
        const int head = u.pn / 5, part = u.pn - 5 * head;
        const int row0 = u.pm * BM + wr * 64 + fr, cin = wc * 32 + 8 * fq;
        f32x4 bv[2][2];
#pragma unroll
        for (int bj = 0; bj < 2; ++bj)
#pragma unroll
            for (int n = 0; n < 2; ++n) bv[bj][n] = *(const f32x4*)(bias + u.pn * BM + bj * HALF + cin + 4 * n);
        if (part < 3) {
#pragma unroll
            for (int ai = 0; ai < 2; ++ai)
#pragma unroll
                for (int m = 0; m < 4; ++m) { bf16_t* rowp = O + (size_t)(row0 + ai * HALF + m * 16) * ldc + head * 1024 + part * 256 + cin;
#pragma unroll
                    for (int bj = 0; bj < 2; ++bj) { const f32x4 v0 = acc[ai][bj][m][0] + bv[bj][0], v1 = acc[ai][bj][m][1] + bv[bj][1];
                        u32x4 w; w.x = cvt_pk_bf16(v0[0], v0[1]); w.y = cvt_pk_bf16(v0[2], v0[3]); w.z = cvt_pk_bf16(v1[0], v1[1]); w.w = cvt_pk_bf16(v1[2], v1[3]);
                        *(u32x4*)(rowp + bj * HALF) = w; } }
        } else {
            const bool silu0 = part == 4;
#pragma unroll
            for (int ai = 0; ai < 2; ++ai)
#pragma unroll
                for (int m = 0; m < 4; ++m) { bf16_t* rowp = O + (size_t)(row0 + ai * HALF + m * 16) * ldc + head * 1024 + 768 + (part - 3) * 128 + cin;
                    float c[8];
#pragma unroll
                    for (int n = 0; n < 2; ++n) { const f32x4 x0 = acc[ai][0][m][n] + bv[0][n], x1 = acc[ai][1][m][n] + bv[1][n];
#pragma unroll
                        for (int e = 0; e < 4; ++e) { const float s0 = __builtin_amdgcn_rcpf(1.f + __expf(-x0[e])), s1 = __builtin_amdgcn_rcpf(1.f + __expf(-x1[e])); c[4 * n + e] = (silu0 ? x0[e] * s0 : s0) * s1; } }
                    u32x4 w; w.x = cvt_pk_bf16(c[0], c[1]); w.y = cvt_pk_bf16(c[2], c[3]); w.z = cvt_pk_bf16(c[4], c[5]); w.w = cvt_pk_bf16(c[6], c[7]);
                    *(u32x4*)rowp = w; }
        }
    }
};
template <class Epi, class Sched, bool ALIGN_EPI = false, bool SP2 = false>
__device__ __forceinline__ void gemm_phase(PG8_LAS unsigned char* lds, const Gemm g, const Sched& S, const Epi& E, const int wave_id  ) {
    int tid_l; asm volatile("v_mbcnt_lo_u32_b32 %0, -1, 0\n\tv_mbcnt_hi_u32_b32 %0, -1, %0" : "=v"(tid_l)); tid_l += wave_id * 64;
    const int tid = tid_l, wid = __builtin_amdgcn_readfirstlane(tid >> 6), lane = tid & 63, wr = wid >> 2, wc = wid & 3, fr = lane & 15, fq = lane >> 4;
    const int K = g.K, nt = K / BK;
    unsigned voffA[2], voffB[2];
#pragma unroll
    for (int i = 0; i < 2; ++i) { int R, C; stage_rc(tid * 16 + i * 8192, R, C); const int Rb = Epi::PERM ? ((R & ~31) + perm32(R & 31)) : R;
        voffA[i] = (unsigned)(R * K + C) * 2u; voffB[i] = (unsigned)(Rb * K + C) * 2u; }
    const size_t kstep = (size_t)(BK * 2);
    const size_t hstep = (size_t)HALF * K * 2;
    const size_t tstep = 2 * hstep;
    const unsigned ldsw = (unsigned)wid * 1024u;
    const int aoff = lds_byte(wr * 64 + fr, fq * 8), boff = lds_byte(wc * 32 + fr, fq * 8);
#define PG8_SA(b, h) (((b) * 2 + (h)) * HTB)
#define PG8_SB(b, h) ((4 + (b) * 2 + (h)) * HTB)
#define PG8_STAGE(bufoff, gbase, voff) do { _Pragma("unroll") for (int _i = 0; _i < 2; ++_i) \
        __builtin_amdgcn_global_load_lds((const unsigned*)((const char*)(gbase) + (voff)[_i]), (PG8_LAS unsigned*)(lds + (bufoff) + ldsw + _i * 8192), 16, 0, 0); } while (0)
#define PG8_LDA(dst, b, h) do { _Pragma("unroll") for (int m = 0; m < 4; ++m) _Pragma("unroll") for (int k = 0; k < 2; ++k) dst[m][k] = *(const PG8_LAS bf16x8*)(lds + PG8_SA(b, h) + aoff + m * 2048 + k * 1024); } while (0)
#define PG8_LDB(dst, b, h) do { _Pragma("unroll") for (int n = 0; n < 2; ++n) _Pragma("unroll") for (int k = 0; k < 2; ++k) dst[n][k] = *(const PG8_LAS bf16x8*)(lds + PG8_SB(b, h) + boff + n * 2048 + k * 1024); } while (0)
#define PG8_MMA(ai, bj, At, Bt) do { __builtin_amdgcn_s_setprio(1); _Pragma("unroll") for (int m = 0; m < 4; ++m) _Pragma("unroll") for (int n = 0; n < 2; ++n) _Pragma("unroll") for (int k = 0; k < 2; ++k) \
        acc[ai][bj][m][n] = __builtin_amdgcn_mfma_f32_16x16x32_bf16(Bt[n][k], At[m][k], acc[ai][bj][m][n], 0, 0, 0); __builtin_amdgcn_s_setprio(0); } while (0)
#define PG8_WAIT_V(n) asm volatile("s_waitcnt vmcnt(" #n ")" ::: "memory")
#define PG8_WAIT_L(n) asm volatile("s_waitcnt lgkmcnt(" #n ")" ::: "memory")
#define PG8_BAR __builtin_amdgcn_s_barrier()
#define PG8_SCHED __builtin_amdgcn_sched_barrier(0)
    Unit cur, nxt; int ui = 0;
    if (!S.next(0, cur)) return;
    f32x4 acc[2][2][4][2];
#pragma unroll
    for (int a = 0; a < 2; ++a)
#pragma unroll
        for (int b = 0; b < 2; ++b)
#pragma unroll
            for (int m = 0; m < 4; ++m)
#pragma unroll
                for (int n = 0; n < 2; ++n) acc[a][b][m][n] = (f32x4){0.f, 0.f, 0.f, 0.f};
    bf16x8 At[4][2], B0[2][2], B1[2][2];
    const char* cA = (const char*)g.A + (size_t)g.atile(cur.pm) * tstep; const char* cB = (const char*)g.Bt + (size_t)cur.pn * tstep;
    S.a_ready(cur);
    if constexpr (SP2) {
        PG8_STAGE(PG8_SB(0, 0), cB, voffB); PG8_STAGE(PG8_SB(0, 1), cB + hstep, voffB); PG8_STAGE(PG8_SA(0, 0), cA, voffA); PG8_STAGE(PG8_SA(0, 1), cA + hstep, voffA);
        if (wr == 1) PG8_BAR;
        PG8_WAIT_V(2); PG8_BAR;
        PG8_STAGE(PG8_SB(1, 0), cB + kstep, voffB); PG8_STAGE(PG8_SA(1, 0), cA + kstep, voffA); PG8_STAGE(PG8_SB(1, 1), cB + hstep + kstep, voffB);
        PG8_WAIT_V(6); PG8_BAR;
    } else {
        PG8_STAGE(PG8_SB(0, 0), cB, voffB); PG8_STAGE(PG8_SA(0, 0), cA, voffA); PG8_STAGE(PG8_SB(0, 1), cB + hstep, voffB); PG8_STAGE(PG8_SA(0, 1), cA + hstep, voffA);
        if (wr == 1) PG8_BAR;
        PG8_WAIT_V(4); PG8_BAR;
        PG8_STAGE(PG8_SB(1, 0), cB + kstep, voffB); PG8_STAGE(PG8_SA(1, 0), cA + kstep, voffA); PG8_STAGE(PG8_SB(1, 1), cB + hstep + kstep, voffB);
        PG8_WAIT_V(6); PG8_BAR;
    }
    for (;;) {
        const bool has_next = S.next(ui + 1, nxt);
        const char* nA = has_next ? (const char*)g.A + (size_t)g.atile(nxt.pm) * tstep : cA; const char* nB = has_next ? (const char*)g.Bt + (size_t)nxt.pn * tstep : cB;
        for (int t = 0; t < nt; t += 2) {
            const bool last = (t == nt - 2);
            const char* a1 = cA + (size_t)(t + 1) * kstep;
            const char* a2 = last ? nA : cA + (size_t)(t + 2) * kstep; const char* b2 = last ? nB : cB + (size_t)(t + 2) * kstep;
            const char* a3 = a2 + kstep; const char* b3 = b2 + kstep;
            if (last && has_next) S.a_ready(nxt);
            if constexpr (SP2) {
            PG8_LDB(B0, 0, 0); PG8_LDB(B1, 0, 1); PG8_SCHED; PG8_LDA(At, 0, 0); PG8_STAGE(PG8_SA(1, 1), a1 + hstep, voffA);
            PG8_WAIT_V(8); PG8_WAIT_L(0); PG8_BAR; PG8_MMA(0, 0, At, B0); PG8_MMA(0, 1, At, B1); PG8_BAR; PG8_SCHED;
            PG8_LDA(At, 0, 1); PG8_STAGE(PG8_SB(0, 0), b2, voffB); PG8_STAGE(PG8_SB(0, 1), b2 + hstep, voffB); PG8_STAGE(PG8_SA(0, 0), a2, voffA);
            PG8_WAIT_V(8); PG8_WAIT_L(0); PG8_BAR; PG8_MMA(1, 0, At, B0); PG8_MMA(1, 1, At, B1); PG8_BAR; PG8_SCHED;
            PG8_LDB(B0, 1, 0); PG8_LDB(B1, 1, 1); PG8_SCHED; PG8_LDA(At, 1, 0); PG8_STAGE(PG8_SA(0, 1), a2 + hstep, voffA);
            PG8_WAIT_V(8); PG8_WAIT_L(0); PG8_BAR; PG8_MMA(0, 0, At, B0); PG8_MMA(0, 1, At, B1); PG8_BAR; PG8_SCHED;
            PG8_LDA(At, 1, 1); PG8_STAGE(PG8_SB(1, 0), b3, voffB); PG8_STAGE(PG8_SB(1, 1), b3 + hstep, voffB); PG8_STAGE(PG8_SA(1, 0), a3, voffA);
            PG8_WAIT_V(8); PG8_WAIT_L(0); PG8_BAR; PG8_MMA(1, 0, At, B0); PG8_MMA(1, 1, At, B1); PG8_BAR; PG8_SCHED;
            } else {
            PG8_LDB(B0, 0, 0); PG8_SCHED; PG8_LDA(At, 0, 0); PG8_STAGE(PG8_SA(1, 1), a1 + hstep, voffA);
            PG8_WAIT_L(8); PG8_BAR; PG8_WAIT_L(0); PG8_MMA(0, 0, At, B0); PG8_BAR; PG8_SCHED;
            PG8_LDB(B1, 0, 1); PG8_STAGE(PG8_SB(0, 0), b2, voffB);
            PG8_BAR; PG8_WAIT_L(0); PG8_MMA(0, 1, At, B1); PG8_BAR;
            PG8_LDA(At, 0, 1); PG8_STAGE(PG8_SA(0, 0), a2, voffA);
            PG8_BAR; PG8_WAIT_L(0); PG8_MMA(1, 0, At, B0); PG8_BAR; PG8_SCHED;
            PG8_STAGE(PG8_SB(0, 1), b2 + hstep, voffB);
            PG8_WAIT_V(6); PG8_BAR; PG8_MMA(1, 1, At, B1); PG8_BAR;
            PG8_LDB(B0, 1, 0); PG8_SCHED; PG8_LDA(At, 1, 0); PG8_STAGE(PG8_SA(0, 1), a2 + hstep, voffA);
            PG8_WAIT_L(8); PG8_BAR; PG8_WAIT_L(0); PG8_MMA(0, 0, At, B0); PG8_BAR; PG8_SCHED;
            PG8_LDB(B1, 1, 1); PG8_STAGE(PG8_SB(1, 0), b3, voffB);
            PG8_BAR; PG8_WAIT_L(0); PG8_MMA(0, 1, At, B1); PG8_BAR;
            PG8_LDA(At, 1, 1); PG8_STAGE(PG8_SA(1, 0), a3, voffA);
            PG8_BAR; PG8_WAIT_L(0); PG8_MMA(1, 0, At, B0); PG8_BAR; PG8_SCHED;
            PG8_STAGE(PG8_SB(1, 1), b3 + hstep, voffB);
            PG8_WAIT_V(6); PG8_BAR; PG8_MMA(1, 1, At, B1); PG8_BAR;
            }
        }
        if constexpr (ALIGN_EPI) { if (wr == 0) PG8_BAR; }
        if constexpr (!Epi::AFTER_DRAIN) { E(acc, cur, wr, wc, fr, fq); S.done(cur); }
        if (!has_next) break;
#pragma unroll
        for (int a = 0; a < 2; ++a)
#pragma unroll
            for (int b = 0; b < 2; ++b)
#pragma unroll
                for (int m = 0; m < 4; ++m)
#pragma unroll
                    for (int n = 0; n < 2; ++n) acc[a][b][m][n] = (f32x4){0.f, 0.f, 0.f, 0.f};
        cur = nxt; cA = nA; cB = nB; ++ui;
        if constexpr (ALIGN_EPI) { if (wr == 1) PG8_BAR; }
    }
    PG8_WAIT_V(0);
    if constexpr (!ALIGN_EPI) { if (wr == 0) PG8_BAR; }
    PG8_BAR;
    if constexpr (Epi::AFTER_DRAIN) { E.fused(acc, cur, wr, wc, fr, fq, lds, wid, lane); S.done(cur); }
#undef PG8_SA
#undef PG8_SB
#undef PG8_STAGE
#undef PG8_LDA
#undef PG8_LDB
#undef PG8_MMA
#undef PG8_WAIT_V
#undef PG8_WAIT_L
#undef PG8_BAR
#undef PG8_SCHED
}
}

#ifndef PG8_SP2
#define PG8_SP2 true
#endif
#ifndef PG8_ALIGN
#define PG8_ALIGN true
#endif

constexpr int NWAVES = 8;
constexpr int D = 1024, BATCH = 32, SEQ = 2048, M = BATCH * SEQ, DEPTH = 2, NH = 8, HD = 128, DFF = 2816;
constexpr int PROJW = 10256;
constexpr int NPROJ = 10240, WHB = 1280;
constexpr int PW = 8192, HB = 1024;
constexpr int NSEG = 4, SEGT = SEQ / NSEG, SEGROWS = BATCH * SEGT;
constexpr int SEG_SH = (SEGT == 256) ? 0 : (SEGT == 512) ? 1 : 2;
constexpr int FSEG = 2, FROWS = M / FSEG;
constexpr float RMS_EPS = 1e-6f;
constexpr int MODW = 6 * D;

constexpr size_t MiB = 1u << 20;
constexpr size_t WS_CTL = 0, CTL_ZERO_BYTES = 1 * MiB;
constexpr size_t WS_WIN = 2 * MiB;
constexpr size_t WS_WOUT = 42 * MiB;
constexpr size_t WS_WUP = 46 * MiB;
constexpr size_t WS_WDN = 68 * MiB;
constexpr size_t WS_WG = 79 * MiB;
constexpr size_t WS_BIASP = 79 * MiB + 256 * 1024;
constexpr size_t WS_BG = 79 * MiB + 512 * 1024;
constexpr size_t WS_LB = 79 * MiB + 768 * 1024;
constexpr size_t WS_MOD = 80 * MiB;
constexpr size_t WS_GATES = 84 * MiB;
constexpr size_t WS_STC = 88 * MiB;
constexpr size_t WS_STS = 104 * MiB;
constexpr size_t WS_STN = 120 * MiB;
constexpr size_t WS_STM = 121 * MiB;
constexpr size_t WS_HN = 122 * MiB;
constexpr size_t WS_Y = 250 * MiB;
constexpr size_t WS_P = 378 * MiB;
constexpr size_t P_BYTES = (size_t)SEGROWS * PW * 2;
constexpr size_t WS_U = 250 * MiB;
constexpr size_t WS_G = 602 * MiB;
constexpr size_t WS_END = 778 * MiB;
static_assert(WS_P + 2 * P_BYTES <= 890 * MiB && WS_U + (size_t)FROWS * 2 * DFF * 2 <= WS_G && WS_G + (size_t)FROWS * DFF * 2 <= WS_END, "ws map");
constexpr int CW_TMO = 0, CW_CODE = 1, CW_BAR = 4096;

constexpr int LDS_BYTES = 160 * 1024;
constexpr int RING_OFF = 0;
constexpr int MISC_OFF = 159 * 1024;

#define GAS __attribute__((address_space(1)))
#define LAS __attribute__((address_space(3)))
typedef unsigned short bf16;
typedef unsigned v4u __attribute__((ext_vector_type(4)));
typedef unsigned v2u __attribute__((ext_vector_type(2)));
typedef float f32x4 __attribute__((ext_vector_type(4)));
typedef short bf16x8 __attribute__((ext_vector_type(8)));
typedef GAS unsigned gu32;
#define RLX_AGENT __ATOMIC_RELAXED, __HIP_MEMORY_SCOPE_AGENT
#define LDS_WAIT() asm volatile("s_waitcnt lgkmcnt(0)" ::: "memory")
#define VM_WAIT() asm volatile("s_waitcnt vmcnt(0)" ::: "memory")
__device__ __forceinline__ unsigned f2bf(float f) { unsigned u = __builtin_bit_cast(unsigned, f); return (u + 0x7fffu + ((u >> 16) & 1u)) >> 16; }
__device__ __forceinline__ unsigned pk2(float lo, float hi) { return f2bf(lo) | (f2bf(hi) << 16); }
__device__ __forceinline__ float bf2f(unsigned short b) { return __builtin_bit_cast(float, ((unsigned)b) << 16); }
__device__ __forceinline__ float sigm(float x) { return 1.f / (1.f + __expf(-x)); }
__device__ __forceinline__ float siluf(float x) { return x / (1.f + __expf(-x)); }
__device__ __forceinline__ float softcap15(float z) { return 15.f * tanhf(z * (1.f / 15.f)); }
__device__ __forceinline__ float logsigm(float z) { return fminf(z, 0.f) - log1pf(expf(-fabsf(z))); }
__device__ __forceinline__ float wave_sum(float v) {
#pragma unroll
    for (int o = 1; o < 64; o <<= 1) v += __shfl_xor(v, o);
    return v;
}

#define PHASE_TID() int tid; asm volatile("v_mbcnt_lo_u32_b32 %0, -1, 0\n\tv_mbcnt_hi_u32_b32 %0, -1, %0" : "=v"(tid)); tid += F.wave_s * 64; const int lane = tid & 63, wave = F.wave_s; (void)lane; (void)wave
#define XB_TMO      128
#define XB_XCNT(j)  (256  + 64 * (j))
#define XB_XSUB(j)  (1280 + 64 * (j))
#define XB_XGEN(j)  (2304 + 64 * (j))
#define XB_TOP      3328
#define XB_TOPGEN   3392
#define XCD_BAR_WORDS 3456
#define XB_SPIN_CAP (1u << 18)

__device__ __forceinline__ unsigned xb_ld(unsigned* p)              { return __hip_atomic_load(p, __ATOMIC_RELAXED, __HIP_MEMORY_SCOPE_AGENT); }
__device__ __forceinline__ unsigned xb_add(unsigned* p, unsigned v) { return __hip_atomic_fetch_add(p, v, __ATOMIC_RELAXED, __HIP_MEMORY_SCOPE_AGENT); }
__device__ __forceinline__ unsigned xb_xcc_id() { return (unsigned)__builtin_amdgcn_s_getreg((3 << 11) | 20) & 0xFu; }
#define XB_SPIN(cond, bar) do { unsigned _sp = 0; while (cond) { __builtin_amdgcn_s_sleep(1); \
    if ((++_sp & 255u) == 0u) { if (xb_ld(&(bar)[XB_TMO])) break; if (_sp > XB_SPIN_CAP) { atomicAdd(&(bar)[XB_TMO], 1u); break; } } } } while (0)

struct XcdBarrier {
    unsigned* bar; unsigned x;
    volatile LAS unsigned* st;
};

__device__ __forceinline__ XcdBarrier xcd_barrier_post(unsigned* bar, volatile LAS unsigned* st) {
    XcdBarrier b; b.bar = bar; b.x = xb_xcc_id(); b.st = st;
    if (threadIdx.x == 0) (void)xb_add(&bar[XB_XCNT(b.x)], 1u);
    return b;
}
__device__ __forceinline__ void xcd_barrier_complete(unsigned* bar, unsigned x, unsigned& nloc, unsigned& nx) {
    const unsigned G = gridDim.x * gridDim.y * gridDim.z;
    unsigned sum, cnt, mine, sp = 0u;
    for (;;) {
        sum = 0u; cnt = 0u; mine = 0u;
#pragma unroll
        for (unsigned j = 0; j < 16; ++j) { const unsigned c = xb_ld(&bar[XB_XCNT(j)]); sum += c; cnt += (c > 0u) ? 1u : 0u; mine = (j == x) ? c : mine; }
        if (sum == G) break;
        __builtin_amdgcn_s_sleep(1);
        if ((++sp & 255u) == 0u) { if (xb_ld(&bar[XB_TMO])) break; if (sp > XB_SPIN_CAP) { atomicAdd(&bar[XB_TMO], 1u); break; } }
    }
    nloc = mine > 0u ? mine : 1u; nx = cnt > 0u ? cnt : 1u;
}

__device__ __forceinline__ void xcd_barrier(const XcdBarrier& b) {
    asm volatile("s_waitcnt vmcnt(0)" ::: "memory");
    __syncthreads();
    if (threadIdx.x == 0) {
        unsigned* bar = b.bar;
        __builtin_amdgcn_s_waitcnt(0);
        unsigned nloc = b.st[0], nx = b.st[1];
        if (nloc == 0u) { xcd_barrier_complete(bar, b.x, nloc, nx); b.st[0] = nloc; b.st[1] = nx; }
        const unsigned old = xb_add(&bar[XB_XSUB(b.x)], 1u);
        const unsigned gen = old / nloc;
        if (old + 1u == (gen + 1u) * nloc) {
            __builtin_amdgcn_fence(__ATOMIC_RELEASE, "agent");
            asm volatile("s_waitcnt vmcnt(0)" ::: "memory");
            const unsigned og = xb_add(&bar[XB_TOP], 1u);
            const unsigned tg = og / nx;
            if (og + 1u == (tg + 1u) * nx) xb_add(&bar[XB_TOPGEN], 1u);
            else XB_SPIN(xb_ld(&bar[XB_TOPGEN]) == tg, bar);
            __builtin_amdgcn_fence(__ATOMIC_ACQUIRE, "agent");
            xb_add(&bar[XB_XGEN(b.x)], 1u);
            asm volatile("s_waitcnt vmcnt(0)" ::: "memory");
        } else {
            XB_SPIN(xb_ld(&bar[XB_XGEN(b.x)]) == gen, bar);
            __builtin_amdgcn_fence(__ATOMIC_ACQUIRE, "agent");
            asm volatile("s_waitcnt vmcnt(0)" ::: "memory");
        }
    }
    __syncthreads();
}

struct Ctx {
    LAS unsigned char* lds;
    int vcu, G, wave_s;
};
struct Args { const float* in[19]; float* out; unsigned char* ws; };
typedef const Args __attribute__((address_space(4))) CArgs;
__device__ __forceinline__ CArgs& getargs() { CArgs* p = (CArgs*)__builtin_amdgcn_kernarg_segment_ptr(); asm volatile("" : "+s"(p)); return *p; }
#define ARGS() CArgs& A = getargs()

__device__ __forceinline__ void p0_transpose_item(const float* W, int ldw, int srccol0, int k0, bf16* WT, int K, int dstrow0, LAS float* scr, int lane) {
#pragma unroll 8
    for (int i = 0; i < 32; ++i) { const int kk = 2 * i + (lane >> 5); scr[kk * 33 + (lane & 31)] = W[(size_t)(k0 + kk) * ldw + srccol0 + (lane & 31)]; }
    LDS_WAIT(); asm volatile("" ::: "memory");
    const int c = lane & 7;
#pragma unroll
    for (int j = 0; j < 4; ++j) { const int n = (lane >> 3) + 8 * j; const LAS float* s = scr + (8 * c) * 33 + n;
        v4u o; o.x = pk2(s[0 * 33], s[1 * 33]); o.y = pk2(s[2 * 33], s[3 * 33]); o.z = pk2(s[4 * 33], s[5 * 33]); o.w = pk2(s[6 * 33], s[7 * 33]);
        *(GAS v4u*)(WT + (size_t)(dstrow0 + n) * K + k0 + 8 * c) = o; }
    LDS_WAIT(); asm volatile("" ::: "memory");
}
__device__ __forceinline__ int in_src_col(int dstrow) {
    const int h = dstrow / WHB, rem = dstrow - h * WHB, blk = rem >> 7, j = rem & 127;
    int base;
    switch (blk) { case 0: base = 0; break; case 1: base = 1024; break; case 2: base = 2048; break; case 3: base = 6160; break; case 4: base = 4112; break;
                   case 5: base = 5136; break; case 6: base = 3072; break; case 7: base = 8208; break; case 8: base = 7184; break; default: base = 9232; break; }
    return base + h * 128 + j;
}
__device__ __forceinline__ void p0_prologue(Ctx& F) {
    PHASE_TID();
    ARGS();
    LAS float* scr = (LAS float*)(F.lds + wave * 16384);
    const int gw = F.vcu * NWAVES + wave, NGW = F.G * NWAVES;
    constexpr int I_IN = 320 * 16, I_OUT = 32 * 16, I_UP = 176 * 16, I_DN = 32 * 44, I_L = I_IN + I_OUT + I_UP + I_DN;
    for (int it = gw; it < 2 * I_L; it += NGW) {
        const int l = it / I_L; int r = it - l * I_L;
        if (r < I_IN) { const int rg = r >> 4, kb = r & 15; p0_transpose_item(A.in[5] + (size_t)l * D * PROJW, PROJW, in_src_col(32 * rg), 64 * kb, (bf16*)(A.ws + WS_WIN) + (size_t)l * NPROJ * D, D, 32 * rg, scr, lane); continue; } r -= I_IN;
        if (r < I_OUT) { const int rg = r >> 4, kb = r & 15; p0_transpose_item(A.in[12] + (size_t)l * D * D, D, 32 * rg, 64 * kb, (bf16*)(A.ws + WS_WOUT) + (size_t)l * D * D, D, 32 * rg, scr, lane); continue; } r -= I_OUT;
        if (r < I_UP) { const int rg = r >> 4, kb = r & 15; const int row0 = 32 * rg, pn = row0 >> 8, half = (row0 >> 7) & 1, j0 = row0 & 127;
            p0_transpose_item(A.in[14] + (size_t)l * D * 2 * DFF, 2 * DFF, half * DFF + pn * 128 + j0, 64 * kb, (bf16*)(A.ws + WS_WUP) + (size_t)l * 2 * DFF * D, D, row0, scr, lane); continue; } r -= I_UP;
        { const int rg = r / 44, kb = r - rg * 44; p0_transpose_item(A.in[17] + (size_t)l * DFF * D, D, 32 * rg, 64 * kb, (bf16*)(A.ws + WS_WDN) + (size_t)l * D * DFF, DFF, 32 * rg, scr, lane); }
    }
    const int gt = F.vcu * (NWAVES * 64) + tid, NGT = F.G * NWAVES * 64;
    float* wg = (float*)(A.ws + WS_WG); float* biasp = (float*)(A.ws + WS_BIASP); float* bg = (float*)(A.ws + WS_BG); float* lb = (float*)(A.ws + WS_LB);
    for (int i = gt; i < 2 * D * 16; i += NGT) { const int g = i & 15, k = (i >> 4) & (D - 1), l = i >> 14; wg[(size_t)(l * 16 + g) * D + k] = A.in[5][((size_t)l * D + k) * PROJW + 4096 + g]; }
    for (int i = gt; i < 2 * NPROJ; i += NGT) { const int l = i / NPROJ, c = i - l * NPROJ; biasp[i] = A.in[6][(size_t)l * PROJW + in_src_col(c)]; }
    for (int i = gt; i < 32; i += NGT) { const int l = i >> 4, g = i & 15; bg[i] = A.in[6][(size_t)l * PROJW + 4096 + g]; }
    for (int i = gt; i < D; i += NGT) { const float z0 = A.in[10][i], z1 = A.in[10][D + i]; lb[i] = 1.f / (1.f + expf(z0 - z1)); }
    __syncthreads();
    for (int wgi = F.vcu; wgi < 2 * (MODW / 64); wgi += F.G) {
        LAS float* cact = (LAS float*)F.lds;
        for (int i = tid; i < BATCH * D; i += NWAVES * 64) cact[i] = siluf(A.in[1][i]);
        __syncthreads();
        const int l = wgi / (MODW / 64), cg = wgi - l * (MODW / 64), col = cg * 64 + lane, kb = wave * 128;
        const float* aw = A.in[2] + (size_t)l * D * MODW + col;
        float acc[32];
#pragma unroll
        for (int b = 0; b < 32; ++b) acc[b] = 0.f;
        for (int k4 = 0; k4 < 32; ++k4) {
            const int k = kb + 4 * k4;
            const float w0 = aw[(size_t)k * MODW], w1 = aw[(size_t)(k + 1) * MODW], w2 = aw[(size_t)(k + 2) * MODW], w3 = aw[(size_t)(k + 3) * MODW];
#pragma unroll
            for (int b = 0; b < 32; ++b) { const f32x4 cv = *(const LAS f32x4*)(cact + b * D + k); acc[b] += cv.x * w0 + cv.y * w1 + cv.z * w2 + cv.w * w3; }
        }
        __syncthreads();
        LAS float* part = (LAS float*)F.lds;
#pragma unroll
        for (int b = 0; b < 32; ++b) part[(wave * 32 + b) * 64 + lane] = acc[b];
        __syncthreads();
        float* mod = (float*)(A.ws + WS_MOD);
        for (int o = tid; o < 32 * 64; o += NWAVES * 64) { const int b = o >> 6, c = o & 63; float s = 0.f;
#pragma unroll
            for (int w = 0; w < 8; ++w) s += part[(w * 32 + b) * 64 + c];
            mod[((size_t)l * BATCH + b) * MODW + cg * 64 + c] = s + A.in[3][(size_t)l * MODW + cg * 64 + c]; }
        __syncthreads();
    }
}

__device__ __forceinline__ float reduce16(float (&v)[16], int lane) {
#define R16_STEP(S, MSK) { const bool up = (lane & (MSK)) != 0; _Pragma("unroll") for (int i = 0; i < (S); ++i) { const float keep = up ? v[i + (S)] : v[i], send = up ? v[i] : v[i + (S)]; v[i] = keep + __shfl_xor(send, (MSK)); } }
    R16_STEP(8, 32) R16_STEP(4, 16) R16_STEP(2, 8) R16_STEP(1, 4)
#undef R16_STEP
    float r = v[0]; r += __shfl_xor(r, 1); r += __shfl_xor(r, 2); return r;
}
template <bool GATES>
__device__ __forceinline__ void norm_phase(Ctx& F, const float* src, const float* nw, const float* modl, int shift_off, int scale_off, bf16* hn, float* gates, const float* wgl, const float* bgl) {
    PHASE_TID();
    LAS float* wgs = (LAS float*)F.lds;
    if (GATES) { for (int i = tid; i < 16 * D / 4; i += NWAVES * 64) ((LAS f32x4*)wgs)[i] = ((const f32x4*)wgl)[i]; __syncthreads(); }
    const int gw = F.vcu * NWAVES + wave, NGW = F.G * NWAVES;
    f32x4 w[4];
#pragma unroll
    for (int j = 0; j < 4; ++j) w[j] = *(const f32x4*)(nw + 256 * j + 4 * lane);
    for (int item = gw; item < M / 32; item += NGW) {
        const int row0 = item * 32, b = row0 >> 11;
        f32x4 sc[4], sh[4];
#pragma unroll
        for (int j = 0; j < 4; ++j) { sc[j] = *(const f32x4*)(modl + (size_t)b * MODW + scale_off + 256 * j + 4 * lane); sh[j] = *(const f32x4*)(modl + (size_t)b * MODW + shift_off + 256 * j + 4 * lane);
            sc[j] = (sc[j] + 1.0f) * w[j]; }
        f32x4 xn[4];
#pragma unroll
        for (int j = 0; j < 4; ++j) xn[j] = *(const GAS f32x4*)(src + (size_t)row0 * D + 256 * j + 4 * lane);
        for (int r = 0; r < 32; ++r) {
            asm volatile("" ::: "memory");
            f32x4 x[4];
#pragma unroll
            for (int j = 0; j < 4; ++j) x[j] = xn[j];
            if (r + 1 < 32) {
#pragma unroll
                for (int j = 0; j < 4; ++j) xn[j] = *(const GAS f32x4*)(src + (size_t)(row0 + r + 1) * D + 256 * j + 4 * lane);
            }
            float ss = 0.f;
#pragma unroll
            for (int j = 0; j < 4; ++j) ss += (x[j].x * x[j].x + x[j].y * x[j].y) + (x[j].z * x[j].z + x[j].w * x[j].w);
            const float rstd = rsqrtf(wave_sum(ss) * (1.f / D) + RMS_EPS);
#pragma unroll
            for (int j = 0; j < 4; ++j) x[j] = x[j] * rstd * sc[j] + sh[j];
            GAS unsigned long long* o8 = (GAS unsigned long long*)(hn + (size_t)(row0 + r) * D) + lane;
#pragma unroll
            for (int j = 0; j < 4; ++j) o8[64 * j] = (unsigned long long)pk2(x[j].x, x[j].y) | ((unsigned long long)pk2(x[j].z, x[j].w) << 32);
            if (GATES) {
                float a[16];
#pragma unroll
                for (int g = 0; g < 16; ++g) { float s = 0.f;
#pragma unroll
                    for (int j = 0; j < 4; ++j) { const f32x4 wv = *(const LAS f32x4*)(wgs + g * D + 256 * j + 4 * lane); s += (x[j].x * wv.x + x[j].y * wv.y) + (x[j].z * wv.z + x[j].w * wv.w); }
                    a[g] = s; }
                const float tot = reduce16(a, lane);
                const int g = ((lane >> 5) & 1) * 8 + ((lane >> 4) & 1) * 4 + ((lane >> 3) & 1) * 2 + ((lane >> 2) & 1);
                if ((lane & 3) == 0) gates[(size_t)(row0 + r) * 16 + g] = tot + bgl[g];
            }
        }
    }
}
__device__ __forceinline__ void final_norm_phase(Ctx& F, float* x, const float* nw) {
    PHASE_TID();
    const int gw = F.vcu * NWAVES + wave, NGW = F.G * NWAVES;
    f32x4 w[4];
#pragma unroll
    for (int j = 0; j < 4; ++j) w[j] = *(const f32x4*)(nw + 256 * j + 4 * lane);
    for (int row = gw; row < M; row += NGW) {
        GAS f32x4* xr = (GAS f32x4*)(x + (size_t)row * D) + lane;
        f32x4 v[4]; float ss = 0.f;
#pragma unroll
        for (int j = 0; j < 4; ++j) { v[j] = xr[64 * j]; ss += (v[j].x * v[j].x + v[j].y * v[j].y) + (v[j].z * v[j].z + v[j].w * v[j].w); }
        const float rstd = rsqrtf(wave_sum(ss) * (1.f / D) + RMS_EPS);
#pragma unroll
        for (int j = 0; j < 4; ++j) xr[64 * j] = v[j] * rstd * w[j];
    }
}

__device__ __forceinline__ void ffn_glu_phase(Ctx& F, const bf16* u, bf16* g, const float* cw, const float* cb) {
    PHASE_TID();
    constexpr int RB = 16, NCH = DFF / 8, NRB = FROWS / RB;
    const int gt = F.vcu * (NWAVES * 64) + tid, NGT = F.G * NWAVES * 64;
    for (int it = gt; it < NRB * NCH; it += NGT) {
        const int rb = it / NCH, ch = it - rb * NCH, f0 = ch * 8, row0 = rb * RB;
        const int cg0 = (f0 >> 7) * 256 + (f0 & 127);
        float wg_[3][8], wv_[3][8], bgv[8], bvv[8];
#pragma unroll
        for (int j = 0; j < 3; ++j)
#pragma unroll
            for (int e = 0; e < 8; ++e) { wg_[j][e] = cw[(size_t)j * 2 * DFF + f0 + e]; wv_[j][e] = cw[(size_t)j * 2 * DFF + DFF + f0 + e]; }
#pragma unroll
        for (int e = 0; e < 8; ++e) { bgv[e] = cb[f0 + e]; bvv[e] = cb[DFF + f0 + e]; }
        float g1[8], g2[8], v1[8], v2[8];
        const int t0 = row0 & (SEQ - 1);
#pragma unroll
        for (int e = 0; e < 8; ++e) { g1[e] = g2[e] = v1[e] = v2[e] = 0.f; }
        if (t0 >= 2) {
            const v4u a1 = *(const GAS v4u*)(u + (size_t)(row0 - 1) * 2 * DFF + cg0), a2 = *(const GAS v4u*)(u + (size_t)(row0 - 2) * 2 * DFF + cg0);
            const v4u b1 = *(const GAS v4u*)(u + (size_t)(row0 - 1) * 2 * DFF + cg0 + 128), b2 = *(const GAS v4u*)(u + (size_t)(row0 - 2) * 2 * DFF + cg0 + 128);
#pragma unroll
            for (int e = 0; e < 4; ++e) { g1[2 * e] = bf2f(a1[e] & 0xffff); g1[2 * e + 1] = bf2f(a1[e] >> 16); g2[2 * e] = bf2f(a2[e] & 0xffff); g2[2 * e + 1] = bf2f(a2[e] >> 16);
                v1[2 * e] = bf2f(b1[e] & 0xffff); v1[2 * e + 1] = bf2f(b1[e] >> 16); v2[2 * e] = bf2f(b2[e] & 0xffff); v2[2 * e + 1] = bf2f(b2[e] >> 16); }
        }
        for (int r = 0; r < RB; ++r) {
            const v4u a0 = *(const GAS v4u*)(u + (size_t)(row0 + r) * 2 * DFF + cg0), b0 = *(const GAS v4u*)(u + (size_t)(row0 + r) * 2 * DFF + cg0 + 128);
            float g0[8], v0[8], o[8];
#pragma unroll
            for (int e = 0; e < 4; ++e) { g0[2 * e] = bf2f(a0[e] & 0xffff); g0[2 * e + 1] = bf2f(a0[e] >> 16); v0[2 * e] = bf2f(b0[e] & 0xffff); v0[2 * e + 1] = bf2f(b0[e] >> 16); }
#pragma unroll
            for (int e = 0; e < 8; ++e) { const float cgv = bgv[e] + wg_[2][e] * g0[e] + wg_[1][e] * g1[e] + wg_[0][e] * g2[e]; const float cvv = bvv[e] + wv_[2][e] * v0[e] + wv_[1][e] * v1[e] + wv_[0][e] * v2[e];
                o[e] = siluf(cgv) * cvv; g2[e] = g1[e]; g1[e] = g0[e]; v2[e] = v1[e]; v1[e] = v0[e]; }
            v4u w; w.x = pk2(o[0], o[1]); w.y = pk2(o[2], o[3]); w.z = pk2(o[4], o[5]); w.w = pk2(o[6], o[7]);
            *(GAS v4u*)(g + (size_t)(row0 + r) * DFF + f0) = w;
        }
    }
}

constexpr int IMG_QM = 0, IMG_KM = 16384, IMG_VM = 32768, IMG_P = 49152, IMG_HQT = 57344, IMG_HKT = 73728, IMG_HV = 90112, PH_OFF = 106496, MF_OFF = 110592, HAB_OFF = 130048, OBB_OFF = 146432;
constexpr int MF_N = 0, MF_DFL = 128, MF_QN = 192, MF_RS = 256, MF_NRED = 384, MF_E7 = 1408, MF_E157 = 1920, MF_CW = 2432, MF_WN = 3712, MF_END = 3968;
static_assert(MF_OFF + MF_END * 4 <= HAB_OFF && OBB_OFF + 16384 <= MISC_OFF, "mixer LDS map");
constexpr int PO_MQ = 0, PO_MK = 128, PO_MV = 256, PO_HI = 384, PO_HQ = 512, PO_HF = 640, PO_CA = 768, PO_CB = 896;
typedef short s16x4 __attribute__((ext_vector_type(4)));
typedef short v4i16_t __attribute__((ext_vector_type(4)));
__device__ __forceinline__ unsigned offb(unsigned row, unsigned ch) { return 256u * row + 16u * (ch ^ (((row & 3u) << 2) | ((row >> 2) & 3u))); }
__device__ __forceinline__ bf16x8 ld16(LAS unsigned char* p) { return *(const LAS bf16x8*)p; }
__device__ __forceinline__ s16x4 ld8(LAS unsigned char* p) { return *(const LAS s16x4*)p; }
__device__ __forceinline__ s16x4 ldtr(LAS unsigned char* p) { return __builtin_bit_cast(s16x4, __builtin_amdgcn_ds_read_tr16_b64_v4i16((LAS v4i16_t*)p)); }
__device__ __forceinline__ bf16x8 cat8(s16x4 a, s16x4 b) { bf16x8 r; r[0] = a[0]; r[1] = a[1]; r[2] = a[2]; r[3] = a[3]; r[4] = b[0]; r[5] = b[1]; r[6] = b[2]; r[7] = b[3]; return r; }
__device__ __forceinline__ bf16x8 frag_row(LAS unsigned char* img, int row0, int ks, int lane) { return ld16(img + offb(row0 + (lane & 15), 4 * ks + (lane >> 4))); }
__device__ __forceinline__ bf16x8 frag_tr(LAS unsigned char* img, int row0, int c, int lane, int rmask) {
    const int g = lane >> 4, qq = (lane & 15) >> 2, p = lane & 3;
    const int r0 = row0 + ((8 * g + qq) & rmask), r1 = row0 + ((8 * g + 4 + qq) & rmask);
    return cat8(ldtr(img + offb(r0, 2 * c + (p >> 1)) + 8 * (p & 1)), ldtr(img + offb(r1, 2 * c + (p >> 1)) + 8 * (p & 1)));
}
__device__ __forceinline__ bf16x8 frag_q2(LAS unsigned char* img, int row0, int ks, int lane) {
    const int r = lane & 15, q = lane >> 4;
    return cat8(ld8(img + offb(row0 + r, 4 * ks + (q >> 1)) + 8 * (q & 1)), ld8(img + offb(row0 + r, 4 * ks + 2 + (q >> 1)) + 8 * (q & 1)));
}
__device__ __forceinline__ bf16x8 pack_acc(const f32x4& lo, const f32x4& hi) {
    v4u w; w.x = pg8::cvt_pk_bf16(lo[0], lo[1]); w.y = pg8::cvt_pk_bf16(lo[2], lo[3]); w.z = pg8::cvt_pk_bf16(hi[0], hi[1]); w.w = pg8::cvt_pk_bf16(hi[2], hi[3]);
    return __builtin_bit_cast(bf16x8, w);
}
__device__ __forceinline__ f32x4 mfma16(const bf16x8& a, const bf16x8& b, const f32x4& c) { return __builtin_amdgcn_mfma_f32_16x16x32_bf16(a, b, c, 0, 0, 0); }
__device__ __forceinline__ float rcpf_(float x) { return __builtin_amdgcn_rcpf(x); }
__device__ __forceinline__ float sigf(float x) { return rcpf_(1.f + __expf(-x)); }
__device__ __forceinline__ float silf(float x) { return x * rcpf_(1.f + __expf(-x)); }
__device__ __forceinline__ unsigned pkbf(float lo, float hi) { return pg8::cvt_pk_bf16(lo, hi); }
__device__ __forceinline__ void unpack8(const v4u& v, float (&o)[8]) {
#pragma unroll
    for (int e = 0; e < 4; ++e) { o[2 * e] = bf2f((unsigned short)(v[e] & 0xffffu)); o[2 * e + 1] = bf2f((unsigned short)(v[e] >> 16)); }
}

#define LN_FRESH(name) int name = lane; asm volatile("" : "+v"(name))
template <bool DRY>
__device__ __forceinline__ void mixer_fast_phase(Ctx& F, int layer, int seg) {
    PHASE_TID();
    ARGS();
    const bf16* Pcur = (const bf16*)(A.ws + WS_P + (size_t)(seg & 1) * P_BYTES);
    const bf16* Pprev = (const bf16*)(A.ws + WS_P + (size_t)((seg & 1) ^ 1) * P_BYTES);
    const float* gates = (const float*)(A.ws + WS_GATES);
    const float* lbp = (const float*)(A.ws + WS_LB);
    bf16* Y = (bf16*)(A.ws + WS_Y);
    float* stC = (float*)(A.ws + WS_STC); float* stS = (float*)(A.ws + WS_STS); float* stN = (float*)(A.ws + WS_STN); float* stM = (float*)(A.ws + WS_STM);
    const float* cw = A.in[7] + (size_t)layer * 4 * 2048; const float* cb = A.in[8] + (size_t)layer * 2048;
    LAS unsigned char* L = F.lds;
    LAS float* MF = (LAS float*)(L + MF_OFF);
    for (int bh = blockIdx.x; bh < BATCH * NH; bh += F.G) {
        const int b = bh >> 3, h = bh & 7;
        for (int i = tid; i < 1280; i += NWAVES * 64) { const int blk = i / 640, j = (i % 640) >> 7, e = i & 127; MF[MF_CW + i] = j < 4 ? cw[(size_t)j * 2048 + blk * 1024 + h * 128 + e] : cb[blk * 1024 + h * 128 + e]; }
        for (int i = tid; i < 1024; i += NWAVES * 64) ((LAS unsigned*)(L + PH_OFF))[i] = 0u;
        if (tid < 256) MF[MF_WN + tid] = tid < 128 ? A.in[9][(size_t)layer * D + h * 128 + tid] : A.in[11][(size_t)layer * D + h * 128 + tid - 128];
        f32x4 Cacc[8], Sacc[8]; float mst;
        if (seg == 0) {
#pragma unroll
            for (int mb = 0; mb < 8; ++mb) { Cacc[mb] = (f32x4){0.f, 0.f, 0.f, 0.f}; Sacc[mb] = (f32x4){0.f, 0.f, 0.f, 0.f}; }
            mst = 0.f; if (tid < 128) MF[MF_N + tid] = 0.f;
        } else {
#pragma unroll
            for (int mb = 0; mb < 8; ++mb)
#pragma unroll
                for (int e = 0; e < 4; ++e) { Cacc[mb][e] = stC[((size_t)(bh * 8 + wave) * 32 + mb * 4 + e) * 64 + lane]; Sacc[mb][e] = stS[((size_t)(bh * 8 + wave) * 32 + mb * 4 + e) * 64 + lane]; }
            mst = stM[bh]; if (tid < 128) MF[MF_N + tid] = stN[bh * 128 + tid];
        }
        __syncthreads();
        for (int c = 0; c < SEGT / 64; ++c) {
            const int tl0 = 64 * c; const size_t grow0 = (size_t)b * SEQ + seg * SEGT + tl0;
            int lane; asm volatile("v_mbcnt_lo_u32_b32 %0, -1, 0\n\tv_mbcnt_hi_u32_b32 %0, -1, %0" : "=v"(lane)); const int tid = wave * 64 + lane;
            const int r = lane & 15, q = lane >> 4;
            float rowfac, decay, mnext;
#ifdef PROBE_PREP2
#pragma unroll 1
            for (int rep_ = 0; rep_ < 2; ++rep_) { asm volatile("" ::: "memory");
#endif
            {
                const float gi = gates[(grow0 + lane) * 16 + h] * (2.f / 15.f), gf = gates[(grow0 + lane) * 16 + 8 + h] * (2.f / 15.f);
                const float li = 15.f - 30.f * rcpf_(1.f + __expf(gi));
                const float zf = 15.f - 30.f * rcpf_(1.f + __expf(gf));
                const float lf = fminf(zf, 0.f) - __logf(1.f + __expf(-fabsf(zf)));
                float bc = lf;
#pragma unroll
                for (int d = 1; d < 64; d <<= 1) { const float t = __shfl_up(bc, d); if (lane >= d) bc += t; }
                const float a = li - bc; float am = a;
#pragma unroll
                for (int o = 1; o < 64; o <<= 1) am = fmaxf(am, __shfl_xor(am, o));
                const float abar = fmaxf(mst, am);
                rowfac = __expf(a - abar) * 0.08838834764831845f;
                decay = __expf(mst - abar); mnext = __shfl(bc, 63) + abar;
                if (wave == 0) MF[MF_DFL + lane] = __expf(-(bc + abar));
            }
#pragma unroll
            for (int pass = 0; pass < 2; ++pass) {
                const int t = (tid >> 4) + 32 * pass, ch = tid & 15, tl = tl0 + t;
                const float rf = __shfl(rowfac, t);
                const bf16* pr0 = Pcur + (size_t)(b * SEGT + tl) * PW + h * HB + ch * 8;
#pragma unroll
                for (int blk = 0; blk < 2; ++blk) {
                    float acc[8];
                    { const f32x4 b0 = *(const LAS f32x4*)(MF + MF_CW + blk * 640 + 512 + ch * 8), b1 = *(const LAS f32x4*)(MF + MF_CW + blk * 640 + 512 + ch * 8 + 4);
                      acc[0] = b0[0]; acc[1] = b0[1]; acc[2] = b0[2]; acc[3] = b0[3]; acc[4] = b1[0]; acc[5] = b1[1]; acc[6] = b1[2]; acc[7] = b1[3]; }
#pragma unroll
                    for (int j = 0; j < 4; ++j) {
                        const int tq = tl - 3 + j;
                        if (seg * SEGT + tq >= 0) {
                            const bf16* prj = tq >= 0 ? Pcur + (size_t)(b * SEGT + tq) * PW : Pprev + (size_t)(b * SEGT + SEGT + tq) * PW;
                            const v4u raw = *(const GAS v4u*)(prj + h * HB + (blk == 0 ? PO_MQ : PO_MK) + ch * 8);
                            float x[8]; unpack8(raw, x);
                            const f32x4 w0 = *(const LAS f32x4*)(MF + MF_CW + blk * 640 + j * 128 + ch * 8), w1 = *(const LAS f32x4*)(MF + MF_CW + blk * 640 + j * 128 + ch * 8 + 4);
#pragma unroll
                            for (int e = 0; e < 4; ++e) { acc[e] += w0[e] * x[e]; acc[4 + e] += w1[e] * x[4 + e]; }
                        }
                    }
                    const float sc = blk == 0 ? 1.f : rf;
                    v4u o; o.x = pkbf(silf(acc[0]) * sc, silf(acc[1]) * sc); o.y = pkbf(silf(acc[2]) * sc, silf(acc[3]) * sc); o.z = pkbf(silf(acc[4]) * sc, silf(acc[5]) * sc); o.w = pkbf(silf(acc[6]) * sc, silf(acc[7]) * sc);
                    *(LAS v4u*)(L + (blk == 0 ? IMG_QM : IMG_KM) + offb(t, ch)) = o;
                }
                *(LAS v4u*)(L + IMG_VM + offb(t, ch)) = *(const GAS v4u*)(pr0 + PO_MV);
                *(LAS v4u*)(L + IMG_HV + offb(t, ch)) = *(const GAS v4u*)(pr0 + PO_HI);
            }
            {
                const int j = wave & 3, hh = wave >> 2, trow = 16 * j + 8 * hh;
                const bf16* pr = Pcur + (size_t)(b * SEGT + tl0 + trow) * PW + h * HB + 2 * lane;
                unsigned rq[8], rf[8];
#pragma unroll
                for (int i = 0; i < 8; ++i) { rq[i] = *(const GAS unsigned*)(pr + (size_t)i * PW + PO_HQ); rf[i] = *(const GAS unsigned*)(pr + (size_t)i * PW + PO_HF); }
                float lb0 = 0.f, lb1 = 0.f; if (layer != 0) { lb0 = lbp[h * 128 + 2 * lane]; lb1 = lbp[h * 128 + 2 * lane + 1]; }
                float l0[8], l1[8], k0[8], k1[8], q0[8], q1[8];
#pragma unroll
                for (int i = 0; i < 8; ++i) {
                    const float s0 = sigf(bf2f((unsigned short)(rf[i] & 0xffffu))), s1 = sigf(bf2f((unsigned short)(rf[i] >> 16)));
                    l0[i] = __logf(lb0 + (1.f - lb0) * s0); l1[i] = __logf(lb1 + (1.f - lb1) * s1);
                    k0[i] = (1.f - lb0) * (1.f - s0); k1[i] = (1.f - lb1) * (1.f - s1);
                    q0[i] = silf(bf2f((unsigned short)(rq[i] & 0xffffu))); q1[i] = silf(bf2f((unsigned short)(rq[i] >> 16)));
                }
                float run0 = 0.f, run1 = 0.f;
#pragma unroll
                for (int ii = 0; ii < 8; ++ii) {
                    const int i = hh ? ii : 7 - ii;
                    if (hh) { run0 += l0[i]; run1 += l1[i]; }
                    const float e0 = hh ? run0 : -run0, e1 = hh ? run1 : -run1;
                    const unsigned o = offb(trow + i, lane >> 2) + 4 * (lane & 3);
                    *(LAS unsigned*)(L + IMG_HQT + o) = pkbf(q0[i] * __expf(e0), q1[i] * __expf(e1));
                    *(LAS unsigned*)(L + IMG_HKT + o) = pkbf(k0[i] * __expf(-e0), k1[i] * __expf(-e1));
                    if (!hh) { run0 += l0[i]; run1 += l1[i]; }
                }
                typedef float f32x2 __attribute__((ext_vector_type(2)));
                *(LAS f32x2*)(MF + (hh ? MF_E157 : MF_E7) + j * 128 + 2 * lane) = (f32x2){__expf(run0), __expf(run1)};
            }
#ifdef PROBE_PREP2
            }
#endif
            __syncthreads();
            {
                const int tb = wave >> 1; float psum = 0.f;
#pragma unroll
                for (int s2 = 0; s2 < 2; ++s2) {
                    const int sb = 2 * (wave & 1) + s2; LN_FRESH(ln);
                    f32x4 acc = (f32x4){0.f, 0.f, 0.f, 0.f};
#pragma unroll
                    for (int ks = 0; ks < 4; ++ks) acc = mfma16(frag_row(L + IMG_KM, 16 * sb, ks, ln), frag_row(L + IMG_QM, 16 * tb, ks, ln), acc);
                    const int t = 16 * tb + r, s0 = 16 * sb + 4 * q;
                    float v[4];
#pragma unroll
                    for (int e = 0; e < 4; ++e) { v[e] = (s0 + e <= t) ? acc[e] : 0.f; psum += v[e]; }
                    v2u w; w.x = pkbf(v[0], v[1]); w.y = pkbf(v[2], v[3]);
                    *(LAS v2u*)(L + IMG_P + 128 * t + 16 * ((2 * sb + (q >> 1)) ^ (t & 7)) + 8 * (q & 1)) = w;
                }
                psum += __shfl_xor(psum, 16); psum += __shfl_xor(psum, 32);
                if (q == 0) MF[MF_RS + 2 * (16 * tb + r) + (wave & 1)] = psum;
            }
            {
                const int t = tid >> 3, part = tid & 7;
                const v4u a0 = *(const LAS v4u*)(L + IMG_QM + offb(t, 2 * part)), a1 = *(const LAS v4u*)(L + IMG_QM + offb(t, 2 * part + 1));
                float x0[8], x1[8]; unpack8(a0, x0); unpack8(a1, x1);
                float d = 0.f;
#pragma unroll
                for (int e4 = 0; e4 < 2; ++e4) { const f32x4 n0 = *(const LAS f32x4*)(MF + MF_N + 16 * part + 4 * e4), n1 = *(const LAS f32x4*)(MF + MF_N + 16 * part + 8 + 4 * e4);
#pragma unroll
                    for (int e = 0; e < 4; ++e) { d += x0[4 * e4 + e] * n0[e]; d += x1[4 * e4 + e] * n1[e]; } }
                d += __shfl_xor(d, 1); d += __shfl_xor(d, 2); d += __shfl_xor(d, 4);
                if (part == 0) MF[MF_QN + t] = d;
            }
            if (wave >= 4) {
                const int j = wave - 4; LN_FRESH(ln);
                f32x4 acc = (f32x4){0.f, 0.f, 0.f, 0.f};
#pragma unroll
                for (int ks = 0; ks < 4; ++ks) acc = mfma16(frag_row(L + IMG_HKT, 16 * j, ks, ln), frag_row(L + IMG_HQT, 16 * j, ks, ln), acc);
                float v[4];
#pragma unroll
                for (int e = 0; e < 4; ++e) v[e] = (4 * q + e <= r) ? acc[e] : 0.f;
                v2u w; w.x = pkbf(v[0], v[1]); w.y = pkbf(v[2], v[3]);
                *(LAS v2u*)(L + PH_OFF + j * 1024 + r * 64 + 8 * q) = w;
            }
            __syncthreads();
            f32x4 hval[4], oacc[4];
            {
                f32x4 Cd[8];
#pragma unroll
                for (int mb = 0; mb < 8; ++mb) Cd[mb] = Cacc[mb] * decay;
                bf16x8 bC[4], bV[2];
#pragma unroll
                for (int ks = 0; ks < 4; ++ks) bC[ks] = pack_acc(Cd[2 * ks], Cd[2 * ks + 1]);
#pragma unroll
                for (int ks = 0; ks < 2; ++ks) { LN_FRESH(ln); bV[ks] = frag_tr(L + IMG_VM, 32 * ks, wave, ln, 31); }
#pragma unroll
                for (int mt = 0; mt < 4; ++mt) {
                    f32x4 acc = (f32x4){0.f, 0.f, 0.f, 0.f}; LN_FRESH(ln);
#pragma unroll
                    for (int ks = 0; ks < 4; ++ks) acc = mfma16(frag_q2(L + IMG_QM, 16 * mt, ks, ln), bC[ks], acc);
#pragma unroll
                    for (int ks = 0; ks < 2; ++ks) { const int t = 16 * mt + r; acc = mfma16(ld16(L + IMG_P + 128 * t + 16 * ((4 * ks + q) ^ (t & 7))), bV[ks], acc); }
                    const int t0 = 16 * mt + 4 * q;
                    const f32x4 r0 = *(const LAS f32x4*)(MF + MF_RS + 2 * t0), r1 = *(const LAS f32x4*)(MF + MF_RS + 2 * t0 + 4), qn4 = *(const LAS f32x4*)(MF + MF_QN + t0), df4 = *(const LAS f32x4*)(MF + MF_DFL + t0);
                    const float den0 = r0[0] + r0[1] + decay * qn4[0], den1 = r0[2] + r0[3] + decay * qn4[1], den2 = r1[0] + r1[1] + decay * qn4[2], den3 = r1[2] + r1[3] + decay * qn4[3];
                    hval[mt][0] = acc[0] * rcpf_(fmaxf(fabsf(den0), df4[0])); hval[mt][1] = acc[1] * rcpf_(fmaxf(fabsf(den1), df4[1])); hval[mt][2] = acc[2] * rcpf_(fmaxf(fabsf(den2), df4[2])); hval[mt][3] = acc[3] * rcpf_(fmaxf(fabsf(den3), df4[3]));
                }
#pragma unroll
                for (int mb = 0; mb < 8; ++mb) {
                    f32x4 acc = Cd[mb]; LN_FRESH(ln);
#pragma unroll
                    for (int ks = 0; ks < 2; ++ks) acc = mfma16(frag_tr(L + IMG_KM, 32 * ks, mb, ln, 31), bV[ks], acc);
                    Cacc[mb] = acc;
                }
                {
                    const int ch = tid & 15, sg = tid >> 4;
                    const v4u a0 = *(const LAS v4u*)(L + IMG_KM + offb(2 * sg, ch)), a1 = *(const LAS v4u*)(L + IMG_KM + offb(2 * sg + 1, ch));
                    float x0[8], x1[8]; unpack8(a0, x0); unpack8(a1, x1);
                    float ps[8];
#pragma unroll
                    for (int e = 0; e < 8; ++e) { ps[e] = x0[e] + x1[e]; ps[e] += __shfl_xor(ps[e], 16); ps[e] += __shfl_xor(ps[e], 32); }
                    if (lane < 16) { *(LAS f32x4*)(MF + MF_NRED + wave * 128 + 8 * ch) = (f32x4){ps[0], ps[1], ps[2], ps[3]}; *(LAS f32x4*)(MF + MF_NRED + wave * 128 + 8 * ch + 4) = (f32x4){ps[4], ps[5], ps[6], ps[7]}; }
                }
            }
#pragma unroll
            for (int j = 0; j < 4; ++j) {
                f32x4 T[8];
#pragma unroll
                for (int mb = 0; mb < 8; ++mb) T[mb] = Sacc[mb] * *(const LAS f32x4*)(MF + MF_E7 + j * 128 + 16 * mb + 4 * q);
                bf16x8 bS[4];
#pragma unroll
                for (int ks = 0; ks < 4; ++ks) bS[ks] = pack_acc(T[2 * ks], T[2 * ks + 1]);
                f32x4 acc = (f32x4){0.f, 0.f, 0.f, 0.f};
                { LN_FRESH(ln);
#pragma unroll
                for (int ks = 0; ks < 4; ++ks) acc = mfma16(frag_q2(L + IMG_HQT, 16 * j, ks, ln), bS[ks], acc); }
                LN_FRESH(ln2);
                const bf16x8 bVh = frag_tr(L + IMG_HV, 16 * j, wave, ln2, 15);
                acc = mfma16(ld16(L + PH_OFF + j * 1024 + r * 64 + 16 * q), bVh, acc);
                oacc[j] = acc;
#pragma unroll
                for (int mb = 0; mb < 8; ++mb) {
                    LN_FRESH(ln3);
                    bf16x8 aK = frag_tr(L + IMG_HKT, 16 * j, mb, ln3, 15);
                    if (q >= 2) aK = (bf16x8){0, 0, 0, 0, 0, 0, 0, 0};
                    Sacc[mb] = mfma16(aK, bVh, T[mb]) * *(const LAS f32x4*)(MF + MF_E157 + j * 128 + 16 * mb + 4 * q);
                }
            }
            __syncthreads();
            const int t4 = tid >> 3, c8 = tid & 7;
            const bf16* pc = Pcur + (size_t)(b * SEGT + tl0 + t4) * PW + h * HB + 16 * c8;
            const v4u ca0 = *(const GAS v4u*)(pc + PO_CA), ca1 = *(const GAS v4u*)(pc + PO_CA + 8), cb0 = *(const GAS v4u*)(pc + PO_CB), cb1 = *(const GAS v4u*)(pc + PO_CB + 8);
#pragma unroll
            for (int mt = 0; mt < 4; ++mt)
#pragma unroll
                for (int e = 0; e < 4; ++e) { const int tt = 16 * mt + 4 * q + e, dvc = 16 * wave + r; const unsigned o = offb(tt, dvc >> 3) + 2 * (dvc & 7);
                    *(LAS unsigned short*)(L + HAB_OFF + o) = (unsigned short)(pkbf(hval[mt][e], hval[mt][e]) & 0xffffu); *(LAS unsigned short*)(L + OBB_OFF + o) = (unsigned short)(pkbf(oacc[mt][e], oacc[mt][e]) & 0xffffu); }
            if (tid < 128) { float s = decay * MF[MF_N + tid];
#pragma unroll
                for (int w = 0; w < 8; ++w) s += MF[MF_NRED + w * 128 + tid];
                MF[MF_N + tid] = s; }
            __syncthreads();
            {
                float ha[16], ob[16], ca[16], cb[16];
                { const v4u a0 = *(const LAS v4u*)(L + HAB_OFF + offb(t4, 2 * c8)), a1 = *(const LAS v4u*)(L + HAB_OFF + offb(t4, 2 * c8 + 1)), b0 = *(const LAS v4u*)(L + OBB_OFF + offb(t4, 2 * c8)), b1 = *(const LAS v4u*)(L + OBB_OFF + offb(t4, 2 * c8 + 1));
                  float x[8]; unpack8(a0, x);
#pragma unroll
                  for (int e = 0; e < 8; ++e) ha[e] = x[e];
                  unpack8(a1, x);
#pragma unroll
                  for (int e = 0; e < 8; ++e) ha[8 + e] = x[e];
                  unpack8(b0, x);
#pragma unroll
                  for (int e = 0; e < 8; ++e) ob[e] = x[e];
                  unpack8(b1, x);
#pragma unroll
                  for (int e = 0; e < 8; ++e) ob[8 + e] = x[e];
                  unpack8(ca0, x);
#pragma unroll
                  for (int e = 0; e < 8; ++e) ca[e] = x[e];
                  unpack8(ca1, x);
#pragma unroll
                  for (int e = 0; e < 8; ++e) ca[8 + e] = x[e];
                  unpack8(cb0, x);
#pragma unroll
                  for (int e = 0; e < 8; ++e) cb[e] = x[e];
                  unpack8(cb1, x);
#pragma unroll
                  for (int e = 0; e < 8; ++e) cb[8 + e] = x[e]; }
                float ssa = 0.f, ssb = 0.f;
#pragma unroll
                for (int e = 0; e < 16; ++e) { ssa += ha[e] * ha[e]; ssb += ob[e] * ob[e]; }
#pragma unroll
                for (int o = 1; o < 8; o <<= 1) { ssa += __shfl_xor(ssa, o); ssb += __shfl_xor(ssb, o); }
                const float ra = rsqrtf(ssa * (1.f / 128.f) + RMS_EPS), rb = rsqrtf(ssb * (1.f / 128.f) + RMS_EPS);
                float y[16];
#pragma unroll
                for (int e4 = 0; e4 < 4; ++e4) { const f32x4 wa = *(const LAS f32x4*)(MF + MF_WN + 16 * c8 + 4 * e4), wb = *(const LAS f32x4*)(MF + MF_WN + 128 + 16 * c8 + 4 * e4);
#pragma unroll
                    for (int e = 0; e < 4; ++e) y[4 * e4 + e] = ca[4 * e4 + e] * (ha[4 * e4 + e] * ra * wa[e]) + cb[4 * e4 + e] * (ob[4 * e4 + e] * rb * wb[e]); }
                v4u o0, o1; o0.x = pkbf(y[0], y[1]); o0.y = pkbf(y[2], y[3]); o0.z = pkbf(y[4], y[5]); o0.w = pkbf(y[6], y[7]); o1.x = pkbf(y[8], y[9]); o1.y = pkbf(y[10], y[11]); o1.z = pkbf(y[12], y[13]); o1.w = pkbf(y[14], y[15]);
                bf16* yp = Y + (grow0 + t4) * D + h * 128 + 16 * c8;
                if (!DRY) { *(GAS v4u*)yp = o0; *(GAS v4u*)(yp + 8) = o1; } else { asm volatile("" :: "v"(o0), "v"(o1)); }
            }
            mst = mnext;
        }
        int lane_s; asm volatile("v_mbcnt_lo_u32_b32 %0, -1, 0\n\tv_mbcnt_hi_u32_b32 %0, -1, %0" : "=v"(lane_s));
#pragma unroll
        for (int mb = 0; mb < 8; ++mb)
#pragma unroll
            for (int e = 0; e < 4; ++e) { if (!DRY) { stC[((size_t)(bh * 8 + wave) * 32 + mb * 4 + e) * 64 + lane_s] = Cacc[mb][e]; stS[((size_t)(bh * 8 + wave) * 32 + mb * 4 + e) * 64 + lane_s] = Sacc[mb][e]; } else { asm volatile("" :: "v"(Cacc[mb][e]), "v"(Sacc[mb][e])); } }
        __syncthreads();
        if (!DRY) { if (tid < 128) stN[bh * 128 + tid] = MF[MF_N + tid];
        if (tid == 0) stM[bh] = mst; }
        __syncthreads();
    }
}

__global__ void __launch_bounds__(NWAVES * 64, 2) fwd_kernel(Args kernel_args_unused) {
    extern __shared__ __attribute__((aligned(16))) unsigned char lds[];
    Ctx F;
    F.lds = (LAS unsigned char*)lds;
    F.wave_s = __builtin_amdgcn_readfirstlane(threadIdx.x >> 6);
    F.G = gridDim.x; { const int bx = blockIdx.x; F.vcu = (F.G % 8 == 0) ? (bx % 8) * (F.G / 8) + bx / 8 : bx; }
    volatile LAS unsigned* MISC = (volatile LAS unsigned*)(F.lds + MISC_OFF);
    if (threadIdx.x < 64) MISC[threadIdx.x] = 0u;
    __syncthreads();
    unsigned bar_x;
    { ARGS(); const XcdBarrier b0 = xcd_barrier_post((unsigned*)((gu32*)(A.ws + WS_CTL) + CW_BAR), MISC + 8); bar_x = b0.x; }
#define GRID_BAR() do { ARGS(); XcdBarrier bb; bb.bar = (unsigned*)((gu32*)(A.ws + WS_CTL) + CW_BAR); bb.x = bar_x; asm volatile("" : "+s"(bb.x)); bb.st = (volatile LAS unsigned*)(F.lds + MISC_OFF) + 8; xcd_barrier(bb); } while (0)

    p0_prologue(F);
    GRID_BAR();

    for (int layer = 0; layer < DEPTH; ++layer) {
#define PHASE_PTRS() ARGS(); const float* src = layer == 0 ? A.in[0] : (const float*)A.out; const float* modl = (const float*)(A.ws + WS_MOD) + (size_t)layer * BATCH * MODW; bf16* hn = (bf16*)(A.ws + WS_HN); (void)src; (void)modl; (void)hn
#ifdef PROBE_EW2
        { PHASE_PTRS();
        norm_phase<true>(F, src, A.in[4] + (size_t)layer * D, modl, 0, D, hn, (float*)(A.ws + WS_GATES), (const float*)(A.ws + WS_WG) + (size_t)layer * 16 * D, (const float*)(A.ws + WS_BG) + layer * 16); __syncthreads(); }
#endif
        { PHASE_PTRS();
        norm_phase<true>(F, src, A.in[4] + (size_t)layer * D, modl, 0, D, hn, (float*)(A.ws + WS_GATES), (const float*)(A.ws + WS_WG) + (size_t)layer * 16 * D, (const float*)(A.ws + WS_BG) + layer * 16); }
        GRID_BAR();
        for (int seg = 0; seg < NSEG; ++seg) {
            {
                PHASE_PTRS();
                pg8::Gemm g{hn, (const bf16*)(A.ws + WS_WIN) + (size_t)layer * NPROJ * D, SEGROWS, NPROJ, D, SEG_SH, SEQ / 256, seg * (SEGT / 256), SEGT / 256 - 1};
                pg8::StaticOrder S; S.init(SEGROWS, NPROJ, F.G, (int)blockIdx.x);
                pg8::EpiInProj E{(bf16*)(A.ws + WS_P + (size_t)(seg & 1) * P_BYTES), PW, (const float*)(A.ws + WS_BIASP) + (size_t)layer * NPROJ};
                pg8::gemm_phase<pg8::EpiInProj, pg8::StaticOrder, PG8_ALIGN, PG8_SP2>(F.lds + RING_OFF, g, S, E, F.wave_s);
            }
            GRID_BAR();
#ifdef PROBE_MIX2
            mixer_fast_phase<true>(F, layer, seg); __syncthreads();
#endif
            mixer_fast_phase<false>(F, layer, seg);
            GRID_BAR();
        }
        {
            PHASE_PTRS();
            pg8::Gemm g{(const bf16*)(A.ws + WS_Y), (const bf16*)(A.ws + WS_WOUT) + (size_t)layer * D * D, M, D, D, 0, 1, 0, 0};
            pg8::StaticOrder S; S.init(M, D, F.G, (int)blockIdx.x);
            pg8::EpiResid E{src, A.out, D, modl + 2 * D, MODW, 0};
#ifdef PROBE_GEMM2
            { pg8::EpiResid E2 = E; E2.out = (float*)(A.ws + WS_P); pg8::gemm_phase<pg8::EpiResid, pg8::StaticOrder, PG8_ALIGN, PG8_SP2>(F.lds + RING_OFF, g, S, E2, F.wave_s); __syncthreads(); }
#endif
            pg8::gemm_phase<pg8::EpiResid, pg8::StaticOrder, PG8_ALIGN, PG8_SP2>(F.lds + RING_OFF, g, S, E, F.wave_s);
        }
        GRID_BAR();
#ifdef PROBE_EW2
        { PHASE_PTRS();
        norm_phase<false>(F, (const float*)A.out, A.in[13] + (size_t)layer * D, modl, 3 * D, 4 * D, hn, nullptr, nullptr, nullptr); __syncthreads(); }
#endif
        { PHASE_PTRS();
        norm_phase<false>(F, (const float*)A.out, A.in[13] + (size_t)layer * D, modl, 3 * D, 4 * D, hn, nullptr, nullptr, nullptr); }
        GRID_BAR();
        for (int fs = 0; fs < FSEG; ++fs) {
            {
                PHASE_PTRS();
                pg8::Gemm g{hn + (size_t)fs * FROWS * D, (const bf16*)(A.ws + WS_WUP) + (size_t)layer * 2 * DFF * D, FROWS, 2 * DFF, D, 0, 1, 0, 0};
                pg8::StaticOrder S; S.init(FROWS, 2 * DFF, F.G, (int)blockIdx.x);
                pg8::EpiBf16B E{(bf16*)(A.ws + WS_U), 2 * DFF, nullptr};
#ifdef PROBE_GEMM2
                { pg8::EpiBf16B E2 = E; E2.O = (bf16*)(A.ws + WS_G); pg8::gemm_phase<pg8::EpiBf16B, pg8::StaticOrder, PG8_ALIGN, PG8_SP2>(F.lds + RING_OFF, g, S, E2, F.wave_s); __syncthreads(); }
#endif
                pg8::gemm_phase<pg8::EpiBf16B, pg8::StaticOrder, PG8_ALIGN, PG8_SP2>(F.lds + RING_OFF, g, S, E, F.wave_s);
            }
            GRID_BAR();
#ifdef PROBE_EW2
            { ARGS(); ffn_glu_phase(F, (const bf16*)(A.ws + WS_U), (bf16*)(A.ws + WS_G), A.in[15] + (size_t)layer * 3 * 2 * DFF, A.in[16] + (size_t)layer * 2 * DFF); __syncthreads(); }
#endif
            { ARGS(); ffn_glu_phase(F, (const bf16*)(A.ws + WS_U), (bf16*)(A.ws + WS_G), A.in[15] + (size_t)layer * 3 * 2 * DFF, A.in[16] + (size_t)layer * 2 * DFF); }
            GRID_BAR();
            {
                PHASE_PTRS();
                pg8::Gemm g{(const bf16*)(A.ws + WS_G), (const bf16*)(A.ws + WS_WDN) + (size_t)layer * D * DFF, FROWS, D, DFF, 0, 1, 0, 0};
                pg8::StaticOrder S; S.init(FROWS, D, F.G, (int)blockIdx.x);
                pg8::EpiResid E{(const float*)A.out, A.out, D, modl + 5 * D, MODW, fs * FROWS};
#ifdef PROBE_GEMM2
                { pg8::EpiResid E2 = E; E2.out = (float*)(A.ws + 778 * MiB) - (size_t)fs * FROWS * D; pg8::gemm_phase<pg8::EpiResid, pg8::StaticOrder, PG8_ALIGN, PG8_SP2>(F.lds + RING_OFF, g, S, E2, F.wave_s); __syncthreads(); }
#endif
                pg8::gemm_phase<pg8::EpiResid, pg8::StaticOrder, PG8_ALIGN, PG8_SP2>(F.lds + RING_OFF, g, S, E, F.wave_s);
            }
            GRID_BAR();
        }
    }
    { ARGS(); final_norm_phase(F, A.out, A.in[18]); }
#undef GRID_BAR
}

extern "C" void kernel_launch(void* const* d_in, const int* in_sizes, int n_in, void* d_out, int out_size, void* d_ws, size_t ws_size, hipStream_t stream) {
    static int grid = 0;
    if (grid == 0) {
        if (n_in != 19 || in_sizes[0] != M * D || out_size != M * D || ws_size < WS_END) { fprintf(stderr, "kernel_launch: unexpected shapes (n_in %d, in0 %d, out %d, ws %zu; need ws >= %zu); nothing launched\n", n_in, n_in > 0 ? in_sizes[0] : -1, out_size, ws_size, (size_t)WS_END); grid = -1; return; }
        int dev = 0, cus = 0, per_cu = 0;
        if (hipGetDevice(&dev) != hipSuccess || hipDeviceGetAttribute(&cus, hipDeviceAttributeMultiprocessorCount, dev) != hipSuccess) { grid = -1; return; }
        if (hipFuncSetAttribute((const void*)fwd_kernel, hipFuncAttributeMaxDynamicSharedMemorySize, LDS_BYTES) != hipSuccess) { fprintf(stderr, "kernel_launch: hipFuncSetAttribute failed\n"); grid = -1; return; }
        if (hipOccupancyMaxActiveBlocksPerMultiprocessor(&per_cu, (const void*)fwd_kernel, NWAVES * 64, LDS_BYTES) != hipSuccess || per_cu < 1)
            fprintf(stderr, "kernel_launch: note: occupancy query reports %d workgroups per CU\n", per_cu);
        (void)hipGetLastError();
        grid = cus;
    }
    if (grid < 0) return;
    if (hipMemsetAsync((char*)d_ws + WS_CTL, 0, CTL_ZERO_BYTES, stream) != hipSuccess) return;
    Args a{};
    for (int i = 0; i < 19; ++i) a.in[i] = (const float*)d_in[i];
    a.out = (float*)d_out; a.ws = (unsigned char*)d_ws;
    hipLaunchKernelGGL(fwd_kernel, dim3(grid), dim3(NWAVES * 64), LDS_BYTES, stream, a);
}
```

```cpp
#include <hip/hip_runtime.h>
#include <cstdio>
#include <cstdint>
namespace pg8 {
#define PG8_LAS __attribute__((address_space(3)))
typedef unsigned short bf16_t;
typedef short bf16x8 __attribute__((ext_vector_type(8)));
typedef float f32x4 __attribute__((ext_vector_type(4)));
typedef unsigned u32x4 __attribute__((ext_vector_type(4)));
constexpr int BM = 256, BK = 64, HALF = 128, HTB = HALF * BK * 2  , STAGE_BYTES = 8 * HTB, NXCD = 8, WGM = 8;

__host__ __device__ __forceinline__ int lds_byte(int r, int c) { const int st = (r >> 4) * 2 + (c >> 5), rr = r & 15, cc = c & 31, ob = rr * 64 + cc * 2; return st * 1024 + (ob ^ (((ob >> 9) & 1) << 5)); }
__host__ __device__ __forceinline__ void stage_rc(int b, int& R, int& C) { const int st = b / 1024, sb = b % 1024, swz = sb ^ (((sb >> 9) & 1) << 5); R = (st >> 1) * 16 + swz / 64; C = (st & 1) * 32 + (swz % 64) / 2; }
__host__ __device__ __forceinline__ int perm32(int rho) { const int n = rho >> 4, i = rho & 15; return 8 * (i >> 2) + 4 * n + (i & 3); }

struct Unit { int pm, pn; };
struct Gemm { const bf16_t* A; const bf16_t* Bt; int M, N, K; int a_sh, a_mul, a_add, a_mask;
    __device__ __forceinline__ int atile(int pm) const { return (pm >> a_sh) * a_mul + a_add + (pm & a_mask); } };

struct StaticOrder {
    int nM, nN, nwg, G, c;
    __host__ __device__ void init(int M, int N, int G_, int c_) { nM = M / BM; nN = N / BM; nwg = nM * nN; G = G_; c = c_; }
    __host__ __device__ bool next(int i, Unit& u) const {
        const long L = (long)i * G + c; if (L >= nwg) return false;
        int wgid = (int)L; { const int q = nwg / NXCD, r = nwg % NXCD, xcd = wgid % NXCD, off = wgid / NXCD; wgid = (xcd < r ? xcd * (q + 1) : r * (q + 1) + (xcd - r) * q) + off; }
        const int nig = WGM * nN, gid = wgid / nig, fm = gid * WGM, gsz = (nM - fm) < WGM ? (nM - fm) : WGM;
        u.pm = fm + ((wgid % nig) % gsz); u.pn = (wgid % nig) / gsz; return true;
    }
    __device__ __forceinline__ void a_ready(const Unit&) const {}
    __device__ __forceinline__ void done(const Unit&) const {}
};

__device__ __forceinline__ unsigned cvt_pk_bf16(float lo, float hi) { unsigned r; asm volatile("v_cvt_pk_bf16_f32 %0, %1, %2" : "=v"(r) : "v"(lo), "v"(hi)); return r; }

struct EpiBf16B {
    static constexpr bool PERM = true, AFTER_DRAIN = false;
    bf16_t* O; int ldc; const float* bias;
    __device__ __forceinline__ void operator()(const f32x4 (&acc)[2][2][4][2], const Unit& u, int wr, int wc, int fr, int fq) const {
        const int row0 = u.pm * BM + wr * 64 + fr; const int col0 = u.pn * BM + wc * 32 + 8 * fq;
        f32x4 bv[2][2];
#pragma unroll
        for (int bj = 0; bj < 2; ++bj)
#pragma unroll
            for (int n = 0; n < 2; ++n) bv[bj][n] = bias ? *(const f32x4*)(bias + col0 + bj * HALF + 4 * n) : (f32x4){0.f, 0.f, 0.f, 0.f};
#pragma unroll
        for (int ai = 0; ai < 2; ++ai)
#pragma unroll
            for (int m = 0; m < 4; ++m) { bf16_t* rowp = O + (size_t)(row0 + ai * HALF + m * 16) * ldc + col0;
#pragma unroll
                for (int bj = 0; bj < 2; ++bj) { const f32x4 v0 = acc[ai][bj][m][0] + bv[bj][0], v1 = acc[ai][bj][m][1] + bv[bj][1];
                    u32x4 w; w.x = cvt_pk_bf16(v0[0], v0[1]); w.y = cvt_pk_bf16(v0[2], v0[3]); w.z = cvt_pk_bf16(v1[0], v1[1]); w.w = cvt_pk_bf16(v1[2], v1[3]);
                    *(u32x4*)(rowp + bj * HALF) = w; } }
    }
};
struct EpiResid {
    static constexpr bool PERM = false, AFTER_DRAIN = false;
    const float* res; float* out; int ldc; const float* gate; int gstride; int row_off;
    __device__ __forceinline__ void operator()(const f32x4 (&acc)[2][2][4][2], const Unit& u, int wr, int wc, int fr, int fq) const {
        const int rbase = row_off + u.pm * BM; const int b = rbase >> 11;
        const int row0 = rbase + wr * 64 + fr, col0 = u.pn * BM + wc * 32 + 4 * fq;
        const float* gp = gate + (size_t)b * gstride + col0;
        f32x4 gv[2][2];
#pragma unroll
        for (int bj = 0; bj < 2; ++bj)
#pragma unroll
            for (int n = 0; n < 2; ++n) gv[bj][n] = *(const f32x4*)(gp + bj * HALF + n * 16);
#pragma unroll
        for (int ai = 0; ai < 2; ++ai)
#pragma unroll
            for (int m = 0; m < 4; ++m) { const size_t off = (size_t)(row0 + ai * HALF + m * 16) * ldc + col0;
#pragma unroll
                for (int bj = 0; bj < 2; ++bj)
#pragma unroll
                    for (int n = 0; n < 2; ++n) { const f32x4 r = *(const f32x4*)(res + off + bj * HALF + n * 16);
                        *(f32x4*)(out + off + bj * HALF + n * 16) = r + gv[bj][n] * acc[ai][bj][m][n]; } }
    }
};


struct EpiInProj {
    static constexpr bool PERM = true, AFTER_DRAIN = false;
    bf16_t* O; int ldc; const float* bias;
    __device__ __forceinline__ void operator()(const f32x4 (&acc)[2][2][4][2], const Unit& u, int wr, int wc, int fr, int fq) const {
        const int head = u.pn / 5, part = u.pn - 5 * head;
        const int row0 = u.pm * BM + wr * 64 + fr, cin = wc * 32 + 8 * fq;
        f32x4 bv[2][2];
#pragma unroll
        for (int bj = 0; bj < 2; ++bj)
#pragma unroll
            for (int n = 0; n < 2; ++n) bv[bj][n] = *(const f32x4*)(bias + u.pn * BM + bj * HALF + cin + 4 * n);
        if (part < 3) {
#pragma unroll
            for (int ai = 0; ai < 2; ++ai)
#pragma unroll
                for (int m = 0; m < 4; ++m) { bf16_t* rowp = O + (size_t)(row0 + ai * HALF + m * 16) * ldc + head * 1024 + part * 256 + cin;
#pragma unroll
                    for (int bj = 0; bj < 2; ++bj) { const f32x4 v0 = acc[ai][bj][m][0] + bv[bj][0], v1 = acc[ai][bj][m][1] + bv[bj][1];
                        u32x4 w; w.x = cvt_pk_bf16(v0[0], v0[1]); w.y = cvt_pk_bf16(v0[2], v0[3]); w.z = cvt_pk_bf16(v1[0], v1[1]); w.w = cvt_pk_bf16(v1[2], v1[3]);
                        *(u32x4*)(rowp + bj * HALF) = w; } }
        } else {
            const bool silu0 = part == 4;
#pragma unroll
            for (int ai = 0; ai < 2; ++ai)
#pragma unroll
                for (int m = 0; m < 4; ++m) { bf16_t* rowp = O + (size_t)(row0 + ai * HALF + m * 16) * ldc + head * 1024 + 768 + (part - 3) * 128 + cin;
                    float c[8];
#pragma unroll
                    for (int n = 0; n < 2; ++n) { const f32x4 x0 = acc[ai][0][m][n] + bv[0][n], x1 = acc[ai][1][m][n] + bv[1][n];
#pragma unroll
                        for (int e = 0; e < 4; ++e) { const float s0 = __builtin_amdgcn_rcpf(1.f + __expf(-x0[e])), s1 = __builtin_amdgcn_rcpf(1.f + __expf(-x1[e])); c[4 * n + e] = (silu0 ? x0[e] * s0 : s0) * s1; } }
                    u32x4 w; w.x = cvt_pk_bf16(c[0], c[1]); w.y = cvt_pk_bf16(c[2], c[3]); w.z = cvt_pk_bf16(c[4], c[5]); w.w = cvt_pk_bf16(c[6], c[7]);
                    *(u32x4*)rowp = w; }
        }
    }
};

struct EpiUpGlu {
    static constexpr bool PERM = true, AFTER_DRAIN = false;
    bf16_t* G; bf16_t* S; const float* cw; const float* cb; int nf;
    __device__ __forceinline__ void operator()(const f32x4 (&acc)[2][2][4][2], const Unit& u, int wr, int wc, int fr, int fq) const {
        const int cin = wc * 32 + 8 * fq, f0 = u.pn * HALF + cin;
        if (fr < 2 || fr >= 14) {
            const int m = fr < 2 ? 0 : 3, rr = fr < 2 ? fr : fr - 12;
#pragma unroll
            for (int ai = 0; ai < 2; ++ai) { const int g64 = u.pm * 4 + 2 * ai + wr; bf16_t* sp = S + ((size_t)g64 * 4 + rr) * (2 * nf) + u.pn * BM + cin;
#pragma unroll
                for (int bj = 0; bj < 2; ++bj) { const f32x4 v0 = fr < 2 ? acc[ai][bj][0][0] : acc[ai][bj][3][0], v1 = fr < 2 ? acc[ai][bj][0][1] : acc[ai][bj][3][1];
                    u32x4 w; w.x = cvt_pk_bf16(v0[0], v0[1]); w.y = cvt_pk_bf16(v0[2], v0[3]); w.z = cvt_pk_bf16(v1[0], v1[1]); w.w = cvt_pk_bf16(v1[2], v1[3]);
                    *(u32x4*)(sp + bj * HALF) = w; } }
            (void)m;
        }
        unsigned outp[2][4][4];
        const int l1 = (fr + 15) & 15, l2 = (fr + 14) & 15;
#pragma unroll
        for (int n = 0; n < 2; ++n) {
            const f32x4 wg0 = *(const f32x4*)(cw + f0 + 4 * n), wg1 = *(const f32x4*)(cw + 2 * nf + f0 + 4 * n), wg2 = *(const f32x4*)(cw + 4 * nf + f0 + 4 * n);
            const f32x4 wv0 = *(const f32x4*)(cw + nf + f0 + 4 * n), wv1 = *(const f32x4*)(cw + 3 * nf + f0 + 4 * n), wv2 = *(const f32x4*)(cw + 5 * nf + f0 + 4 * n);
            const f32x4 bg = *(const f32x4*)(cb + f0 + 4 * n), bv = *(const f32x4*)(cb + nf + f0 + 4 * n);
#pragma unroll
            for (int ai = 0; ai < 2; ++ai) {
                float o[4][4];
#pragma unroll
                for (int e = 0; e < 4; ++e) {
                    float g1[4], g2[4], v1[4], v2[4];
#pragma unroll
                    for (int m = 0; m < 4; ++m) { g1[m] = __shfl(acc[ai][0][m][n][e], l1, 16); g2[m] = __shfl(acc[ai][0][m][n][e], l2, 16); v1[m] = __shfl(acc[ai][1][m][n][e], l1, 16); v2[m] = __shfl(acc[ai][1][m][n][e], l2, 16); }
#pragma unroll
                    for (int m = 0; m < 4; ++m) {
                        const float pg1 = fr == 0 ? (m > 0 ? g1[m > 0 ? m - 1 : 0] : 0.f) : g1[m], pg2 = fr < 2 ? (m > 0 ? g2[m > 0 ? m - 1 : 0] : 0.f) : g2[m];
                        const float pv1 = fr == 0 ? (m > 0 ? v1[m > 0 ? m - 1 : 0] : 0.f) : v1[m], pv2 = fr < 2 ? (m > 0 ? v2[m > 0 ? m - 1 : 0] : 0.f) : v2[m];
                        const float cg = bg[e] + wg2[e] * acc[ai][0][m][n][e] + wg1[e] * pg1 + wg0[e] * pg2;
                        const float cv = bv[e] + wv2[e] * acc[ai][1][m][n][e] + wv1[e] * pv1 + wv0[e] * pv2;
                        o[m][e] = cg * __builtin_amdgcn_rcpf(1.f + __expf(-cg)) * cv;
                    }
                }
#pragma unroll
                for (int m = 0; m < 4; ++m) { outp[ai][m][2 * n] = cvt_pk_bf16(o[m][0], o[m][1]); outp[ai][m][2 * n + 1] = cvt_pk_bf16(o[m][2], o[m][3]); }
            }
        }
#pragma unroll
        for (int ai = 0; ai < 2; ++ai)
#pragma unroll
            for (int m = 0; m < 4; ++m) if (m > 0 || fr >= 2) { u32x4 w; w.x = outp[ai][m][0]; w.y = outp[ai][m][1]; w.z = outp[ai][m][2]; w.w = outp[ai][m][3];
                *(u32x4*)(G + (size_t)(u.pm * BM + ai * HALF + wr * 64 + m * 16 + fr) * nf + f0) = w; }
    }
};
template <class Epi, class Sched, bool ALIGN_EPI = false, bool SP2 = false>
__device__ __forceinline__ void gemm_phase(PG8_LAS unsigned char* lds, const Gemm g, const Sched& S, const Epi& E, const int wave_id  ) {
    int tid_l; asm volatile("v_mbcnt_lo_u32_b32 %0, -1, 0\n\tv_mbcnt_hi_u32_b32 %0, -1, %0" : "=v"(tid_l)); tid_l += wave_id * 64;
    const int tid = tid_l, wid = __builtin_amdgcn_readfirstlane(tid >> 6), lane = tid & 63, wr = wid >> 2, wc = wid & 3, fr = lane & 15, fq = lane >> 4;
    const int K = g.K, nt = K / BK;
    unsigned voffA[2], voffB[2];
#pragma unroll
    for (int i = 0; i < 2; ++i) { int R, C; stage_rc(tid * 16 + i * 8192, R, C); const int Rb = Epi::PERM ? ((R & ~31) + perm32(R & 31)) : R;
        voffA[i] = (unsigned)(R * K + C) * 2u; voffB[i] = (unsigned)(Rb * K + C) * 2u; }
    const size_t kstep = (size_t)(BK * 2);
    const size_t hstep = (size_t)HALF * K * 2;
    const size_t tstep = 2 * hstep;
    const unsigned ldsw = (unsigned)wid * 1024u;
    const int aoff = lds_byte(wr * 64 + fr, fq * 8), boff = lds_byte(wc * 32 + fr, fq * 8);
#define PG8_SA(b, h) (((b) * 2 + (h)) * HTB)
#define PG8_SB(b, h) ((4 + (b) * 2 + (h)) * HTB)
#define PG8_STAGE(bufoff, gbase, voff) do { _Pragma("unroll") for (int _i = 0; _i < 2; ++_i) \
        __builtin_amdgcn_global_load_lds((const unsigned*)((const char*)(gbase) + (voff)[_i]), (PG8_LAS unsigned*)(lds + (bufoff) + ldsw + _i * 8192), 16, 0, 0); } while (0)
#define PG8_LDA(dst, b, h) do { _Pragma("unroll") for (int m = 0; m < 4; ++m) _Pragma("unroll") for (int k = 0; k < 2; ++k) dst[m][k] = *(const PG8_LAS bf16x8*)(lds + PG8_SA(b, h) + aoff + m * 2048 + k * 1024); } while (0)
#define PG8_LDB(dst, b, h) do { _Pragma("unroll") for (int n = 0; n < 2; ++n) _Pragma("unroll") for (int k = 0; k < 2; ++k) dst[n][k] = *(const PG8_LAS bf16x8*)(lds + PG8_SB(b, h) + boff + n * 2048 + k * 1024); } while (0)
#define PG8_MMA(ai, bj, At, Bt) do { __builtin_amdgcn_s_setprio(1); _Pragma("unroll") for (int m = 0; m < 4; ++m) _Pragma("unroll") for (int n = 0; n < 2; ++n) _Pragma("unroll") for (int k = 0; k < 2; ++k) \
        acc[ai][bj][m][n] = __builtin_amdgcn_mfma_f32_16x16x32_bf16(Bt[n][k], At[m][k], acc[ai][bj][m][n], 0, 0, 0); __builtin_amdgcn_s_setprio(0); } while (0)
#define PG8_WAIT_V(n) asm volatile("s_waitcnt vmcnt(" #n ")" ::: "memory")
#define PG8_WAIT_L(n) asm volatile("s_waitcnt lgkmcnt(" #n ")" ::: "memory")
#define PG8_BAR __builtin_amdgcn_s_barrier()
#define PG8_SCHED __builtin_amdgcn_sched_barrier(0)
    Unit cur, nxt; int ui = 0;
    if (!S.next(0, cur)) return;
    f32x4 acc[2][2][4][2];
#pragma unroll
    for (int a = 0; a < 2; ++a)
#pragma unroll
        for (int b = 0; b < 2; ++b)
#pragma unroll
            for (int m = 0; m < 4; ++m)
#pragma unroll
                for (int n = 0; n < 2; ++n) acc[a][b][m][n] = (f32x4){0.f, 0.f, 0.f, 0.f};
    bf16x8 At[4][2], B0[2][2], B1[2][2];
    const char* cA = (const char*)g.A + (size_t)g.atile(cur.pm) * tstep; const char* cB = (const char*)g.Bt + (size_t)cur.pn * tstep;
    S.a_ready(cur);
    if constexpr (SP2) {
        PG8_STAGE(PG8_SB(0, 0), cB, voffB); PG8_STAGE(PG8_SB(0, 1), cB + hstep, voffB); PG8_STAGE(PG8_SA(0, 0), cA, voffA); PG8_STAGE(PG8_SA(0, 1), cA + hstep, voffA);
        if (wr == 1) PG8_BAR;
        PG8_WAIT_V(2); PG8_BAR;
        PG8_STAGE(PG8_SB(1, 0), cB + kstep, voffB); PG8_STAGE(PG8_SA(1, 0), cA + kstep, voffA); PG8_STAGE(PG8_SB(1, 1), cB + hstep + kstep, voffB);
        PG8_WAIT_V(6); PG8_BAR;
    } else {
        PG8_STAGE(PG8_SB(0, 0), cB, voffB); PG8_STAGE(PG8_SA(0, 0), cA, voffA); PG8_STAGE(PG8_SB(0, 1), cB + hstep, voffB); PG8_STAGE(PG8_SA(0, 1), cA + hstep, voffA);
        if (wr == 1) PG8_BAR;
        PG8_WAIT_V(4); PG8_BAR;
        PG8_STAGE(PG8_SB(1, 0), cB + kstep, voffB); PG8_STAGE(PG8_SA(1, 0), cA + kstep, voffA); PG8_STAGE(PG8_SB(1, 1), cB + hstep + kstep, voffB);
        PG8_WAIT_V(6); PG8_BAR;
    }
    for (;;) {
        const bool has_next = S.next(ui + 1, nxt);
        const char* nA = has_next ? (const char*)g.A + (size_t)g.atile(nxt.pm) * tstep : cA; const char* nB = has_next ? (const char*)g.Bt + (size_t)nxt.pn * tstep : cB;
        for (int t = 0; t < nt; t += 2) {
            const bool last = (t == nt - 2);
            const char* a1 = cA + (size_t)(t + 1) * kstep;
            const char* a2 = last ? nA : cA + (size_t)(t + 2) * kstep; const char* b2 = last ? nB : cB + (size_t)(t + 2) * kstep;
            const char* a3 = a2 + kstep; const char* b3 = b2 + kstep;
            if (last && has_next) S.a_ready(nxt);
            if constexpr (SP2) {
            PG8_LDB(B0, 0, 0); PG8_LDB(B1, 0, 1); PG8_SCHED; PG8_LDA(At, 0, 0); PG8_STAGE(PG8_SA(1, 1), a1 + hstep, voffA);
            PG8_WAIT_V(8); PG8_WAIT_L(0); PG8_BAR; PG8_MMA(0, 0, At, B0); PG8_MMA(0, 1, At, B1); PG8_BAR; PG8_SCHED;
            PG8_LDA(At, 0, 1); PG8_STAGE(PG8_SB(0, 0), b2, voffB); PG8_STAGE(PG8_SB(0, 1), b2 + hstep, voffB); PG8_STAGE(PG8_SA(0, 0), a2, voffA);
            PG8_WAIT_V(8); PG8_WAIT_L(0); PG8_BAR; PG8_MMA(1, 0, At, B0); PG8_MMA(1, 1, At, B1); PG8_BAR; PG8_SCHED;
            PG8_LDB(B0, 1, 0); PG8_LDB(B1, 1, 1); PG8_SCHED; PG8_LDA(At, 1, 0); PG8_STAGE(PG8_SA(0, 1), a2 + hstep, voffA);
            PG8_WAIT_V(8); PG8_WAIT_L(0); PG8_BAR; PG8_MMA(0, 0, At, B0); PG8_MMA(0, 1, At, B1); PG8_BAR; PG8_SCHED;
            PG8_LDA(At, 1, 1); PG8_STAGE(PG8_SB(1, 0), b3, voffB); PG8_STAGE(PG8_SB(1, 1), b3 + hstep, voffB); PG8_STAGE(PG8_SA(1, 0), a3, voffA);
            PG8_WAIT_V(8); PG8_WAIT_L(0); PG8_BAR; PG8_MMA(1, 0, At, B0); PG8_MMA(1, 1, At, B1); PG8_BAR; PG8_SCHED;
            } else {
            PG8_LDB(B0, 0, 0); PG8_SCHED; PG8_LDA(At, 0, 0); PG8_STAGE(PG8_SA(1, 1), a1 + hstep, voffA);
            PG8_WAIT_L(8); PG8_BAR; PG8_WAIT_L(0); PG8_MMA(0, 0, At, B0); PG8_BAR; PG8_SCHED;
            PG8_LDB(B1, 0, 1); PG8_STAGE(PG8_SB(0, 0), b2, voffB);
            PG8_BAR; PG8_WAIT_L(0); PG8_MMA(0, 1, At, B1); PG8_BAR;
            PG8_LDA(At, 0, 1); PG8_STAGE(PG8_SA(0, 0), a2, voffA);
            PG8_BAR; PG8_WAIT_L(0); PG8_MMA(1, 0, At, B0); PG8_BAR; PG8_SCHED;
            PG8_STAGE(PG8_SB(0, 1), b2 + hstep, voffB);
            PG8_WAIT_V(6); PG8_BAR; PG8_MMA(1, 1, At, B1); PG8_BAR;
            PG8_LDB(B0, 1, 0); PG8_SCHED; PG8_LDA(At, 1, 0); PG8_STAGE(PG8_SA(0, 1), a2 + hstep, voffA);
            PG8_WAIT_L(8); PG8_BAR; PG8_WAIT_L(0); PG8_MMA(0, 0, At, B0); PG8_BAR; PG8_SCHED;
            PG8_LDB(B1, 1, 1); PG8_STAGE(PG8_SB(1, 0), b3, voffB);
            PG8_BAR; PG8_WAIT_L(0); PG8_MMA(0, 1, At, B1); PG8_BAR;
            PG8_LDA(At, 1, 1); PG8_STAGE(PG8_SA(1, 0), a3, voffA);
            PG8_BAR; PG8_WAIT_L(0); PG8_MMA(1, 0, At, B0); PG8_BAR; PG8_SCHED;
            PG8_STAGE(PG8_SB(1, 1), b3 + hstep, voffB);
            PG8_WAIT_V(6); PG8_BAR; PG8_MMA(1, 1, At, B1); PG8_BAR;
            }
        }
        if constexpr (ALIGN_EPI) { if (wr == 0) PG8_BAR; }
        if constexpr (!Epi::AFTER_DRAIN) { E(acc, cur, wr, wc, fr, fq); S.done(cur); }
        if (!has_next) break;
#pragma unroll
        for (int a = 0; a < 2; ++a)
#pragma unroll
            for (int b = 0; b < 2; ++b)
#pragma unroll
                for (int m = 0; m < 4; ++m)
#pragma unroll
                    for (int n = 0; n < 2; ++n) acc[a][b][m][n] = (f32x4){0.f, 0.f, 0.f, 0.f};
        cur = nxt; cA = nA; cB = nB; ++ui;
        if constexpr (ALIGN_EPI) { if (wr == 1) PG8_BAR; }
    }
    PG8_WAIT_V(0);
    if constexpr (!ALIGN_EPI) { if (wr == 0) PG8_BAR; }
    PG8_BAR;
    if constexpr (Epi::AFTER_DRAIN) { E.fused(acc, cur, wr, wc, fr, fq, lds, wid, lane); S.done(cur); }
#undef PG8_SA
#undef PG8_SB
#undef PG8_STAGE
#undef PG8_LDA
#undef PG8_LDB
#undef PG8_MMA
#undef PG8_WAIT_V
#undef PG8_WAIT_L
#undef PG8_BAR
#undef PG8_SCHED
}
}

#ifndef PG8_SP2
#define PG8_SP2 true
#endif
#ifndef PG8_ALIGN
#define PG8_ALIGN true
#endif

constexpr int NWAVES = 8;
constexpr int D = 1024, BATCH = 32, SEQ = 2048, M = BATCH * SEQ, DEPTH = 2, NH = 8, HD = 128, DFF = 2816;
constexpr int PROJW = 10256;
constexpr int NPROJ = 10240, WHB = 1280;
constexpr int PW = 8192, HB = 1024;
constexpr int NSEG = 4, SEGT = SEQ / NSEG, SEGROWS = BATCH * SEGT;
constexpr int SEG_SH = (SEGT == 256) ? 0 : (SEGT == 512) ? 1 : 2;
constexpr int FSEG = 2, FROWS = M / FSEG;
constexpr float RMS_EPS = 1e-6f;
constexpr int MODW = 6 * D;

constexpr size_t MiB = 1u << 20;
constexpr size_t WS_CTL = 0, CTL_ZERO_BYTES = 1 * MiB;
constexpr size_t WS_WIN = 2 * MiB;
constexpr size_t WS_WOUT = 42 * MiB;
constexpr size_t WS_WUP = 46 * MiB;
constexpr size_t WS_WDN = 68 * MiB;
constexpr size_t WS_WG = 79 * MiB;
constexpr size_t WS_BIASP = 79 * MiB + 256 * 1024;
constexpr size_t WS_BG = 79 * MiB + 512 * 1024;
constexpr size_t WS_LB = 79 * MiB + 768 * 1024;
constexpr size_t WS_MOD = 80 * MiB;
constexpr size_t WS_GATES = 84 * MiB;
constexpr size_t WS_STC = 88 * MiB;
constexpr size_t WS_STS = 104 * MiB;
constexpr size_t WS_STN = 120 * MiB;
constexpr size_t WS_STM = 121 * MiB;
constexpr size_t WS_HN = 122 * MiB;
constexpr size_t WS_Y = 250 * MiB;
constexpr size_t WS_P = 378 * MiB;
constexpr size_t P_BYTES = (size_t)SEGROWS * PW * 2;
constexpr size_t WS_G = 250 * MiB;
constexpr size_t WS_S = 620 * MiB;
constexpr size_t WS_END = 778 * MiB;
static_assert(WS_P + 2 * P_BYTES <= 890 * MiB && WS_G + (size_t)M * DFF * 2 <= WS_S && WS_S + (size_t)(M / 64) * 4 * 2 * DFF * 2 <= WS_END, "ws map");
constexpr int CW_TMO = 0, CW_CODE = 1, CW_BAR = 4096;

constexpr int LDS_BYTES = 160 * 1024;
constexpr int RING_OFF = 0;
constexpr int MISC_OFF = 159 * 1024;

#define GAS __attribute__((address_space(1)))
#define LAS __attribute__((address_space(3)))
typedef unsigned short bf16;
typedef unsigned v4u __attribute__((ext_vector_type(4)));
typedef unsigned v2u __attribute__((ext_vector_type(2)));
typedef float f32x4 __attribute__((ext_vector_type(4)));
typedef short bf16x8 __attribute__((ext_vector_type(8)));
typedef GAS unsigned gu32;
#define RLX_AGENT __ATOMIC_RELAXED, __HIP_MEMORY_SCOPE_AGENT
#define LDS_WAIT() asm volatile("s_waitcnt lgkmcnt(0)" ::: "memory")
#define VM_WAIT() asm volatile("s_waitcnt vmcnt(0)" ::: "memory")
__device__ __forceinline__ unsigned f2bf(float f) { unsigned u = __builtin_bit_cast(unsigned, f); return (u + 0x7fffu + ((u >> 16) & 1u)) >> 16; }
__device__ __forceinline__ unsigned pk2(float lo, float hi) { return f2bf(lo) | (f2bf(hi) << 16); }
__device__ __forceinline__ float bf2f(unsigned short b) { return __builtin_bit_cast(float, ((unsigned)b) << 16); }
__device__ __forceinline__ float sigm(float x) { return 1.f / (1.f + __expf(-x)); }
__device__ __forceinline__ float siluf(float x) { return x / (1.f + __expf(-x)); }
__device__ __forceinline__ float softcap15(float z) { return 15.f * tanhf(z * (1.f / 15.f)); }
__device__ __forceinline__ float logsigm(float z) { return fminf(z, 0.f) - log1pf(expf(-fabsf(z))); }
__device__ __forceinline__ float wave_sum(float v) {
#pragma unroll
    for (int o = 1; o < 64; o <<= 1) v += __shfl_xor(v, o);
    return v;
}

#define PHASE_TID() int tid; asm volatile("v_mbcnt_lo_u32_b32 %0, -1, 0\n\tv_mbcnt_hi_u32_b32 %0, -1, %0" : "=v"(tid)); tid += F.wave_s * 64; const int lane = tid & 63, wave = F.wave_s; (void)lane; (void)wave
#define XB_TMO      128
#define XB_XCNT(j)  (256  + 64 * (j))
#define XB_XSUB(j)  (1280 + 64 * (j))
#define XB_XGEN(j)  (2304 + 64 * (j))
#define XB_TOP      3328
#define XB_TOPGEN   3392
#define XCD_BAR_WORDS 3456
#define XB_SPIN_CAP (1u << 18)

__device__ __forceinline__ unsigned xb_ld(unsigned* p)              { return __hip_atomic_load(p, __ATOMIC_RELAXED, __HIP_MEMORY_SCOPE_AGENT); }
__device__ __forceinline__ unsigned xb_add(unsigned* p, unsigned v) { return __hip_atomic_fetch_add(p, v, __ATOMIC_RELAXED, __HIP_MEMORY_SCOPE_AGENT); }
__device__ __forceinline__ unsigned xb_xcc_id() { return (unsigned)__builtin_amdgcn_s_getreg((3 << 11) | 20) & 0xFu; }
#define XB_SPIN(cond, bar) do { unsigned _sp = 0; while (cond) { __builtin_amdgcn_s_sleep(1); \
    if ((++_sp & 255u) == 0u) { if (xb_ld(&(bar)[XB_TMO])) break; if (_sp > XB_SPIN_CAP) { atomicAdd(&(bar)[XB_TMO], 1u); break; } } } } while (0)

struct XcdBarrier {
    unsigned* bar; unsigned x;
    volatile LAS unsigned* st;
};

__device__ __forceinline__ XcdBarrier xcd_barrier_post(unsigned* bar, volatile LAS unsigned* st) {
    XcdBarrier b; b.bar = bar; b.x = xb_xcc_id(); b.st = st;
    if (threadIdx.x == 0) (void)xb_add(&bar[XB_XCNT(b.x)], 1u);
    return b;
}
__device__ __forceinline__ void xcd_barrier_complete(unsigned* bar, unsigned x, unsigned& nloc, unsigned& nx) {
    const unsigned G = gridDim.x * gridDim.y * gridDim.z;
    unsigned sum, cnt, mine, sp = 0u;
    for (;;) {
        sum = 0u; cnt = 0u; mine = 0u;
#pragma unroll
        for (unsigned j = 0; j < 16; ++j) { const unsigned c = xb_ld(&bar[XB_XCNT(j)]); sum += c; cnt += (c > 0u) ? 1u : 0u; mine = (j == x) ? c : mine; }
        if (sum == G) break;
        __builtin_amdgcn_s_sleep(1);
        if ((++sp & 255u) == 0u) { if (xb_ld(&bar[XB_TMO])) break; if (sp > XB_SPIN_CAP) { atomicAdd(&bar[XB_TMO], 1u); break; } }
    }
    nloc = mine > 0u ? mine : 1u; nx = cnt > 0u ? cnt : 1u;
}

__device__ __forceinline__ void xcd_barrier(const XcdBarrier& b) {
    asm volatile("s_waitcnt vmcnt(0)" ::: "memory");
    __syncthreads();
    if (threadIdx.x == 0) {
        unsigned* bar = b.bar;
        __builtin_amdgcn_s_waitcnt(0);
        unsigned nloc = b.st[0], nx = b.st[1];
        if (nloc == 0u) { xcd_barrier_complete(bar, b.x, nloc, nx); b.st[0] = nloc; b.st[1] = nx; }
        const unsigned old = xb_add(&bar[XB_XSUB(b.x)], 1u);
        const unsigned gen = old / nloc;
        if (old + 1u == (gen + 1u) * nloc) {
            __builtin_amdgcn_fence(__ATOMIC_RELEASE, "agent");
            asm volatile("s_waitcnt vmcnt(0)" ::: "memory");
            const unsigned og = xb_add(&bar[XB_TOP], 1u);
            const unsigned tg = og / nx;
            if (og + 1u == (tg + 1u) * nx) xb_add(&bar[XB_TOPGEN], 1u);
            else XB_SPIN(xb_ld(&bar[XB_TOPGEN]) == tg, bar);
            __builtin_amdgcn_fence(__ATOMIC_ACQUIRE, "agent");
            xb_add(&bar[XB_XGEN(b.x)], 1u);
            asm volatile("s_waitcnt vmcnt(0)" ::: "memory");
        } else {
            XB_SPIN(xb_ld(&bar[XB_XGEN(b.x)]) == gen, bar);
            __builtin_amdgcn_fence(__ATOMIC_ACQUIRE, "agent");
            asm volatile("s_waitcnt vmcnt(0)" ::: "memory");
        }
    }
    __syncthreads();
}

struct Ctx {
    LAS unsigned char* lds;
    int vcu, G, wave_s;
};
struct Args { const float* in[19]; float* out; unsigned char* ws; };
typedef const Args __attribute__((address_space(4))) CArgs;
__device__ __forceinline__ CArgs& getargs() { CArgs* p = (CArgs*)__builtin_amdgcn_kernarg_segment_ptr(); asm volatile("" : "+s"(p)); return *p; }
#define ARGS() CArgs& A = getargs()

__device__ __forceinline__ void p0_transpose_item(const float* W, int ldw, int srccol0, int k0, bf16* WT, int K, int dstrow0, LAS float* scr, int lane) {
#pragma unroll 8
    for (int i = 0; i < 32; ++i) { const int kk = 2 * i + (lane >> 5); scr[kk * 33 + (lane & 31)] = W[(size_t)(k0 + kk) * ldw + srccol0 + (lane & 31)]; }
    LDS_WAIT(); asm volatile("" ::: "memory");
    const int c = lane & 7;
#pragma unroll
    for (int j = 0; j < 4; ++j) { const int n = (lane >> 3) + 8 * j; const LAS float* s = scr + (8 * c) * 33 + n;
        v4u o; o.x = pk2(s[0 * 33], s[1 * 33]); o.y = pk2(s[2 * 33], s[3 * 33]); o.z = pk2(s[4 * 33], s[5 * 33]); o.w = pk2(s[6 * 33], s[7 * 33]);
        *(GAS v4u*)(WT + (size_t)(dstrow0 + n) * K + k0 + 8 * c) = o; }
    LDS_WAIT(); asm volatile("" ::: "memory");
}
__device__ __forceinline__ int in_src_col(int dstrow) {
    const int h = dstrow / WHB, rem = dstrow - h * WHB, blk = rem >> 7, j = rem & 127;
    int base;
    switch (blk) { case 0: base = 0; break; case 1: base = 1024; break; case 2: base = 2048; break; case 3: base = 6160; break; case 4: base = 4112; break;
                   case 5: base = 5136; break; case 6: base = 3072; break; case 7: base = 8208; break; case 8: base = 7184; break; default: base = 9232; break; }
    return base + h * 128 + j;
}
__device__ __forceinline__ void p0_prologue(Ctx& F) {
    PHASE_TID();
    ARGS();
    LAS float* scr = (LAS float*)(F.lds + wave * 16384);
    const int gw = F.vcu * NWAVES + wave, NGW = F.G * NWAVES;
    constexpr int I_IN = 320 * 16, I_OUT = 32 * 16, I_UP = 176 * 16, I_DN = 32 * 44, I_L = I_IN + I_OUT + I_UP + I_DN;
    for (int it = gw; it < 2 * I_L; it += NGW) {
        const int l = it / I_L; int r = it - l * I_L;
        if (r < I_IN) { const int rg = r >> 4, kb = r & 15; p0_transpose_item(A.in[5] + (size_t)l * D * PROJW, PROJW, in_src_col(32 * rg), 64 * kb, (bf16*)(A.ws + WS_WIN) + (size_t)l * NPROJ * D, D, 32 * rg, scr, lane); continue; } r -= I_IN;
        if (r < I_OUT) { const int rg = r >> 4, kb = r & 15; p0_transpose_item(A.in[12] + (size_t)l * D * D, D, 32 * rg, 64 * kb, (bf16*)(A.ws + WS_WOUT) + (size_t)l * D * D, D, 32 * rg, scr, lane); continue; } r -= I_OUT;
        if (r < I_UP) { const int rg = r >> 4, kb = r & 15; const int row0 = 32 * rg, pn = row0 >> 8, half = (row0 >> 7) & 1, j0 = row0 & 127;
            p0_transpose_item(A.in[14] + (size_t)l * D * 2 * DFF, 2 * DFF, half * DFF + pn * 128 + j0, 64 * kb, (bf16*)(A.ws + WS_WUP) + (size_t)l * 2 * DFF * D, D, row0, scr, lane); continue; } r -= I_UP;
        { const int rg = r / 44, kb = r - rg * 44; p0_transpose_item(A.in[17] + (size_t)l * DFF * D, D, 32 * rg, 64 * kb, (bf16*)(A.ws + WS_WDN) + (size_t)l * D * DFF, DFF, 32 * rg, scr, lane); }
    }
    const int gt = F.vcu * (NWAVES * 64) + tid, NGT = F.G * NWAVES * 64;
    float* wg = (float*)(A.ws + WS_WG); float* biasp = (float*)(A.ws + WS_BIASP); float* bg = (float*)(A.ws + WS_BG); float* lb = (float*)(A.ws + WS_LB);
    for (int i = gt; i < 2 * D * 16; i += NGT) { const int g = i & 15, k = (i >> 4) & (D - 1), l = i >> 14; wg[(size_t)(l * 16 + g) * D + k] = A.in[5][((size_t)l * D + k) * PROJW + 4096 + g]; }
    for (int i = gt; i < 2 * NPROJ; i += NGT) { const int l = i / NPROJ, c = i - l * NPROJ; biasp[i] = A.in[6][(size_t)l * PROJW + in_src_col(c)]; }
    for (int i = gt; i < 32; i += NGT) { const int l = i >> 4, g = i & 15; bg[i] = A.in[6][(size_t)l * PROJW + 4096 + g]; }
    for (int i = gt; i < D; i += NGT) { const float z0 = A.in[10][i], z1 = A.in[10][D + i]; lb[i] = 1.f / (1.f + expf(z0 - z1)); }
    __syncthreads();
    for (int wgi = F.vcu; wgi < 2 * (MODW / 64); wgi += F.G) {
        LAS float* cact = (LAS float*)F.lds;
        for (int i = tid; i < BATCH * D; i += NWAVES * 64) cact[i] = siluf(A.in[1][i]);
        __syncthreads();
        const int l = wgi / (MODW / 64), cg = wgi - l * (MODW / 64), col = cg * 64 + lane, kb = wave * 128;
        const float* aw = A.in[2] + (size_t)l * D * MODW + col;
        float acc[32];
#pragma unroll
        for (int b = 0; b < 32; ++b) acc[b] = 0.f;
        for (int k4 = 0; k4 < 32; ++k4) {
            const int k = kb + 4 * k4;
            const float w0 = aw[(size_t)k * MODW], w1 = aw[(size_t)(k + 1) * MODW], w2 = aw[(size_t)(k + 2) * MODW], w3 = aw[(size_t)(k + 3) * MODW];
#pragma unroll
            for (int b = 0; b < 32; ++b) { const f32x4 cv = *(const LAS f32x4*)(cact + b * D + k); acc[b] += cv.x * w0 + cv.y * w1 + cv.z * w2 + cv.w * w3; }
        }
        __syncthreads();
        LAS float* part = (LAS float*)F.lds;
#pragma unroll
        for (int b = 0; b < 32; ++b) part[(wave * 32 + b) * 64 + lane] = acc[b];
        __syncthreads();
        float* mod = (float*)(A.ws + WS_MOD);
        for (int o = tid; o < 32 * 64; o += NWAVES * 64) { const int b = o >> 6, c = o & 63; float s = 0.f;
#pragma unroll
            for (int w = 0; w < 8; ++w) s += part[(w * 32 + b) * 64 + c];
            mod[((size_t)l * BATCH + b) * MODW + cg * 64 + c] = s + A.in[3][(size_t)l * MODW + cg * 64 + c]; }
        __syncthreads();
    }
}

__device__ __forceinline__ float reduce16(float (&v)[16], int lane) {
#define R16_STEP(S, MSK) { const bool up = (lane & (MSK)) != 0; _Pragma("unroll") for (int i = 0; i < (S); ++i) { const float keep = up ? v[i + (S)] : v[i], send = up ? v[i] : v[i + (S)]; v[i] = keep + __shfl_xor(send, (MSK)); } }
    R16_STEP(8, 32) R16_STEP(4, 16) R16_STEP(2, 8) R16_STEP(1, 4)
#undef R16_STEP
    float r = v[0]; r += __shfl_xor(r, 1); r += __shfl_xor(r, 2); return r;
}
template <bool GATES>
__device__ __forceinline__ void norm_phase(Ctx& F, const float* src, const float* nw, const float* modl, int shift_off, int scale_off, bf16* hn, float* gates, const float* wgl, const float* bgl) {
    PHASE_TID();
    LAS float* wgs = (LAS float*)F.lds;
    if (GATES) { for (int i = tid; i < 16 * D / 4; i += NWAVES * 64) ((LAS f32x4*)wgs)[i] = ((const f32x4*)wgl)[i]; __syncthreads(); }
    const int gw = F.vcu * NWAVES + wave, NGW = F.G * NWAVES;
    f32x4 w[4];
#pragma unroll
    for (int j = 0; j < 4; ++j) w[j] = *(const f32x4*)(nw + 256 * j + 4 * lane);
    for (int item = gw; item < M / 32; item += NGW) {
        const int row0 = item * 32, b = row0 >> 11;
        f32x4 sc[4], sh[4];
#pragma unroll
        for (int j = 0; j < 4; ++j) { sc[j] = *(const f32x4*)(modl + (size_t)b * MODW + scale_off + 256 * j + 4 * lane); sh[j] = *(const f32x4*)(modl + (size_t)b * MODW + shift_off + 256 * j + 4 * lane);
            sc[j] = (sc[j] + 1.0f) * w[j]; }
        f32x4 xn[4];
#pragma unroll
        for (int j = 0; j < 4; ++j) xn[j] = *(const GAS f32x4*)(src + (size_t)row0 * D + 256 * j + 4 * lane);
        for (int r = 0; r < 32; ++r) {
            asm volatile("" ::: "memory");
            f32x4 x[4];
#pragma unroll
            for (int j = 0; j < 4; ++j) x[j] = xn[j];
            if (r + 1 < 32) {
#pragma unroll
                for (int j = 0; j < 4; ++j) xn[j] = *(const GAS f32x4*)(src + (size_t)(row0 + r + 1) * D + 256 * j + 4 * lane);
            }
            float ss = 0.f;
#pragma unroll
            for (int j = 0; j < 4; ++j) ss += (x[j].x * x[j].x + x[j].y * x[j].y) + (x[j].z * x[j].z + x[j].w * x[j].w);
            const float rstd = rsqrtf(wave_sum(ss) * (1.f / D) + RMS_EPS);
#pragma unroll
            for (int j = 0; j < 4; ++j) x[j] = x[j] * rstd * sc[j] + sh[j];
            GAS unsigned long long* o8 = (GAS unsigned long long*)(hn + (size_t)(row0 + r) * D) + lane;
#pragma unroll
            for (int j = 0; j < 4; ++j) o8[64 * j] = (unsigned long long)pk2(x[j].x, x[j].y) | ((unsigned long long)pk2(x[j].z, x[j].w) << 32);
            if (GATES) {
                float a[16];
#pragma unroll
                for (int g = 0; g < 16; ++g) { float s = 0.f;
#pragma unroll
                    for (int j = 0; j < 4; ++j) { const f32x4 wv = *(const LAS f32x4*)(wgs + g * D + 256 * j + 4 * lane); s += (x[j].x * wv.x + x[j].y * wv.y) + (x[j].z * wv.z + x[j].w * wv.w); }
                    a[g] = s; }
                const float tot = reduce16(a, lane);
                const int g = ((lane >> 5) & 1) * 8 + ((lane >> 4) & 1) * 4 + ((lane >> 3) & 1) * 2 + ((lane >> 2) & 1);
                if ((lane & 3) == 0) gates[(size_t)(row0 + r) * 16 + g] = tot + bgl[g];
            }
        }
    }
}
__device__ __forceinline__ void final_norm_phase(Ctx& F, float* x, const float* nw) {
    PHASE_TID();
    const int gw = F.vcu * NWAVES + wave, NGW = F.G * NWAVES;
    f32x4 w[4];
#pragma unroll
    for (int j = 0; j < 4; ++j) w[j] = *(const f32x4*)(nw + 256 * j + 4 * lane);
    for (int row = gw; row < M; row += NGW) {
        GAS f32x4* xr = (GAS f32x4*)(x + (size_t)row * D) + lane;
        f32x4 v[4]; float ss = 0.f;
#pragma unroll
        for (int j = 0; j < 4; ++j) { v[j] = xr[64 * j]; ss += (v[j].x * v[j].x + v[j].y * v[j].y) + (v[j].z * v[j].z + v[j].w * v[j].w); }
        const float rstd = rsqrtf(wave_sum(ss) * (1.f / D) + RMS_EPS);
#pragma unroll
        for (int j = 0; j < 4; ++j) xr[64 * j] = v[j] * rstd * w[j];
    }
}

__device__ __forceinline__ void unpack8(const v4u& v, float (&o)[8]) {
#pragma unroll
    for (int e = 0; e < 4; ++e) { o[2 * e] = bf2f((unsigned short)(v[e] & 0xffffu)); o[2 * e + 1] = bf2f((unsigned short)(v[e] >> 16)); }
}
__device__ __forceinline__ void ffn_glu_phase(Ctx& F, const bf16* u, bf16* g, const float* cw, const float* cb) {
    PHASE_TID();
    constexpr int RB = 16, NCH = DFF / 8, NRB = FROWS / RB;
    const int gt = F.vcu * (NWAVES * 64) + tid, NGT = F.G * NWAVES * 64;
    for (int it = gt; it < NRB * NCH; it += NGT) {
        const int rb = it / NCH, ch = it - rb * NCH, f0 = ch * 8, row0 = rb * RB;
        const int cg0 = (f0 >> 7) * 256 + (f0 & 127);
        float wg_[3][8], wv_[3][8], bgv[8], bvv[8];
#pragma unroll
        for (int j = 0; j < 3; ++j)
#pragma unroll
            for (int e = 0; e < 8; ++e) { wg_[j][e] = cw[(size_t)j * 2 * DFF + f0 + e]; wv_[j][e] = cw[(size_t)j * 2 * DFF + DFF + f0 + e]; }
#pragma unroll
        for (int e = 0; e < 8; ++e) { bgv[e] = cb[f0 + e]; bvv[e] = cb[DFF + f0 + e]; }
        float g1[8], g2[8], v1[8], v2[8];
        const int t0 = row0 & (SEQ - 1);
#pragma unroll
        for (int e = 0; e < 8; ++e) { g1[e] = g2[e] = v1[e] = v2[e] = 0.f; }
        if (t0 >= 2) {
            const v4u a1 = *(const GAS v4u*)(u + (size_t)(row0 - 1) * 2 * DFF + cg0), a2 = *(const GAS v4u*)(u + (size_t)(row0 - 2) * 2 * DFF + cg0);
            const v4u b1 = *(const GAS v4u*)(u + (size_t)(row0 - 1) * 2 * DFF + cg0 + 128), b2 = *(const GAS v4u*)(u + (size_t)(row0 - 2) * 2 * DFF + cg0 + 128);
#pragma unroll
            for (int e = 0; e < 4; ++e) { g1[2 * e] = bf2f(a1[e] & 0xffff); g1[2 * e + 1] = bf2f(a1[e] >> 16); g2[2 * e] = bf2f(a2[e] & 0xffff); g2[2 * e + 1] = bf2f(a2[e] >> 16);
                v1[2 * e] = bf2f(b1[e] & 0xffff); v1[2 * e + 1] = bf2f(b1[e] >> 16); v2[2 * e] = bf2f(b2[e] & 0xffff); v2[2 * e + 1] = bf2f(b2[e] >> 16); }
        }
        for (int r = 0; r < RB; ++r) {
            const v4u a0 = *(const GAS v4u*)(u + (size_t)(row0 + r) * 2 * DFF + cg0), b0 = *(const GAS v4u*)(u + (size_t)(row0 + r) * 2 * DFF + cg0 + 128);
            float g0[8], v0[8], o[8];
#pragma unroll
            for (int e = 0; e < 4; ++e) { g0[2 * e] = bf2f(a0[e] & 0xffff); g0[2 * e + 1] = bf2f(a0[e] >> 16); v0[2 * e] = bf2f(b0[e] & 0xffff); v0[2 * e + 1] = bf2f(b0[e] >> 16); }
#pragma unroll
            for (int e = 0; e < 8; ++e) { const float cgv = bgv[e] + wg_[2][e] * g0[e] + wg_[1][e] * g1[e] + wg_[0][e] * g2[e]; const float cvv = bvv[e] + wv_[2][e] * v0[e] + wv_[1][e] * v1[e] + wv_[0][e] * v2[e];
                o[e] = siluf(cgv) * cvv; g2[e] = g1[e]; g1[e] = g0[e]; v2[e] = v1[e]; v1[e] = v0[e]; }
            v4u w; w.x = pk2(o[0], o[1]); w.y = pk2(o[2], o[3]); w.z = pk2(o[4], o[5]); w.w = pk2(o[6], o[7]);
            *(GAS v4u*)(g + (size_t)(row0 + r) * DFF + f0) = w;
        }
    }
}

__device__ __forceinline__ void ffn_fix_phase(Ctx& F, const bf16* S, bf16* G, const float* cw, const float* cb) {
    PHASE_TID();
    constexpr int NCH = DFF / 8, NG = M / 64;
    const int gt = F.vcu * (NWAVES * 64) + tid, NGT = F.G * NWAVES * 64;
    for (int it = gt; it < NG * NCH; it += NGT) {
        const int g64 = it / NCH, ch = it - g64 * NCH, f0 = ch * 8, col = (f0 >> 7) * 256 + (f0 & 127);
        const bool first = (g64 & 31) == 0;
        float c0g[8], c0v[8], c1g[8], c1v[8], p2g[8], p2v[8], p3g[8], p3v[8];
        { const bf16* sp = S + (size_t)g64 * 4 * (2 * DFF) + col;
          const v4u a = *(const GAS v4u*)sp, b = *(const GAS v4u*)(sp + 128), c = *(const GAS v4u*)(sp + 2 * DFF), d = *(const GAS v4u*)(sp + 2 * DFF + 128);
          unpack8(a, c0g); unpack8(b, c0v); unpack8(c, c1g); unpack8(d, c1v); }
        if (!first) { const bf16* sp = S + ((size_t)(g64 - 1) * 4 + 2) * (2 * DFF) + col;
          const v4u a = *(const GAS v4u*)sp, b = *(const GAS v4u*)(sp + 128), c = *(const GAS v4u*)(sp + 2 * DFF), d = *(const GAS v4u*)(sp + 2 * DFF + 128);
          unpack8(a, p2g); unpack8(b, p2v); unpack8(c, p3g); unpack8(d, p3v); }
        else {
#pragma unroll
            for (int e = 0; e < 8; ++e) { p2g[e] = p2v[e] = p3g[e] = p3v[e] = 0.f; } }
        float o0[8], o1[8];
#pragma unroll
        for (int e = 0; e < 8; ++e) {
            const float wg0 = cw[f0 + e], wg1 = cw[2 * DFF + f0 + e], wg2 = cw[4 * DFF + f0 + e], wv0 = cw[DFF + f0 + e], wv1 = cw[3 * DFF + f0 + e], wv2 = cw[5 * DFF + f0 + e], bg = cb[f0 + e], bv = cb[DFF + f0 + e];
            const float g0 = bg + wg2 * c0g[e] + wg1 * p3g[e] + wg0 * p2g[e], v0 = bv + wv2 * c0v[e] + wv1 * p3v[e] + wv0 * p2v[e];
            const float g1 = bg + wg2 * c1g[e] + wg1 * c0g[e] + wg0 * p3g[e], v1 = bv + wv2 * c1v[e] + wv1 * c0v[e] + wv0 * p3v[e];
            o0[e] = siluf(g0) * v0; o1[e] = siluf(g1) * v1;
        }
        v4u w0, w1; w0.x = pk2(o0[0], o0[1]); w0.y = pk2(o0[2], o0[3]); w0.z = pk2(o0[4], o0[5]); w0.w = pk2(o0[6], o0[7]); w1.x = pk2(o1[0], o1[1]); w1.y = pk2(o1[2], o1[3]); w1.z = pk2(o1[4], o1[5]); w1.w = pk2(o1[6], o1[7]);
        *(GAS v4u*)(G + (size_t)(g64 * 64) * DFF + f0) = w0; *(GAS v4u*)(G + (size_t)(g64 * 64 + 1) * DFF + f0) = w1;
    }
}

constexpr int IMG_QM = 0, IMG_KM = 16384, IMG_VM = 32768, IMG_P = 49152, IMG_HQT = 57344, IMG_HKT = 73728, IMG_HV = 90112, PH_OFF = 106496, MF_OFF = 110592, HAB_OFF = 130048, OBB_OFF = 146432;
constexpr int MF_N = 0, MF_DFL = 128, MF_QN = 192, MF_RS = 256, MF_NRED = 384, MF_E7 = 1408, MF_E157 = 1920, MF_CW = 2432, MF_WN = 3712, MF_END = 3968;
static_assert(MF_OFF + MF_END * 4 <= HAB_OFF && OBB_OFF + 16384 <= MISC_OFF, "mixer LDS map");
constexpr int PO_MQ = 0, PO_MK = 128, PO_MV = 256, PO_HI = 384, PO_HQ = 512, PO_HF = 640, PO_CA = 768, PO_CB = 896;
typedef short s16x4 __attribute__((ext_vector_type(4)));
typedef short v4i16_t __attribute__((ext_vector_type(4)));
__device__ __forceinline__ unsigned offb(unsigned row, unsigned ch) { return 256u * row + 16u * (ch ^ (((row & 3u) << 2) | ((row >> 2) & 3u))); }
__device__ __forceinline__ bf16x8 ld16(LAS unsigned char* p) { return *(const LAS bf16x8*)p; }
__device__ __forceinline__ s16x4 ld8(LAS unsigned char* p) { return *(const LAS s16x4*)p; }
__device__ __forceinline__ s16x4 ldtr(LAS unsigned char* p) { return __builtin_bit_cast(s16x4, __builtin_amdgcn_ds_read_tr16_b64_v4i16((LAS v4i16_t*)p)); }
__device__ __forceinline__ bf16x8 cat8(s16x4 a, s16x4 b) { bf16x8 r; r[0] = a[0]; r[1] = a[1]; r[2] = a[2]; r[3] = a[3]; r[4] = b[0]; r[5] = b[1]; r[6] = b[2]; r[7] = b[3]; return r; }
__device__ __forceinline__ bf16x8 frag_row(LAS unsigned char* img, int row0, int ks, int lane) { return ld16(img + offb(row0 + (lane & 15), 4 * ks + (lane >> 4))); }
__device__ __forceinline__ bf16x8 frag_tr(LAS unsigned char* img, int row0, int c, int lane, int rmask) {
    const int g = lane >> 4, qq = (lane & 15) >> 2, p = lane & 3;
    const int r0 = row0 + ((8 * g + qq) & rmask), r1 = row0 + ((8 * g + 4 + qq) & rmask);
    return cat8(ldtr(img + offb(r0, 2 * c + (p >> 1)) + 8 * (p & 1)), ldtr(img + offb(r1, 2 * c + (p >> 1)) + 8 * (p & 1)));
}
__device__ __forceinline__ bf16x8 frag_q2(LAS unsigned char* img, int row0, int ks, int lane) {
    const int r = lane & 15, q = lane >> 4;
    return cat8(ld8(img + offb(row0 + r, 4 * ks + (q >> 1)) + 8 * (q & 1)), ld8(img + offb(row0 + r, 4 * ks + 2 + (q >> 1)) + 8 * (q & 1)));
}
__device__ __forceinline__ bf16x8 pack_acc(const f32x4& lo, const f32x4& hi) {
    v4u w; w.x = pg8::cvt_pk_bf16(lo[0], lo[1]); w.y = pg8::cvt_pk_bf16(lo[2], lo[3]); w.z = pg8::cvt_pk_bf16(hi[0], hi[1]); w.w = pg8::cvt_pk_bf16(hi[2], hi[3]);
    return __builtin_bit_cast(bf16x8, w);
}
__device__ __forceinline__ f32x4 mfma16(const bf16x8& a, const bf16x8& b, const f32x4& c) { return __builtin_amdgcn_mfma_f32_16x16x32_bf16(a, b, c, 0, 0, 0); }
__device__ __forceinline__ float rcpf_(float x) { return __builtin_amdgcn_rcpf(x); }
__device__ __forceinline__ float sigf(float x) { return rcpf_(1.f + __expf(-x)); }
__device__ __forceinline__ float silf(float x) { return x * rcpf_(1.f + __expf(-x)); }
__device__ __forceinline__ unsigned pkbf(float lo, float hi) { return pg8::cvt_pk_bf16(lo, hi); }

#define LN_FRESH(name) int name = lane; asm volatile("" : "+v"(name))
template <bool DRY>
__device__ __forceinline__ void mixer_fast_phase(Ctx& F, int layer, int seg) {
    PHASE_TID();
    ARGS();
    const bf16* Pcur = (const bf16*)(A.ws + WS_P + (size_t)(seg & 1) * P_BYTES);
    const bf16* Pprev = (const bf16*)(A.ws + WS_P + (size_t)((seg & 1) ^ 1) * P_BYTES);
    const float* gates = (const float*)(A.ws + WS_GATES);
    const float* lbp = (const float*)(A.ws + WS_LB);
    bf16* Y = (bf16*)(A.ws + WS_Y);
    float* stC = (float*)(A.ws + WS_STC); float* stS = (float*)(A.ws + WS_STS); float* stN = (float*)(A.ws + WS_STN); float* stM = (float*)(A.ws + WS_STM);
    const float* cw = A.in[7] + (size_t)layer * 4 * 2048; const float* cb = A.in[8] + (size_t)layer * 2048;
    LAS unsigned char* L = F.lds;
    LAS float* MF = (LAS float*)(L + MF_OFF);
    for (int bh = blockIdx.x; bh < BATCH * NH; bh += F.G) {
        const int b = bh >> 3, h = bh & 7;
        for (int i = tid; i < 1280; i += NWAVES * 64) { const int blk = i / 640, j = (i % 640) >> 7, e = i & 127; MF[MF_CW + i] = j < 4 ? cw[(size_t)j * 2048 + blk * 1024 + h * 128 + e] : cb[blk * 1024 + h * 128 + e]; }
        for (int i = tid; i < 1024; i += NWAVES * 64) ((LAS unsigned*)(L + PH_OFF))[i] = 0u;
        if (tid < 256) MF[MF_WN + tid] = tid < 128 ? A.in[9][(size_t)layer * D + h * 128 + tid] : A.in[11][(size_t)layer * D + h * 128 + tid - 128];
        f32x4 Cacc[8], Sacc[8]; float mst;
        if (seg == 0) {
#pragma unroll
            for (int mb = 0; mb < 8; ++mb) { Cacc[mb] = (f32x4){0.f, 0.f, 0.f, 0.f}; Sacc[mb] = (f32x4){0.f, 0.f, 0.f, 0.f}; }
            mst = 0.f; if (tid < 128) MF[MF_N + tid] = 0.f;
        } else {
#pragma unroll
            for (int mb = 0; mb < 8; ++mb)
#pragma unroll
                for (int e = 0; e < 4; ++e) { Cacc[mb][e] = stC[((size_t)(bh * 8 + wave) * 32 + mb * 4 + e) * 64 + lane]; Sacc[mb][e] = stS[((size_t)(bh * 8 + wave) * 32 + mb * 4 + e) * 64 + lane]; }
            mst = stM[bh]; if (tid < 128) MF[MF_N + tid] = stN[bh * 128 + tid];
        }
        __syncthreads();
        for (int c = 0; c < SEGT / 64; ++c) {
            const int tl0 = 64 * c; const size_t grow0 = (size_t)b * SEQ + seg * SEGT + tl0;
            int lane; asm volatile("v_mbcnt_lo_u32_b32 %0, -1, 0\n\tv_mbcnt_hi_u32_b32 %0, -1, %0" : "=v"(lane)); const int tid = wave * 64 + lane;
            const int r = lane & 15, q = lane >> 4;
            float rowfac, decay, mnext;
#ifdef PROBE_PREP2
#pragma unroll 1
            for (int rep_ = 0; rep_ < 2; ++rep_) { asm volatile("" ::: "memory");
#endif
            {
                const float gi = gates[(grow0 + lane) * 16 + h] * (2.f / 15.f), gf = gates[(grow0 + lane) * 16 + 8 + h] * (2.f / 15.f);
                const float li = 15.f - 30.f * rcpf_(1.f + __expf(gi));
                const float zf = 15.f - 30.f * rcpf_(1.f + __expf(gf));
                const float lf = fminf(zf, 0.f) - __logf(1.f + __expf(-fabsf(zf)));
                float bc = lf;
#pragma unroll
                for (int d = 1; d < 64; d <<= 1) { const float t = __shfl_up(bc, d); if (lane >= d) bc += t; }
                const float a = li - bc; float am = a;
#pragma unroll
                for (int o = 1; o < 64; o <<= 1) am = fmaxf(am, __shfl_xor(am, o));
                const float abar = fmaxf(mst, am);
                rowfac = __expf(a - abar) * 0.08838834764831845f;
                decay = __expf(mst - abar); mnext = __shfl(bc, 63) + abar;
                if (wave == 0) MF[MF_DFL + lane] = __expf(-(bc + abar));
            }
#pragma unroll
            for (int pass = 0; pass < 2; ++pass) {
                const int t = (tid >> 4) + 32 * pass, ch = tid & 15, tl = tl0 + t;
                const float rf = __shfl(rowfac, t);
                const bf16* pr0 = Pcur + (size_t)(b * SEGT + tl) * PW + h * HB + ch * 8;
#pragma unroll
                for (int blk = 0; blk < 2; ++blk) {
                    float acc[8];
                    { const f32x4 b0 = *(const LAS f32x4*)(MF + MF_CW + blk * 640 + 512 + ch * 8), b1 = *(const LAS f32x4*)(MF + MF_CW + blk * 640 + 512 + ch * 8 + 4);
                      acc[0] = b0[0]; acc[1] = b0[1]; acc[2] = b0[2]; acc[3] = b0[3]; acc[4] = b1[0]; acc[5] = b1[1]; acc[6] = b1[2]; acc[7] = b1[3]; }
#pragma unroll
                    for (int j = 0; j < 4; ++j) {
                        const int tq = tl - 3 + j;
                        if (seg * SEGT + tq >= 0) {
                            const bf16* prj = tq >= 0 ? Pcur + (size_t)(b * SEGT + tq) * PW : Pprev + (size_t)(b * SEGT + SEGT + tq) * PW;
                            const v4u raw = *(const GAS v4u*)(prj + h * HB + (blk == 0 ? PO_MQ : PO_MK) + ch * 8);
                            float x[8]; unpack8(raw, x);
                            const f32x4 w0 = *(const LAS f32x4*)(MF + MF_CW + blk * 640 + j * 128 + ch * 8), w1 = *(const LAS f32x4*)(MF + MF_CW + blk * 640 + j * 128 + ch * 8 + 4);
#pragma unroll
                            for (int e = 0; e < 4; ++e) { acc[e] += w0[e] * x[e]; acc[4 + e] += w1[e] * x[4 + e]; }
                        }
                    }
                    const float sc = blk == 0 ? 1.f : rf;
                    v4u o; o.x = pkbf(silf(acc[0]) * sc, silf(acc[1]) * sc); o.y = pkbf(silf(acc[2]) * sc, silf(acc[3]) * sc); o.z = pkbf(silf(acc[4]) * sc, silf(acc[5]) * sc); o.w = pkbf(silf(acc[6]) * sc, silf(acc[7]) * sc);
                    *(LAS v4u*)(L + (blk == 0 ? IMG_QM : IMG_KM) + offb(t, ch)) = o;
                }
                *(LAS v4u*)(L + IMG_VM + offb(t, ch)) = *(const GAS v4u*)(pr0 + PO_MV);
                *(LAS v4u*)(L + IMG_HV + offb(t, ch)) = *(const GAS v4u*)(pr0 + PO_HI);
            }
            {
                const int j = wave & 3, hh = wave >> 2, trow = 16 * j + 8 * hh;
                const bf16* pr = Pcur + (size_t)(b * SEGT + tl0 + trow) * PW + h * HB + 2 * lane;
                unsigned rq[8], rf[8];
#pragma unroll
                for (int i = 0; i < 8; ++i) { rq[i] = *(const GAS unsigned*)(pr + (size_t)i * PW + PO_HQ); rf[i] = *(const GAS unsigned*)(pr + (size_t)i * PW + PO_HF); }
                float lb0 = 0.f, lb1 = 0.f; if (layer != 0) { lb0 = lbp[h * 128 + 2 * lane]; lb1 = lbp[h * 128 + 2 * lane + 1]; }
                float l0[8], l1[8], k0[8], k1[8], q0[8], q1[8];
#pragma unroll
                for (int i = 0; i < 8; ++i) {
                    const float s0 = sigf(bf2f((unsigned short)(rf[i] & 0xffffu))), s1 = sigf(bf2f((unsigned short)(rf[i] >> 16)));
                    l0[i] = __logf(lb0 + (1.f - lb0) * s0); l1[i] = __logf(lb1 + (1.f - lb1) * s1);
                    k0[i] = (1.f - lb0) * (1.f - s0); k1[i] = (1.f - lb1) * (1.f - s1);
                    q0[i] = silf(bf2f((unsigned short)(rq[i] & 0xffffu))); q1[i] = silf(bf2f((unsigned short)(rq[i] >> 16)));
                }
                float run0 = 0.f, run1 = 0.f;
#pragma unroll
                for (int ii = 0; ii < 8; ++ii) {
                    const int i = hh ? ii : 7 - ii;
                    if (hh) { run0 += l0[i]; run1 += l1[i]; }
                    const float e0 = hh ? run0 : -run0, e1 = hh ? run1 : -run1;
                    const unsigned o = offb(trow + i, lane >> 2) + 4 * (lane & 3);
                    *(LAS unsigned*)(L + IMG_HQT + o) = pkbf(q0[i] * __expf(e0), q1[i] * __expf(e1));
                    *(LAS unsigned*)(L + IMG_HKT + o) = pkbf(k0[i] * __expf(-e0), k1[i] * __expf(-e1));
                    if (!hh) { run0 += l0[i]; run1 += l1[i]; }
                }
                typedef float f32x2 __attribute__((ext_vector_type(2)));
                *(LAS f32x2*)(MF + (hh ? MF_E157 : MF_E7) + j * 128 + 2 * lane) = (f32x2){__expf(run0), __expf(run1)};
            }
#ifdef PROBE_PREP2
            }
#endif
            __syncthreads();
            {
                const int tb = wave >> 1; float psum = 0.f;
#pragma unroll
                for (int s2 = 0; s2 < 2; ++s2) {
                    const int sb = 2 * (wave & 1) + s2; LN_FRESH(ln);
                    f32x4 acc = (f32x4){0.f, 0.f, 0.f, 0.f};
#pragma unroll
                    for (int ks = 0; ks < 4; ++ks) acc = mfma16(frag_row(L + IMG_KM, 16 * sb, ks, ln), frag_row(L + IMG_QM, 16 * tb, ks, ln), acc);
                    const int t = 16 * tb + r, s0 = 16 * sb + 4 * q;
                    float v[4];
#pragma unroll
                    for (int e = 0; e < 4; ++e) { v[e] = (s0 + e <= t) ? acc[e] : 0.f; psum += v[e]; }
                    v2u w; w.x = pkbf(v[0], v[1]); w.y = pkbf(v[2], v[3]);
                    *(LAS v2u*)(L + IMG_P + 128 * t + 16 * ((2 * sb + (q >> 1)) ^ (t & 7)) + 8 * (q & 1)) = w;
                }
                psum += __shfl_xor(psum, 16); psum += __shfl_xor(psum, 32);
                if (q == 0) MF[MF_RS + 2 * (16 * tb + r) + (wave & 1)] = psum;
            }
            {
                const int t = tid >> 3, part = tid & 7;
                const v4u a0 = *(const LAS v4u*)(L + IMG_QM + offb(t, 2 * part)), a1 = *(const LAS v4u*)(L + IMG_QM + offb(t, 2 * part + 1));
                float x0[8], x1[8]; unpack8(a0, x0); unpack8(a1, x1);
                float d = 0.f;
#pragma unroll
                for (int e4 = 0; e4 < 2; ++e4) { const f32x4 n0 = *(const LAS f32x4*)(MF + MF_N + 16 * part + 4 * e4), n1 = *(const LAS f32x4*)(MF + MF_N + 16 * part + 8 + 4 * e4);
#pragma unroll
                    for (int e = 0; e < 4; ++e) { d += x0[4 * e4 + e] * n0[e]; d += x1[4 * e4 + e] * n1[e]; } }
                d += __shfl_xor(d, 1); d += __shfl_xor(d, 2); d += __shfl_xor(d, 4);
                if (part == 0) MF[MF_QN + t] = d;
            }
            if (wave >= 4) {
                const int j = wave - 4; LN_FRESH(ln);
                f32x4 acc = (f32x4){0.f, 0.f, 0.f, 0.f};
#pragma unroll
                for (int ks = 0; ks < 4; ++ks) acc = mfma16(frag_row(L + IMG_HKT, 16 * j, ks, ln), frag_row(L + IMG_HQT, 16 * j, ks, ln), acc);
                float v[4];
#pragma unroll
                for (int e = 0; e < 4; ++e) v[e] = (4 * q + e <= r) ? acc[e] : 0.f;
                v2u w; w.x = pkbf(v[0], v[1]); w.y = pkbf(v[2], v[3]);
                *(LAS v2u*)(L + PH_OFF + j * 1024 + r * 64 + 8 * q) = w;
            }
            __syncthreads();
            f32x4 hval[4], oacc[4];
            {
                f32x4 Cd[8];
#pragma unroll
                for (int mb = 0; mb < 8; ++mb) Cd[mb] = Cacc[mb] * decay;
                bf16x8 bC[4], bV[2];
#pragma unroll
                for (int ks = 0; ks < 4; ++ks) bC[ks] = pack_acc(Cd[2 * ks], Cd[2 * ks + 1]);
#pragma unroll
                for (int ks = 0; ks < 2; ++ks) { LN_FRESH(ln); bV[ks] = frag_tr(L + IMG_VM, 32 * ks, wave, ln, 31); }
#pragma unroll
                for (int mt = 0; mt < 4; ++mt) {
                    f32x4 acc = (f32x4){0.f, 0.f, 0.f, 0.f}; LN_FRESH(ln);
#pragma unroll
                    for (int ks = 0; ks < 4; ++ks) acc = mfma16(frag_q2(L + IMG_QM, 16 * mt, ks, ln), bC[ks], acc);
#pragma unroll
                    for (int ks = 0; ks < 2; ++ks) { const int t = 16 * mt + r; acc = mfma16(ld16(L + IMG_P + 128 * t + 16 * ((4 * ks + q) ^ (t & 7))), bV[ks], acc); }
                    const int t0 = 16 * mt + 4 * q;
                    const f32x4 r0 = *(const LAS f32x4*)(MF + MF_RS + 2 * t0), r1 = *(const LAS f32x4*)(MF + MF_RS + 2 * t0 + 4), qn4 = *(const LAS f32x4*)(MF + MF_QN + t0), df4 = *(const LAS f32x4*)(MF + MF_DFL + t0);
                    const float den0 = r0[0] + r0[1] + decay * qn4[0], den1 = r0[2] + r0[3] + decay * qn4[1], den2 = r1[0] + r1[1] + decay * qn4[2], den3 = r1[2] + r1[3] + decay * qn4[3];
                    hval[mt][0] = acc[0] * rcpf_(fmaxf(fabsf(den0), df4[0])); hval[mt][1] = acc[1] * rcpf_(fmaxf(fabsf(den1), df4[1])); hval[mt][2] = acc[2] * rcpf_(fmaxf(fabsf(den2), df4[2])); hval[mt][3] = acc[3] * rcpf_(fmaxf(fabsf(den3), df4[3]));
                }
#pragma unroll
                for (int mb = 0; mb < 8; ++mb) {
                    f32x4 acc = Cd[mb]; LN_FRESH(ln);
#pragma unroll
                    for (int ks = 0; ks < 2; ++ks) acc = mfma16(frag_tr(L + IMG_KM, 32 * ks, mb, ln, 31), bV[ks], acc);
                    Cacc[mb] = acc;
                }
                {
                    const int ch = tid & 15, sg = tid >> 4;
                    const v4u a0 = *(const LAS v4u*)(L + IMG_KM + offb(2 * sg, ch)), a1 = *(const LAS v4u*)(L + IMG_KM + offb(2 * sg + 1, ch));
                    float x0[8], x1[8]; unpack8(a0, x0); unpack8(a1, x1);
                    float ps[8];
#pragma unroll
                    for (int e = 0; e < 8; ++e) { ps[e] = x0[e] + x1[e]; ps[e] += __shfl_xor(ps[e], 16); ps[e] += __shfl_xor(ps[e], 32); }
                    if (lane < 16) { *(LAS f32x4*)(MF + MF_NRED + wave * 128 + 8 * ch) = (f32x4){ps[0], ps[1], ps[2], ps[3]}; *(LAS f32x4*)(MF + MF_NRED + wave * 128 + 8 * ch + 4) = (f32x4){ps[4], ps[5], ps[6], ps[7]}; }
                }
            }
#pragma unroll
            for (int j = 0; j < 4; ++j) {
                f32x4 T[8];
#pragma unroll
                for (int mb = 0; mb < 8; ++mb) T[mb] = Sacc[mb] * *(const LAS f32x4*)(MF + MF_E7 + j * 128 + 16 * mb + 4 * q);
                bf16x8 bS[4];
#pragma unroll
                for (int ks = 0; ks < 4; ++ks) bS[ks] = pack_acc(T[2 * ks], T[2 * ks + 1]);
                f32x4 acc = (f32x4){0.f, 0.f, 0.f, 0.f};
                { LN_FRESH(ln);
#pragma unroll
                for (int ks = 0; ks < 4; ++ks) acc = mfma16(frag_q2(L + IMG_HQT, 16 * j, ks, ln), bS[ks], acc); }
                LN_FRESH(ln2);
                const bf16x8 bVh = frag_tr(L + IMG_HV, 16 * j, wave, ln2, 15);
                acc = mfma16(ld16(L + PH_OFF + j * 1024 + r * 64 + 16 * q), bVh, acc);
                oacc[j] = acc;
#pragma unroll
                for (int mb = 0; mb < 8; ++mb) {
                    LN_FRESH(ln3);
                    bf16x8 aK = frag_tr(L + IMG_HKT, 16 * j, mb, ln3, 15);
                    if (q >= 2) aK = (bf16x8){0, 0, 0, 0, 0, 0, 0, 0};
                    Sacc[mb] = mfma16(aK, bVh, T[mb]) * *(const LAS f32x4*)(MF + MF_E157 + j * 128 + 16 * mb + 4 * q);
                }
            }
            __syncthreads();
            const int t4 = tid >> 3, c8 = tid & 7;
            const bf16* pc = Pcur + (size_t)(b * SEGT + tl0 + t4) * PW + h * HB + 16 * c8;
            const v4u ca0 = *(const GAS v4u*)(pc + PO_CA), ca1 = *(const GAS v4u*)(pc + PO_CA + 8), cb0 = *(const GAS v4u*)(pc + PO_CB), cb1 = *(const GAS v4u*)(pc + PO_CB + 8);
#pragma unroll
            for (int mt = 0; mt < 4; ++mt)
#pragma unroll
                for (int e = 0; e < 4; ++e) { const int tt = 16 * mt + 4 * q + e, dvc = 16 * wave + r; const unsigned o = offb(tt, dvc >> 3) + 2 * (dvc & 7);
                    *(LAS unsigned short*)(L + HAB_OFF + o) = (unsigned short)(pkbf(hval[mt][e], hval[mt][e]) & 0xffffu); *(LAS unsigned short*)(L + OBB_OFF + o) = (unsigned short)(pkbf(oacc[mt][e], oacc[mt][e]) & 0xffffu); }
            if (tid < 128) { float s = decay * MF[MF_N + tid];
#pragma unroll
                for (int w = 0; w < 8; ++w) s += MF[MF_NRED + w * 128 + tid];
                MF[MF_N + tid] = s; }
            __syncthreads();
            {
                float ha[16], ob[16], ca[16], cb[16];
                { const v4u a0 = *(const LAS v4u*)(L + HAB_OFF + offb(t4, 2 * c8)), a1 = *(const LAS v4u*)(L + HAB_OFF + offb(t4, 2 * c8 + 1)), b0 = *(const LAS v4u*)(L + OBB_OFF + offb(t4, 2 * c8)), b1 = *(const LAS v4u*)(L + OBB_OFF + offb(t4, 2 * c8 + 1));
                  float x[8]; unpack8(a0, x);
#pragma unroll
                  for (int e = 0; e < 8; ++e) ha[e] = x[e];
                  unpack8(a1, x);
#pragma unroll
                  for (int e = 0; e < 8; ++e) ha[8 + e] = x[e];
                  unpack8(b0, x);
#pragma unroll
                  for (int e = 0; e < 8; ++e) ob[e] = x[e];
                  unpack8(b1, x);
#pragma unroll
                  for (int e = 0; e < 8; ++e) ob[8 + e] = x[e];
                  unpack8(ca0, x);
#pragma unroll
                  for (int e = 0; e < 8; ++e) ca[e] = x[e];
                  unpack8(ca1, x);
#pragma unroll
                  for (int e = 0; e < 8; ++e) ca[8 + e] = x[e];
                  unpack8(cb0, x);
#pragma unroll
                  for (int e = 0; e < 8; ++e) cb[e] = x[e];
                  unpack8(cb1, x);
#pragma unroll
                  for (int e = 0; e < 8; ++e) cb[8 + e] = x[e]; }
                float ssa = 0.f, ssb = 0.f;
#pragma unroll
                for (int e = 0; e < 16; ++e) { ssa += ha[e] * ha[e]; ssb += ob[e] * ob[e]; }
#pragma unroll
                for (int o = 1; o < 8; o <<= 1) { ssa += __shfl_xor(ssa, o); ssb += __shfl_xor(ssb, o); }
                const float ra = rsqrtf(ssa * (1.f / 128.f) + RMS_EPS), rb = rsqrtf(ssb * (1.f / 128.f) + RMS_EPS);
                float y[16];
#pragma unroll
                for (int e4 = 0; e4 < 4; ++e4) { const f32x4 wa = *(const LAS f32x4*)(MF + MF_WN + 16 * c8 + 4 * e4), wb = *(const LAS f32x4*)(MF + MF_WN + 128 + 16 * c8 + 4 * e4);
#pragma unroll
                    for (int e = 0; e < 4; ++e) y[4 * e4 + e] = ca[4 * e4 + e] * (ha[4 * e4 + e] * ra * wa[e]) + cb[4 * e4 + e] * (ob[4 * e4 + e] * rb * wb[e]); }
                v4u o0, o1; o0.x = pkbf(y[0], y[1]); o0.y = pkbf(y[2], y[3]); o0.z = pkbf(y[4], y[5]); o0.w = pkbf(y[6], y[7]); o1.x = pkbf(y[8], y[9]); o1.y = pkbf(y[10], y[11]); o1.z = pkbf(y[12], y[13]); o1.w = pkbf(y[14], y[15]);
                bf16* yp = Y + (grow0 + t4) * D + h * 128 + 16 * c8;
                if (!DRY) { *(GAS v4u*)yp = o0; *(GAS v4u*)(yp + 8) = o1; } else { asm volatile("" :: "v"(o0), "v"(o1)); }
            }
            mst = mnext;
        }
        int lane_s; asm volatile("v_mbcnt_lo_u32_b32 %0, -1, 0\n\tv_mbcnt_hi_u32_b32 %0, -1, %0" : "=v"(lane_s));
#pragma unroll
        for (int mb = 0; mb < 8; ++mb)
#pragma unroll
            for (int e = 0; e < 4; ++e) { if (!DRY) { stC[((size_t)(bh * 8 + wave) * 32 + mb * 4 + e) * 64 + lane_s] = Cacc[mb][e]; stS[((size_t)(bh * 8 + wave) * 32 + mb * 4 + e) * 64 + lane_s] = Sacc[mb][e]; } else { asm volatile("" :: "v"(Cacc[mb][e]), "v"(Sacc[mb][e])); } }
        __syncthreads();
        if (!DRY) { if (tid < 128) stN[bh * 128 + tid] = MF[MF_N + tid];
        if (tid == 0) stM[bh] = mst; }
        __syncthreads();
    }
}

__global__ void __launch_bounds__(NWAVES * 64, 2) fwd_kernel(Args kernel_args_unused) {
    extern __shared__ __attribute__((aligned(16))) unsigned char lds[];
    Ctx F;
    F.lds = (LAS unsigned char*)lds;
    F.wave_s = __builtin_amdgcn_readfirstlane(threadIdx.x >> 6);
    F.G = gridDim.x; { const int bx = blockIdx.x; F.vcu = (F.G % 8 == 0) ? (bx % 8) * (F.G / 8) + bx / 8 : bx; }
    volatile LAS unsigned* MISC = (volatile LAS unsigned*)(F.lds + MISC_OFF);
    if (threadIdx.x < 64) MISC[threadIdx.x] = 0u;
    __syncthreads();
    unsigned bar_x;
    { ARGS(); const XcdBarrier b0 = xcd_barrier_post((unsigned*)((gu32*)(A.ws + WS_CTL) + CW_BAR), MISC + 8); bar_x = b0.x; }
#define GRID_BAR() do { ARGS(); XcdBarrier bb; bb.bar = (unsigned*)((gu32*)(A.ws + WS_CTL) + CW_BAR); bb.x = bar_x; asm volatile("" : "+s"(bb.x)); bb.st = (volatile LAS unsigned*)(F.lds + MISC_OFF) + 8; xcd_barrier(bb); } while (0)

    p0_prologue(F);
    GRID_BAR();

    for (int layer = 0; layer < DEPTH; ++layer) {
#define PHASE_PTRS() ARGS(); const float* src = layer == 0 ? A.in[0] : (const float*)A.out; const float* modl = (const float*)(A.ws + WS_MOD) + (size_t)layer * BATCH * MODW; bf16* hn = (bf16*)(A.ws + WS_HN); (void)src; (void)modl; (void)hn
#ifdef PROBE_EW2
        { PHASE_PTRS();
        norm_phase<true>(F, src, A.in[4] + (size_t)layer * D, modl, 0, D, hn, (float*)(A.ws + WS_GATES), (const float*)(A.ws + WS_WG) + (size_t)layer * 16 * D, (const float*)(A.ws + WS_BG) + layer * 16); __syncthreads(); }
#endif
        { PHASE_PTRS();
        norm_phase<true>(F, src, A.in[4] + (size_t)layer * D, modl, 0, D, hn, (float*)(A.ws + WS_GATES), (const float*)(A.ws + WS_WG) + (size_t)layer * 16 * D, (const float*)(A.ws + WS_BG) + layer * 16); }
        GRID_BAR();
        for (int seg = 0; seg < NSEG; ++seg) {
            {
                PHASE_PTRS();
                pg8::Gemm g{hn, (const bf16*)(A.ws + WS_WIN) + (size_t)layer * NPROJ * D, SEGROWS, NPROJ, D, SEG_SH, SEQ / 256, seg * (SEGT / 256), SEGT / 256 - 1};
                pg8::StaticOrder S; S.init(SEGROWS, NPROJ, F.G, (int)blockIdx.x);
                pg8::EpiInProj E{(bf16*)(A.ws + WS_P + (size_t)(seg & 1) * P_BYTES), PW, (const float*)(A.ws + WS_BIASP) + (size_t)layer * NPROJ};
                pg8::gemm_phase<pg8::EpiInProj, pg8::StaticOrder, PG8_ALIGN, PG8_SP2>(F.lds + RING_OFF, g, S, E, F.wave_s);
            }
            GRID_BAR();
#ifdef PROBE_MIX2
            mixer_fast_phase<true>(F, layer, seg); __syncthreads();
#endif
            mixer_fast_phase<false>(F, layer, seg);
            GRID_BAR();
        }
        {
            PHASE_PTRS();
            pg8::Gemm g{(const bf16*)(A.ws + WS_Y), (const bf16*)(A.ws + WS_WOUT) + (size_t)layer * D * D, M, D, D, 0, 1, 0, 0};
            pg8::StaticOrder S; S.init(M, D, F.G, (int)blockIdx.x);
            pg8::EpiResid E{src, A.out, D, modl + 2 * D, MODW, 0};
#ifdef PROBE_GEMM2
            { pg8::EpiResid E2 = E; E2.out = (float*)(A.ws + WS_P); pg8::gemm_phase<pg8::EpiResid, pg8::StaticOrder, PG8_ALIGN, PG8_SP2>(F.lds + RING_OFF, g, S, E2, F.wave_s); __syncthreads(); }
#endif
            pg8::gemm_phase<pg8::EpiResid, pg8::StaticOrder, PG8_ALIGN, PG8_SP2>(F.lds + RING_OFF, g, S, E, F.wave_s);
        }
        GRID_BAR();
#ifdef PROBE_EW2
        { PHASE_PTRS();
        norm_phase<false>(F, (const float*)A.out, A.in[13] + (size_t)layer * D, modl, 3 * D, 4 * D, hn, nullptr, nullptr, nullptr); __syncthreads(); }
#endif
        { PHASE_PTRS();
        norm_phase<false>(F, (const float*)A.out, A.in[13] + (size_t)layer * D, modl, 3 * D, 4 * D, hn, nullptr, nullptr, nullptr); }
        GRID_BAR();
        {
            PHASE_PTRS();
            pg8::Gemm g{hn, (const bf16*)(A.ws + WS_WUP) + (size_t)layer * 2 * DFF * D, M, 2 * DFF, D, 0, 1, 0, 0};
            pg8::StaticOrder S; S.init(M, 2 * DFF, F.G, (int)blockIdx.x);
            pg8::EpiUpGlu E{(bf16*)(A.ws + WS_G), (bf16*)(A.ws + WS_S), A.in[15] + (size_t)layer * 3 * 2 * DFF, A.in[16] + (size_t)layer * 2 * DFF, DFF};
            pg8::gemm_phase<pg8::EpiUpGlu, pg8::StaticOrder, PG8_ALIGN, PG8_SP2>(F.lds + RING_OFF, g, S, E, F.wave_s);
        }
        GRID_BAR();
        { ARGS(); ffn_fix_phase(F, (const bf16*)(A.ws + WS_S), (bf16*)(A.ws + WS_G), A.in[15] + (size_t)layer * 3 * 2 * DFF, A.in[16] + (size_t)layer * 2 * DFF); }
        GRID_BAR();
        {
            PHASE_PTRS();
            pg8::Gemm g{(const bf16*)(A.ws + WS_G), (const bf16*)(A.ws + WS_WDN) + (size_t)layer * D * DFF, M, D, DFF, 0, 1, 0, 0};
            pg8::StaticOrder S; S.init(M, D, F.G, (int)blockIdx.x);
            pg8::EpiResid E{(const float*)A.out, A.out, D, modl + 5 * D, MODW, 0};
            pg8::gemm_phase<pg8::EpiResid, pg8::StaticOrder, PG8_ALIGN, PG8_SP2>(F.lds + RING_OFF, g, S, E, F.wave_s);
        }
        GRID_BAR();
    }
    { ARGS(); final_norm_phase(F, A.out, A.in[18]); }
#undef GRID_BAR
}

extern "C" void kernel_launch(void* const* d_in, const int* in_sizes, int n_in, void* d_out, int out_size, void* d_ws, size_t ws_size, hipStream_t stream) {
    static int grid = 0;
    if (grid == 0) {
        if (n_in != 19 || in_sizes[0] != M * D || out_size != M * D || ws_size < WS_END) { fprintf(stderr, "kernel_launch: unexpected shapes (n_in %d, in0 %d, out %d, ws %zu; need ws >= %zu); nothing launched\n", n_in, n_in > 0 ? in_sizes[0] : -1, out_size, ws_size, (size_t)WS_END); grid = -1; return; }
        int dev = 0, cus = 0, per_cu = 0;
        if (hipGetDevice(&dev) != hipSuccess || hipDeviceGetAttribute(&cus, hipDeviceAttributeMultiprocessorCount, dev) != hipSuccess) { grid = -1; return; }
        if (hipFuncSetAttribute((const void*)fwd_kernel, hipFuncAttributeMaxDynamicSharedMemorySize, LDS_BYTES) != hipSuccess) { fprintf(stderr, "kernel_launch: hipFuncSetAttribute failed\n"); grid = -1; return; }
        if (hipOccupancyMaxActiveBlocksPerMultiprocessor(&per_cu, (const void*)fwd_kernel, NWAVES * 64, LDS_BYTES) != hipSuccess || per_cu < 1)
            fprintf(stderr, "kernel_launch: note: occupancy query reports %d workgroups per CU\n", per_cu);
        (void)hipGetLastError();
        grid = cus;
    }
    if (grid < 0) return;
    if (hipMemsetAsync((char*)d_ws + WS_CTL, 0, CTL_ZERO_BYTES, stream) != hipSuccess) return;
    Args a{};
    for (int i = 0; i < 19; ++i) a.in[i] = (const float*)d_in[i];
    a.out = (float*)d_out; a.ws = (unsigned char*)d_ws;
    hipLaunchKernelGGL(fwd_kernel, dim3(grid), dim3(NWAVES * 64), LDS_BYTES, stream, a);
}
```

```cpp
#include <hip/hip_runtime.h>
#include <cstdio>
#include <cstdint>
namespace pg8 {
#define PG8_LAS __attribute__((address_space(3)))
typedef unsigned short bf16_t;
typedef short bf16x8 __attribute__((ext_vector_type(8)));
typedef float f32x4 __attribute__((ext_vector_type(4)));
typedef unsigned u32x4 __attribute__((ext_vector_type(4)));
constexpr int BM = 256, BK = 64, HALF = 128, HTB = HALF * BK * 2  , STAGE_BYTES = 8 * HTB, NXCD = 8, WGM = 8;

__host__ __device__ __forceinline__ int lds_byte(int r, int c) { const int st = (r >> 4) * 2 + (c >> 5), rr = r & 15, cc = c & 31, ob = rr * 64 + cc * 2; return st * 1024 + (ob ^ (((ob >> 9) & 1) << 5)); }
__host__ __device__ __forceinline__ void stage_rc(int b, int& R, int& C) { const int st = b / 1024, sb = b % 1024, swz = sb ^ (((sb >> 9) & 1) << 5); R = (st >> 1) * 16 + swz / 64; C = (st & 1) * 32 + (swz % 64) / 2; }
__host__ __device__ __forceinline__ int perm32(int rho) { const int n = rho >> 4, i = rho & 15; return 8 * (i >> 2) + 4 * n + (i & 3); }

struct Unit { int pm, pn; };
struct Gemm { const bf16_t* A; const bf16_t* Bt; int M, N, K; int a_sh, a_mul, a_add, a_mask;
    __device__ __forceinline__ int atile(int pm) const { return (pm >> a_sh) * a_mul + a_add + (pm & a_mask); } };

struct StaticOrder {
    int nM, nN, nwg, G, c;
    __host__ __device__ void init(int M, int N, int G_, int c_) { nM = M / BM; nN = N / BM; nwg = nM * nN; G = G_; c = c_; }
    __host__ __device__ bool next(int i, Unit& u) const {
        const long L = (long)i * G + c; if (L >= nwg) return false;
        int wgid = (int)L; { const int q = nwg / NXCD, r = nwg % NXCD, xcd = wgid % NXCD, off = wgid / NXCD; wgid = (xcd < r ? xcd * (q + 1) : r * (q + 1) + (xcd - r) * q) + off; }
        const int nig = WGM * nN, gid = wgid / nig, fm = gid * WGM, gsz = (nM - fm) < WGM ? (nM - fm) : WGM;
        u.pm = fm + ((wgid % nig) % gsz); u.pn = (wgid % nig) / gsz; return true;
    }
    __device__ __forceinline__ void a_ready(const Unit&) const {}
    __device__ __forceinline__ void done(const Unit&) const {}
};

__host__ __device__ __forceinline__ int wg_bh(int i) { return (i & 7) * 32 + (i >> 3); }
struct OwnOrder {
    int G, c, MT;
    __host__ __device__ void init(int G_, int c_, int MT_) { G = G_; c = c_; MT = MT_; }
    __host__ __device__ bool next(int i, Unit& u) const {
        const int upb = MT * 5, k = i / upb, j = i - k * upb, bhi = c + k * G; if (bhi >= 256) return false;
        const int bh = wg_bh(bhi), b = bh >> 3, h = bh & 7;
        u.pm = b * MT + j / 5; u.pn = 5 * h + j % 5; return true;
    }
    __device__ __forceinline__ void a_ready(const Unit&) const {}
    __device__ __forceinline__ void done(const Unit&) const {}
};

__device__ __forceinline__ unsigned cvt_pk_bf16(float lo, float hi) { unsigned r; asm volatile("v_cvt_pk_bf16_f32 %0, %1, %2" : "=v"(r) : "v"(lo), "v"(hi)); return r; }

struct EpiBf16B {
    static constexpr bool PERM = true, AFTER_DRAIN = false; static constexpr int TID = 4;
    bf16_t* O; int ldc; const float* bias;
    __device__ __forceinline__ void operator()(const f32x4 (&acc)[2][2][4][2], const Unit& u, int wr, int wc, int fr, int fq) const {
        const int row0 = u.pm * BM + wr * 64 + fr; const int col0 = u.pn * BM + wc * 32 + 8 * fq;
        f32x4 bv[2][2];
#pragma unroll
        for (int bj = 0; bj < 2; ++bj)
#pragma unroll
            for (int n = 0; n < 2; ++n) bv[bj][n] = bias ? *(const f32x4*)(bias + col0 + bj * HALF + 4 * n) : (f32x4){0.f, 0.f, 0.f, 0.f};
#pragma unroll
        for (int ai = 0; ai < 2; ++ai)
#pragma unroll
            for (int m = 0; m < 4; ++m) { bf16_t* rowp = O + (size_t)(row0 + ai * HALF + m * 16) * ldc + col0;
#pragma unroll
                for (int bj = 0; bj < 2; ++bj) { const f32x4 v0 = acc[ai][bj][m][0] + bv[bj][0], v1 = acc[ai][bj][m][1] + bv[bj][1];
                    u32x4 w; w.x = cvt_pk_bf16(v0[0], v0[1]); w.y = cvt_pk_bf16(v0[2], v0[3]); w.z = cvt_pk_bf16(v1[0], v1[1]); w.w = cvt_pk_bf16(v1[2], v1[3]);
                    *(u32x4*)(rowp + bj * HALF) = w; } }
    }
};
struct EpiResid {
    static constexpr bool PERM = false, AFTER_DRAIN = false; static constexpr int TID = 3;
    const float* res; float* out; int ldc; const float* gate; int gstride; int row_off; int pm_mask;
    __device__ __forceinline__ void operator()(const f32x4 (&acc)[2][2][4][2], const Unit& u, int wr, int wc, int fr, int fq) const {
        const int rbase = row_off + u.pm * BM; const int b = rbase >> 11;
        const int row0 = rbase + wr * 64 + fr, col0 = u.pn * BM + wc * 32 + 4 * fq;
        const float* gp = gate + (size_t)b * gstride + col0;
        f32x4 gv[2][2];
#pragma unroll
        for (int bj = 0; bj < 2; ++bj)
#pragma unroll
            for (int n = 0; n < 2; ++n) gv[bj][n] = *(const f32x4*)(gp + bj * HALF + n * 16);
        const size_t fold = (size_t)(u.pm & ~pm_mask) * BM * ldc;
#pragma unroll
        for (int ai = 0; ai < 2; ++ai) {
            f32x4 rv[4][2][2];
#pragma unroll
            for (int m = 0; m < 4; ++m)
#pragma unroll
                for (int bj = 0; bj < 2; ++bj)
#pragma unroll
                    for (int n = 0; n < 2; ++n) rv[m][bj][n] = *(const f32x4*)(res + (size_t)(row0 + ai * HALF + m * 16) * ldc + col0 + bj * HALF + n * 16);
            asm volatile("" ::: "memory");
#pragma unroll
            for (int m = 0; m < 4; ++m)
#pragma unroll
                for (int bj = 0; bj < 2; ++bj)
#pragma unroll
                    for (int n = 0; n < 2; ++n) *(f32x4*)(out + ((size_t)(row0 + ai * HALF + m * 16) * ldc - fold) + col0 + bj * HALF + n * 16) = rv[m][bj][n] + gv[bj][n] * acc[ai][bj][m][n];
            asm volatile("" ::: "memory");
        }
    }
};


struct EpiInProj {
    static constexpr bool PERM = true, AFTER_DRAIN = false; static constexpr int TID = 1;
    bf16_t* O; int ldc; const float* bias; int pm_mask;
    __device__ __forceinline__ void operator()(const f32x4 (&acc)[2][2][4][2], const Unit& u, int wr, int wc, int fr, int fq) const {
        const int head = u.pn / 5, part = u.pn - 5 * head;
        const int row0 = (u.pm & pm_mask) * BM + wr * 64 + fr, cin = wc * 32 + 8 * fq;
        f32x4 bv[2][2];
#pragma unroll
        for (int bj = 0; bj < 2; ++bj)
#pragma unroll
            for (int n = 0; n < 2; ++n) bv[bj][n] = *(const f32x4*)(bias + u.pn * BM + bj * HALF + cin + 4 * n);
        if (part < 3) {
#pragma unroll
            for (int ai = 0; ai < 2; ++ai)
#pragma unroll
                for (int m = 0; m < 4; ++m) { bf16_t* rowp = O + (size_t)(row0 + ai * HALF + m * 16) * ldc + head * 1024 + part * 256 + cin;
#pragma unroll
                    for (int bj = 0; bj < 2; ++bj) { const f32x4 v0 = acc[ai][bj][m][0] + bv[bj][0], v1 = acc[ai][bj][m][1] + bv[bj][1];
                        u32x4 w; w.x = cvt_pk_bf16(v0[0], v0[1]); w.y = cvt_pk_bf16(v0[2], v0[3]); w.z = cvt_pk_bf16(v1[0], v1[1]); w.w = cvt_pk_bf16(v1[2], v1[3]);
                        if (pm_mask == -2) { asm volatile("" :: "v"(w)); } else *(u32x4*)(rowp + bj * HALF) = w; } }
        } else {
            const bool silu0 = part == 4;
#pragma unroll
            for (int ai = 0; ai < 2; ++ai)
#pragma unroll
                for (int m = 0; m < 4; ++m) { bf16_t* rowp = O + (size_t)(row0 + ai * HALF + m * 16) * ldc + head * 1024 + 768 + (part - 3) * 128 + cin;
                    float c[8];
#pragma unroll
                    for (int n = 0; n < 2; ++n) { const f32x4 x0 = acc[ai][0][m][n] + bv[0][n], x1 = acc[ai][1][m][n] + bv[1][n];
                        const f32x4 t0 = x0 * -1.4426950408889634f, t1 = x1 * -1.4426950408889634f;
                        const f32x4 d0 = (f32x4){__builtin_amdgcn_exp2f(t0[0]), __builtin_amdgcn_exp2f(t0[1]), __builtin_amdgcn_exp2f(t0[2]), __builtin_amdgcn_exp2f(t0[3])} + 1.f;
                        const f32x4 d1 = (f32x4){__builtin_amdgcn_exp2f(t1[0]), __builtin_amdgcn_exp2f(t1[1]), __builtin_amdgcn_exp2f(t1[2]), __builtin_amdgcn_exp2f(t1[3])} + 1.f;
                        const f32x4 dd = d0 * d1;
                        f32x4 s01 = (f32x4){__builtin_amdgcn_rcpf(dd[0]), __builtin_amdgcn_rcpf(dd[1]), __builtin_amdgcn_rcpf(dd[2]), __builtin_amdgcn_rcpf(dd[3])};
                        if (silu0) { asm volatile("" ::: "memory"); s01 = s01 * x0; }
#pragma unroll
                        for (int e = 0; e < 4; ++e) c[4 * n + e] = s01[e]; }
                    u32x4 w; w.x = cvt_pk_bf16(c[0], c[1]); w.y = cvt_pk_bf16(c[2], c[3]); w.z = cvt_pk_bf16(c[4], c[5]); w.w = cvt_pk_bf16(c[6], c[7]);
                    if (pm_mask == -2) { asm volatile("" :: "v"(w)); } else *(u32x4*)rowp = w; }
        }
    }
};

struct EpiUpGlu {
    static constexpr bool PERM = true, AFTER_DRAIN = false; static constexpr int TID = 2;
    bf16_t* G; bf16_t* S; const float* cw; const float* cb; int nf; int pm_mask;
    __device__ __forceinline__ void operator()(const f32x4 (&acc)[2][2][4][2], const Unit& u, int wr, int wc, int fr, int fq) const {
        const int cin = wc * 32 + 8 * fq, f0 = u.pn * HALF + cin;
        if (fr < 2 || fr >= 14) {
            const int m = fr < 2 ? 0 : 3, rr = fr < 2 ? fr : fr - 12;
#pragma unroll
            for (int ai = 0; ai < 2; ++ai) { const int g64 = (u.pm & pm_mask) * 4 + 2 * ai + wr; bf16_t* sp = S + ((size_t)g64 * 4 + rr) * (2 * nf) + u.pn * BM + cin;
#pragma unroll
                for (int bj = 0; bj < 2; ++bj) { const f32x4 v0 = fr < 2 ? acc[ai][bj][0][0] : acc[ai][bj][3][0], v1 = fr < 2 ? acc[ai][bj][0][1] : acc[ai][bj][3][1];
                    u32x4 w; w.x = cvt_pk_bf16(v0[0], v0[1]); w.y = cvt_pk_bf16(v0[2], v0[3]); w.z = cvt_pk_bf16(v1[0], v1[1]); w.w = cvt_pk_bf16(v1[2], v1[3]);
                    *(u32x4*)(sp + bj * HALF) = w; } }
            (void)m;
        }
        unsigned outp[2][4][4];
#define UG_MIRROR(x) __builtin_bit_cast(float, __builtin_amdgcn_update_dpp(0, __builtin_bit_cast(int, (x)), 0x140, 0xf, 0xf, true))
#define UG_SWAP01(x) __builtin_bit_cast(float, __builtin_amdgcn_update_dpp(0, __builtin_bit_cast(int, (x)), 0xB1, 0xf, 0xf, true))
#define UG_SHR1(old, x) __builtin_bit_cast(float, __builtin_amdgcn_update_dpp(__builtin_bit_cast(int, (old)), __builtin_bit_cast(int, (x)), 0x111, 0xf, 0xf, false))
#define UG_SHR2(old, x) __builtin_bit_cast(float, __builtin_amdgcn_update_dpp(__builtin_bit_cast(int, (old)), __builtin_bit_cast(int, (x)), 0x112, 0xf, 0xf, false))
        typedef float f32x2u __attribute__((ext_vector_type(2)));
#define UG_P2(v4, ep) ((f32x2u){(v4)[2 * (ep)], (v4)[2 * (ep) + 1]})
#pragma unroll
        for (int n = 0; n < 2; ++n) {
            const f32x4 wg0 = *(const f32x4*)(cw + f0 + 4 * n), wg1 = *(const f32x4*)(cw + 2 * nf + f0 + 4 * n), wg2 = *(const f32x4*)(cw + 4 * nf + f0 + 4 * n);
            const f32x4 wv0 = *(const f32x4*)(cw + nf + f0 + 4 * n), wv1 = *(const f32x4*)(cw + 3 * nf + f0 + 4 * n), wv2 = *(const f32x4*)(cw + 5 * nf + f0 + 4 * n);
            const f32x4 bg = *(const f32x4*)(cb + f0 + 4 * n), bv = *(const f32x4*)(cb + nf + f0 + 4 * n);
#pragma unroll
            for (int ai = 0; ai < 2; ++ai) {
                float o[4][4];
#pragma unroll
                for (int ep = 0; ep < 2; ++ep) {
                    const f32x2u g0 = UG_P2(wg0, ep), g1 = UG_P2(wg1, ep), g2 = UG_P2(wg2, ep), v0 = UG_P2(wv0, ep), v1 = UG_P2(wv1, ep), v2 = UG_P2(wv2, ep), b_g = UG_P2(bg, ep), b_v = UG_P2(bv, ep);
                    f32x2u mg = (f32x2u){0.f, 0.f}, mv = (f32x2u){0.f, 0.f};
#pragma unroll
                    for (int m = 0; m < 4; ++m) {
                        const f32x2u xg = UG_P2(acc[ai][0][m][n], ep), xv = UG_P2(acc[ai][1][m][n], ep);
                        const float xg0 = xg.x, xg1 = xg.y, xv0 = xv.x, xv1 = xv.y, mg0 = mg.x, mg1 = mg.y, mv0 = mv.x, mv1 = mv.y;
                        const f32x2u pg2 = (f32x2u){UG_SHR2(UG_SWAP01(mg0), xg0), UG_SHR2(UG_SWAP01(mg1), xg1)}, pv2 = (f32x2u){UG_SHR2(UG_SWAP01(mv0), xv0), UG_SHR2(UG_SWAP01(mv1), xv1)};
                        const f32x2u pg1 = (f32x2u){UG_SHR1(mg0, xg0), UG_SHR1(mg1, xg1)}, pv1 = (f32x2u){UG_SHR1(mv0, xv0), UG_SHR1(mv1, xv1)};
                        const f32x2u cg = b_g + g2 * xg + g1 * pg1 + g0 * pg2;
                        const f32x2u cv = b_v + v2 * xv + v1 * pv1 + v0 * pv2;
                        const f32x2u ex = cg * -1.4426950408889634f;
                        const f32x2u den = (f32x2u){__builtin_amdgcn_exp2f(ex.x), __builtin_amdgcn_exp2f(ex.y)} + 1.f;
                        const f32x2u r = (f32x2u){__builtin_amdgcn_rcpf(den.x), __builtin_amdgcn_rcpf(den.y)};
                        const f32x2u ov = cg * r * cv;
                        o[m][2 * ep] = ov.x; o[m][2 * ep + 1] = ov.y;
                        mg = (f32x2u){UG_MIRROR(xg0), UG_MIRROR(xg1)}; mv = (f32x2u){UG_MIRROR(xv0), UG_MIRROR(xv1)};
                    }
                }
#pragma unroll
                for (int m = 0; m < 4; ++m) { outp[ai][m][2 * n] = cvt_pk_bf16(o[m][0], o[m][1]); outp[ai][m][2 * n + 1] = cvt_pk_bf16(o[m][2], o[m][3]); }
            }
        }
#undef UG_P2
#undef UG_MIRROR
#undef UG_SWAP01
#undef UG_SHR1
#undef UG_SHR2
#pragma unroll
        for (int ai = 0; ai < 2; ++ai)
#pragma unroll
            for (int m = 0; m < 4; ++m) if (m > 0 || fr >= 2) { u32x4 w; w.x = outp[ai][m][0]; w.y = outp[ai][m][1]; w.z = outp[ai][m][2]; w.w = outp[ai][m][3];
                *(u32x4*)(G + (size_t)((u.pm & pm_mask) * BM + ai * HALF + wr * 64 + m * 16 + fr) * nf + f0) = w; }
    }
};

template <bool PERM_> struct EpiNull {
    static constexpr bool PERM = PERM_, AFTER_DRAIN = false; static constexpr int TID = 5;
    __device__ __forceinline__ void operator()(const f32x4 (&acc)[2][2][4][2], const Unit&, int, int, int, int) const {
#pragma unroll
        for (int a = 0; a < 2; ++a)
#pragma unroll
            for (int b = 0; b < 2; ++b)
#pragma unroll
                for (int m = 0; m < 4; ++m)
#pragma unroll
                    for (int n = 0; n < 2; ++n) asm volatile("" :: "v"(acc[a][b][m][n]));
    }
};
template <class Epi, class Sched, bool ALIGN_EPI = false, bool SP2 = false>
__device__ __forceinline__ void gemm_phase(PG8_LAS unsigned char* lds, const Gemm g, const Sched& S, const Epi& E, const int wave_id  ) {
    int tid_l; asm volatile("v_mbcnt_lo_u32_b32 %0, -1, 0\n\tv_mbcnt_hi_u32_b32 %0, -1, %0" : "=v"(tid_l)); tid_l += wave_id * 64;
    const int tid = tid_l, wid = __builtin_amdgcn_readfirstlane(tid >> 6), lane = tid & 63, wr = wid >> 2, wc = wid & 3, fr = lane & 15, fq = lane >> 4;
    const int K = g.K, nt = K / BK;
    unsigned voffA[2], voffB[2];
#pragma unroll
    for (int i = 0; i < 2; ++i) { int R, C; stage_rc(tid * 16 + i * 8192, R, C); const int Rb = Epi::PERM ? ((R & ~31) + perm32(R & 31)) : R;
        voffA[i] = (unsigned)(R * K + C) * 2u; voffB[i] = (unsigned)(Rb * K + C) * 2u; }
    const size_t kstep = (size_t)(BK * 2);
    const size_t hstep = (size_t)HALF * K * 2;
    const size_t tstep = 2 * hstep;
    const unsigned ldsw = (unsigned)wid * 1024u;
    const int aoff = lds_byte(wr * 64 + fr, fq * 8), boff = lds_byte(wc * 32 + fr, fq * 8);
#define PG8_SA(b, h) (((b) * 2 + (h)) * HTB)
#define PG8_SB(b, h) ((4 + (b) * 2 + (h)) * HTB)
#define PG8_STAGE(bufoff, gbase, voff) do { _Pragma("unroll") for (int _i = 0; _i < 2; ++_i) \
        __builtin_amdgcn_global_load_lds((const unsigned*)((const char*)(gbase) + (voff)[_i]), (PG8_LAS unsigned*)(lds + (bufoff) + ldsw + _i * 8192), 16, 0, 0); } while (0)
#define PG8_LDA(dst, b, h) do { _Pragma("unroll") for (int m = 0; m < 4; ++m) _Pragma("unroll") for (int k = 0; k < 2; ++k) dst[m][k] = *(const PG8_LAS bf16x8*)(lds + PG8_SA(b, h) + aoff + m * 2048 + k * 1024); } while (0)
#define PG8_LDB(dst, b, h) do { _Pragma("unroll") for (int n = 0; n < 2; ++n) _Pragma("unroll") for (int k = 0; k < 2; ++k) dst[n][k] = *(const PG8_LAS bf16x8*)(lds + PG8_SB(b, h) + boff + n * 2048 + k * 1024); } while (0)
#define PG8_MMA(ai, bj, At, Bt) do { __builtin_amdgcn_s_setprio(1); _Pragma("unroll") for (int m = 0; m < 4; ++m) _Pragma("unroll") for (int n = 0; n < 2; ++n) _Pragma("unroll") for (int k = 0; k < 2; ++k) \
        acc[ai][bj][m][n] = __builtin_amdgcn_mfma_f32_16x16x32_bf16(Bt[n][k], At[m][k], acc[ai][bj][m][n], 0, 0, 0); __builtin_amdgcn_s_setprio(0); } while (0)
#define PG8_WAIT_V(n) asm volatile("s_waitcnt vmcnt(" #n ")" ::: "memory")
#define PG8_WAIT_L(n) asm volatile("s_waitcnt lgkmcnt(" #n ")" ::: "memory")
#define PG8_BAR __builtin_amdgcn_s_barrier()
#define PG8_SCHED __builtin_amdgcn_sched_barrier(0)
    Unit cur, nxt; int ui = 0;
    if (!S.next(0, cur)) return;
    f32x4 acc[2][2][4][2];
#pragma unroll
    for (int a = 0; a < 2; ++a)
#pragma unroll
        for (int b = 0; b < 2; ++b)
#pragma unroll
            for (int m = 0; m < 4; ++m)
#pragma unroll
                for (int n = 0; n < 2; ++n) { f32x4 z_; asm volatile("v_mov_b64 %0, 0\n\tv_mov_b64 %1, 0" : "=v"(*(double*)&z_), "=v"(*((double*)&z_ + 1))); acc[a][b][m][n] = z_; }
    bf16x8 At[4][2], B0[2][2], B1[2][2];
    const char* cA = (const char*)g.A + (size_t)g.atile(cur.pm) * tstep; const char* cB = (const char*)g.Bt + (size_t)cur.pn * tstep;
    S.a_ready(cur);
#if defined(PG8_STAGGER) && PG8_STAGGER > 0
    {
        const unsigned long long t0_ = __builtin_amdgcn_s_memrealtime(), dt_ = (unsigned long long)((blockIdx.x >> 3) & 7) * PG8_STAGGER;
        while (__builtin_amdgcn_s_memrealtime() - t0_ < dt_) __builtin_amdgcn_s_sleep(8);
    }
#endif
    if constexpr (SP2) {
        PG8_STAGE(PG8_SB(0, 0), cB, voffB); PG8_STAGE(PG8_SB(0, 1), cB + hstep, voffB); PG8_STAGE(PG8_SA(0, 0), cA, voffA); PG8_STAGE(PG8_SA(0, 1), cA + hstep, voffA);
        if (wr == 1) PG8_BAR;
        PG8_WAIT_V(2); PG8_BAR;
        PG8_STAGE(PG8_SB(1, 0), cB + kstep, voffB); PG8_STAGE(PG8_SA(1, 0), cA + kstep, voffA); PG8_STAGE(PG8_SB(1, 1), cB + hstep + kstep, voffB);
        PG8_WAIT_V(6); PG8_BAR;
    } else {
        PG8_STAGE(PG8_SB(0, 0), cB, voffB); PG8_STAGE(PG8_SA(0, 0), cA, voffA); PG8_STAGE(PG8_SB(0, 1), cB + hstep, voffB); PG8_STAGE(PG8_SA(0, 1), cA + hstep, voffA);
        if (wr == 1) PG8_BAR;
        PG8_WAIT_V(4); PG8_BAR;
        PG8_STAGE(PG8_SB(1, 0), cB + kstep, voffB); PG8_STAGE(PG8_SA(1, 0), cA + kstep, voffA); PG8_STAGE(PG8_SB(1, 1), cB + hstep + kstep, voffB);
        PG8_WAIT_V(6); PG8_BAR;
    }
    for (;;) {
        const bool has_next = S.next(ui + 1, nxt);
        const char* nA = has_next ? (const char*)g.A + (size_t)g.atile(nxt.pm) * tstep : cA; const char* nB = has_next ? (const char*)g.Bt + (size_t)nxt.pn * tstep : cB;
        for (int t = 0; t < nt; t += 2) {
            const bool last = (t == nt - 2);
            const char* a1 = cA + (size_t)(t + 1) * kstep;
            const char* a2 = last ? nA : cA + (size_t)(t + 2) * kstep; const char* b2 = last ? nB : cB + (size_t)(t + 2) * kstep;
            const char* a3 = a2 + kstep; const char* b3 = b2 + kstep;
            if (last && has_next) S.a_ready(nxt);
            if constexpr (SP2) {
            PG8_LDB(B0, 0, 0); PG8_LDB(B1, 0, 1); PG8_SCHED; PG8_LDA(At, 0, 0); PG8_STAGE(PG8_SA(1, 1), a1 + hstep, voffA);
            PG8_WAIT_V(8); PG8_WAIT_L(0); PG8_BAR; PG8_MMA(0, 0, At, B0); PG8_MMA(0, 1, At, B1); PG8_BAR; PG8_SCHED;
            PG8_LDA(At, 0, 1); PG8_STAGE(PG8_SB(0, 0), b2, voffB); PG8_STAGE(PG8_SB(0, 1), b2 + hstep, voffB); PG8_STAGE(PG8_SA(0, 0), a2, voffA);
            PG8_WAIT_V(8); PG8_WAIT_L(0); PG8_BAR; PG8_MMA(1, 0, At, B0); PG8_MMA(1, 1, At, B1); PG8_BAR; PG8_SCHED;
            PG8_LDB(B0, 1, 0); PG8_LDB(B1, 1, 1); PG8_SCHED; PG8_LDA(At, 1, 0); PG8_STAGE(PG8_SA(0, 1), a2 + hstep, voffA);
            PG8_WAIT_V(8); PG8_WAIT_L(0); PG8_BAR; PG8_MMA(0, 0, At, B0); PG8_MMA(0, 1, At, B1); PG8_BAR; PG8_SCHED;
            PG8_LDA(At, 1, 1); PG8_STAGE(PG8_SB(1, 0), b3, voffB); PG8_STAGE(PG8_SB(1, 1), b3 + hstep, voffB); PG8_STAGE(PG8_SA(1, 0), a3, voffA);
            PG8_WAIT_V(8); PG8_WAIT_L(0); PG8_BAR; PG8_MMA(1, 0, At, B0); PG8_MMA(1, 1, At, B1); PG8_BAR; PG8_SCHED;
            } else {
            PG8_LDB(B0, 0, 0); PG8_SCHED; PG8_LDA(At, 0, 0); PG8_STAGE(PG8_SA(1, 1), a1 + hstep, voffA);
            PG8_WAIT_L(8); PG8_BAR; PG8_WAIT_L(0); PG8_MMA(0, 0, At, B0); PG8_BAR; PG8_SCHED;
            PG8_LDB(B1, 0, 1); PG8_STAGE(PG8_SB(0, 0), b2, voffB);
            PG8_BAR; PG8_WAIT_L(0); PG8_MMA(0, 1, At, B1); PG8_BAR;
            PG8_LDA(At, 0, 1); PG8_STAGE(PG8_SA(0, 0), a2, voffA);
            PG8_BAR; PG8_WAIT_L(0); PG8_MMA(1, 0, At, B0); PG8_BAR; PG8_SCHED;
            PG8_STAGE(PG8_SB(0, 1), b2 + hstep, voffB);
            PG8_WAIT_V(6); PG8_BAR; PG8_MMA(1, 1, At, B1); PG8_BAR;
            PG8_LDB(B0, 1, 0); PG8_SCHED; PG8_LDA(At, 1, 0); PG8_STAGE(PG8_SA(0, 1), a2 + hstep, voffA);
            PG8_WAIT_L(8); PG8_BAR; PG8_WAIT_L(0); PG8_MMA(0, 0, At, B0); PG8_BAR; PG8_SCHED;
            PG8_LDB(B1, 1, 1); PG8_STAGE(PG8_SB(1, 0), b3, voffB);
            PG8_BAR; PG8_WAIT_L(0); PG8_MMA(0, 1, At, B1); PG8_BAR;
            PG8_LDA(At, 1, 1); PG8_STAGE(PG8_SA(1, 0), a3, voffA);
            PG8_BAR; PG8_WAIT_L(0); PG8_MMA(1, 0, At, B0); PG8_BAR; PG8_SCHED;
            PG8_STAGE(PG8_SB(1, 1), b3 + hstep, voffB);
            PG8_WAIT_V(6); PG8_BAR; PG8_MMA(1, 1, At, B1); PG8_BAR;
            }
        }
        if constexpr (ALIGN_EPI) { if (wr == 0) PG8_BAR; }
        if constexpr (!Epi::AFTER_DRAIN) { E(acc, cur, wr, wc, fr, fq); S.done(cur); }
        if (!has_next) break;
#pragma unroll
        for (int a = 0; a < 2; ++a)
#pragma unroll
            for (int b = 0; b < 2; ++b)
#pragma unroll
                for (int m = 0; m < 4; ++m)
#pragma unroll
                    for (int n = 0; n < 2; ++n) { f32x4 z_; asm volatile("v_mov_b64 %0, 0\n\tv_mov_b64 %1, 0" : "=v"(*(double*)&z_), "=v"(*((double*)&z_ + 1))); acc[a][b][m][n] = z_; }
        cur = nxt; cA = nA; cB = nB; ++ui;
        if constexpr (ALIGN_EPI) { if (wr == 1) PG8_BAR; }
    }
    PG8_WAIT_V(0);
    if constexpr (!ALIGN_EPI) { if (wr == 0) PG8_BAR; }
    PG8_BAR;
    if constexpr (Epi::AFTER_DRAIN) { E.fused(acc, cur, wr, wc, fr, fq, lds, wid, lane); S.done(cur); }
#undef PG8_SA
#undef PG8_SB
#undef PG8_STAGE
#undef PG8_LDA
#undef PG8_LDB
#undef PG8_MMA
#undef PG8_WAIT_V
#undef PG8_WAIT_L
#undef PG8_BAR
#undef PG8_SCHED
}
}

#ifndef PG8_SP2
#define PG8_SP2 true
#endif
#ifndef PG8_ALIGN
#define PG8_ALIGN true
#endif

constexpr int NWAVES = 8;
constexpr int D = 1024, BATCH = 32, SEQ = 2048, M = BATCH * SEQ, DEPTH = 2, NH = 8, HD = 128, DFF = 2816;
constexpr int PROJW = 10256;
constexpr int NPROJ = 10240, WHB = 1280;
constexpr int PW = 8192, HB = 1024;
constexpr int NSEG = 2, SEGT = SEQ / NSEG, SEGROWS = BATCH * SEGT;
constexpr int SEG_SH = (SEGT == 256) ? 0 : (SEGT == 512) ? 1 : 2;
constexpr int FSEG = 2, FROWS = M / FSEG;
constexpr float RMS_EPS = 1e-6f;
constexpr int MODW = 6 * D;

constexpr size_t MiB = 1u << 20;
constexpr size_t WS_CTL = 0, CTL_ZERO_BYTES = 1 * MiB;
constexpr size_t WS_WIN = 2 * MiB;
constexpr size_t WS_WOUT = 42 * MiB;
constexpr size_t WS_WUP = 46 * MiB;
constexpr size_t WS_WDN = 68 * MiB;
constexpr size_t WS_WG = 79 * MiB;
constexpr size_t WS_BIASP = 79 * MiB + 256 * 1024;
constexpr size_t WS_BG = 79 * MiB + 512 * 1024;
constexpr size_t WS_LB = 79 * MiB + 768 * 1024;
constexpr size_t WS_MOD = 80 * MiB;
constexpr size_t WS_GATES = 84 * MiB;
constexpr size_t WS_STC = 88 * MiB;
constexpr size_t WS_STS = 104 * MiB;
constexpr size_t WS_STN = 120 * MiB;
constexpr size_t WS_STM = 121 * MiB;
constexpr size_t WS_HALO = 121 * MiB + 512 * 1024;
constexpr size_t WS_HN = 122 * MiB;
constexpr size_t WS_Y = 250 * MiB;
constexpr size_t WS_P = 378 * MiB;
constexpr size_t P_BYTES = (size_t)SEGROWS * PW * 2;
constexpr size_t WS_G = 250 * MiB;
constexpr size_t WS_S = 620 * MiB;
constexpr size_t WS_END = 890 * MiB;
constexpr int PBUF_MASK = 0;
static_assert(WS_P + (PBUF_MASK + 1) * P_BYTES <= 890 * MiB && WS_G + (size_t)M * DFF * 2 <= WS_S && WS_S + (size_t)(M / 64) * 4 * 2 * DFF * 2 <= WS_END, "ws map");
constexpr int CW_TMO = 0, CW_CODE = 1, CW_BAR = 4096;

constexpr int LDS_BYTES = 160 * 1024;
constexpr int RING_OFF = 0;
constexpr int MISC_OFF = 159 * 1024;

#define GAS __attribute__((address_space(1)))
#define LAS __attribute__((address_space(3)))
typedef unsigned short bf16;
typedef unsigned v4u __attribute__((ext_vector_type(4)));
typedef unsigned v2u __attribute__((ext_vector_type(2)));
typedef float f32x4 __attribute__((ext_vector_type(4)));
typedef short bf16x8 __attribute__((ext_vector_type(8)));
typedef GAS unsigned gu32;
#define RLX_AGENT __ATOMIC_RELAXED, __HIP_MEMORY_SCOPE_AGENT
#define LDS_WAIT() asm volatile("s_waitcnt lgkmcnt(0)" ::: "memory")
#define VM_WAIT() asm volatile("s_waitcnt vmcnt(0)" ::: "memory")
__device__ __forceinline__ unsigned f2bf(float f) { unsigned u = __builtin_bit_cast(unsigned, f); return (u + 0x7fffu + ((u >> 16) & 1u)) >> 16; }
__device__ __forceinline__ unsigned pk2(float lo, float hi) { return f2bf(lo) | (f2bf(hi) << 16); }
__device__ __forceinline__ float bf2f(unsigned short b) { return __builtin_bit_cast(float, ((unsigned)b) << 16); }
__device__ __forceinline__ float sigm(float x) { return 1.f / (1.f + __expf(-x)); }
__device__ __forceinline__ float siluf(float x) { return x / (1.f + __expf(-x)); }
__device__ __forceinline__ float softcap15(float z) { return 15.f * tanhf(z * (1.f / 15.f)); }
__device__ __forceinline__ float logsigm(float z) { return fminf(z, 0.f) - log1pf(expf(-fabsf(z))); }
__device__ __forceinline__ float wave_sum(float v) {
#pragma unroll
    for (int o = 1; o < 64; o <<= 1) v += __shfl_xor(v, o);
    return v;
}

#define PHASE_TID() int tid; asm volatile("v_mbcnt_lo_u32_b32 %0, -1, 0\n\tv_mbcnt_hi_u32_b32 %0, -1, %0" : "=v"(tid)); tid += F.wave_s * 64; const int lane = tid & 63, wave = F.wave_s; (void)lane; (void)wave
#define XB_TMO      128
#define XB_XCNT(j)  (256  + 64 * (j))
#define XB_XSUB(j)  (1280 + 64 * (j))
#define XB_XGEN(j)  (2304 + 64 * (j))
#define XB_TOP      3328
#define XB_TOPGEN   3392
#define XCD_BAR_WORDS 3456
#define XB_SPIN_CAP (1u << 18)

__device__ __forceinline__ unsigned xb_ld(unsigned* p)              { return __hip_atomic_load(p, __ATOMIC_RELAXED, __HIP_MEMORY_SCOPE_AGENT); }
__device__ __forceinline__ unsigned xb_add(unsigned* p, unsigned v) { return __hip_atomic_fetch_add(p, v, __ATOMIC_RELAXED, __HIP_MEMORY_SCOPE_AGENT); }
__device__ __forceinline__ unsigned xb_xcc_id() { return (unsigned)__builtin_amdgcn_s_getreg((3 << 11) | 20) & 0xFu; }
#define XB_SPIN(cond, bar) do { unsigned _sp = 0; while (cond) { __builtin_amdgcn_s_sleep(1); \
    if ((++_sp & 255u) == 0u) { if (xb_ld(&(bar)[XB_TMO])) break; if (_sp > XB_SPIN_CAP) { atomicAdd(&(bar)[XB_TMO], 1u); break; } } } } while (0)

struct XcdBarrier {
    unsigned* bar; unsigned x;
    volatile LAS unsigned* st;
};

__device__ __forceinline__ XcdBarrier xcd_barrier_post(unsigned* bar, volatile LAS unsigned* st) {
    XcdBarrier b; b.bar = bar; b.x = xb_xcc_id(); b.st = st;
    if (threadIdx.x == 0) (void)xb_add(&bar[XB_XCNT(b.x)], 1u);
    return b;
}
__device__ __forceinline__ void xcd_barrier_complete(unsigned* bar, unsigned x, unsigned& nloc, unsigned& nx) {
    const unsigned G = gridDim.x * gridDim.y * gridDim.z;
    unsigned sum, cnt, mine, sp = 0u;
    for (;;) {
        sum = 0u; cnt = 0u; mine = 0u;
#pragma unroll
        for (unsigned j = 0; j < 16; ++j) { const unsigned c = xb_ld(&bar[XB_XCNT(j)]); sum += c; cnt += (c > 0u) ? 1u : 0u; mine = (j == x) ? c : mine; }
        if (sum == G) break;
        __builtin_amdgcn_s_sleep(1);
        if ((++sp & 255u) == 0u) { if (xb_ld(&bar[XB_TMO])) break; if (sp > XB_SPIN_CAP) { atomicAdd(&bar[XB_TMO], 1u); break; } }
    }
    nloc = mine > 0u ? mine : 1u; nx = cnt > 0u ? cnt : 1u;
}

__device__ __forceinline__ void xcd_barrier(const XcdBarrier& b, const bool leader  ) {
    asm volatile("s_waitcnt vmcnt(0)" ::: "memory");
    __syncthreads();
    if (leader) {
        unsigned* bar = b.bar;
        __builtin_amdgcn_s_waitcnt(0);
        unsigned nloc = b.st[0], nx = b.st[1];
        if (nloc == 0u) { xcd_barrier_complete(bar, b.x, nloc, nx); b.st[0] = nloc; b.st[1] = nx; }
        const unsigned old = xb_add(&bar[XB_XSUB(b.x)], 1u);
        const unsigned gen = old / nloc;
        if (old + 1u == (gen + 1u) * nloc) {
            __builtin_amdgcn_fence(__ATOMIC_RELEASE, "agent");
            asm volatile("s_waitcnt vmcnt(0)" ::: "memory");
            const unsigned og = xb_add(&bar[XB_TOP], 1u);
            const unsigned tg = og / nx;
            if (og + 1u == (tg + 1u) * nx) xb_add(&bar[XB_TOPGEN], 1u);
            else XB_SPIN(xb_ld(&bar[XB_TOPGEN]) == tg, bar);
            __builtin_amdgcn_fence(__ATOMIC_ACQUIRE, "agent");
            xb_add(&bar[XB_XGEN(b.x)], 1u);
            asm volatile("s_waitcnt vmcnt(0)" ::: "memory");
        } else {
            XB_SPIN(xb_ld(&bar[XB_XGEN(b.x)]) == gen, bar);
            __builtin_amdgcn_fence(__ATOMIC_ACQUIRE, "agent");
            asm volatile("s_waitcnt vmcnt(0)" ::: "memory");
        }
    }
    __syncthreads();
}

struct Ctx {
    LAS unsigned char* lds;
    int vcu, G, wave_s;
};
struct Args { const float* in[19]; float* out; unsigned char* ws; };
typedef const Args __attribute__((address_space(4))) CArgs;
__device__ __forceinline__ CArgs& getargs() { CArgs* p = (CArgs*)__builtin_amdgcn_kernarg_segment_ptr(); asm volatile("" : "+s"(p)); return *p; }
#define ARGS() CArgs& A = getargs()

struct P0Item { const float* src; bf16* dst; int ldw, K; };
__device__ __forceinline__ void p0_item_load(const P0Item& I, int lane, f32x4 (&v)[8]) {
#pragma unroll
    for (int i = 0; i < 8; ++i) v[i] = *(const GAS f32x4*)(I.src + (size_t)(8 * i + (lane >> 3)) * I.ldw + 4 * (lane & 7));
}
__device__ __forceinline__ void p0_item_store(const P0Item& I, int lane, const f32x4 (&v)[8], LAS float* scr) {
#pragma unroll
    for (int i = 0; i < 8; ++i) { LAS float* d = scr + (8 * i + (lane >> 3)) * 33 + 4 * (lane & 7); d[0] = v[i][0]; d[1] = v[i][1]; d[2] = v[i][2]; d[3] = v[i][3]; }
    LDS_WAIT(); asm volatile("" ::: "memory");
    const int c = lane & 7;
#pragma unroll
    for (int j = 0; j < 4; ++j) { const int n = (lane >> 3) + 8 * j; const LAS float* s = scr + (8 * c) * 33 + n;
        v4u o; o.x = pg8::cvt_pk_bf16(s[0 * 33], s[1 * 33]); o.y = pg8::cvt_pk_bf16(s[2 * 33], s[3 * 33]); o.z = pg8::cvt_pk_bf16(s[4 * 33], s[5 * 33]); o.w = pg8::cvt_pk_bf16(s[6 * 33], s[7 * 33]);
        *(GAS v4u*)(I.dst + (size_t)n * I.K + 8 * c) = o; }
    LDS_WAIT(); asm volatile("" ::: "memory");
}
__device__ __forceinline__ int in_src_col(int dstrow) {
    const int h = dstrow / WHB, rem = dstrow - h * WHB, blk = rem >> 7, j = rem & 127;
    int base;
    switch (blk) { case 0: base = 0; break; case 1: base = 1024; break; case 2: base = 2048; break; case 3: base = 6160; break; case 4: base = 4112; break;
                   case 5: base = 5136; break; case 6: base = 3072; break; case 7: base = 8208; break; case 8: base = 7184; break; default: base = 9232; break; }
    return base + h * 128 + j;
}
__device__ __forceinline__ void p0_prologue(Ctx& F) {
    PHASE_TID();
    ARGS();
    LAS float* scr = (LAS float*)(F.lds + wave * 16384);
    const int gw = F.vcu * NWAVES + wave, NGW = F.G * NWAVES;
    constexpr int I_IN = 320 * 16, I_OUT = 32 * 16, I_UP = 176 * 16, I_DN = 32 * 44, I_L = I_IN + I_OUT + I_UP + I_DN;
    auto item_of = [&](int it) {
        asm volatile("" : "+v"(it));
        P0Item I; const int l = it / I_L; int r = it - l * I_L;
        if (r < I_IN) { const int rg = r >> 4, kb = r & 15; I.ldw = PROJW; I.K = D; I.src = A.in[5] + (size_t)l * D * PROJW + (size_t)(64 * kb) * PROJW + in_src_col(32 * rg); I.dst = (bf16*)(A.ws + WS_WIN) + (size_t)l * NPROJ * D + (size_t)(32 * rg) * D + 64 * kb; return I; } r -= I_IN;
        if (r < I_OUT) { const int rg = r >> 4, kb = r & 15; I.ldw = D; I.K = D; I.src = A.in[12] + (size_t)l * D * D + (size_t)(64 * kb) * D + 32 * rg; I.dst = (bf16*)(A.ws + WS_WOUT) + (size_t)l * D * D + (size_t)(32 * rg) * D + 64 * kb; return I; } r -= I_OUT;
        if (r < I_UP) { const int rg = r >> 4, kb = r & 15; const int row0 = 32 * rg, pn = row0 >> 8, half = (row0 >> 7) & 1, j0 = row0 & 127; I.ldw = 2 * DFF; I.K = D;
            I.src = A.in[14] + (size_t)l * D * 2 * DFF + (size_t)(64 * kb) * (2 * DFF) + half * DFF + pn * 128 + j0; I.dst = (bf16*)(A.ws + WS_WUP) + (size_t)l * 2 * DFF * D + (size_t)row0 * D + 64 * kb; return I; } r -= I_UP;
        { const int rg = r / 44, kb = r - rg * 44; I.ldw = D; I.K = DFF; I.src = A.in[17] + (size_t)l * DFF * D + (size_t)(64 * kb) * D + 32 * rg; I.dst = (bf16*)(A.ws + WS_WDN) + (size_t)l * D * DFF + (size_t)(32 * rg) * DFF + 64 * kb; return I; }
    };
    {
        f32x4 va[8], vb[8]; int it = gw;
        P0Item Ia = item_of(it < 2 * I_L ? it : 0), Ib = Ia;
        if (it < 2 * I_L) p0_item_load(Ia, lane, va);
        while (it < 2 * I_L) {
            const int itb = it + NGW, itc = itb + NGW;
            if (itb < 2 * I_L) { Ib = item_of(itb); p0_item_load(Ib, lane, vb); }
            p0_item_store(Ia, lane, va, scr);
            if (itb >= 2 * I_L) break;
            if (itc < 2 * I_L) { Ia = item_of(itc); p0_item_load(Ia, lane, va); }
            p0_item_store(Ib, lane, vb, scr);
            it = itc;
        }
    }
    const int gt = F.vcu * (NWAVES * 64) + tid, NGT = F.G * NWAVES * 64;
    float* wg = (float*)(A.ws + WS_WG); float* biasp = (float*)(A.ws + WS_BIASP); float* bg = (float*)(A.ws + WS_BG); float* lb = (float*)(A.ws + WS_LB);
    for (int i = gt; i < 2 * D * 16; i += NGT) { const int g = i & 15, k = (i >> 4) & (D - 1), l = i >> 14; wg[(size_t)(l * 16 + g) * D + k] = A.in[5][((size_t)l * D + k) * PROJW + 4096 + g]; }
    for (int i = gt; i < 2 * NPROJ; i += NGT) { const int l = i / NPROJ, c = i - l * NPROJ; biasp[i] = A.in[6][(size_t)l * PROJW + in_src_col(c)]; }
    for (int i = gt; i < 32; i += NGT) { const int l = i >> 4, g = i & 15; bg[i] = A.in[6][(size_t)l * PROJW + 4096 + g]; }
    for (int i = gt; i < D; i += NGT) { const float z0 = A.in[10][i], z1 = A.in[10][D + i]; lb[i] = 1.f / (1.f + expf(z0 - z1)); }
    __syncthreads();
    for (int wgi = F.vcu; wgi < 2 * (MODW / 64); wgi += F.G) {
        constexpr int CS = D + 8;
        LAS unsigned short* chi = (LAS unsigned short*)F.lds; LAS unsigned short* clo = chi + BATCH * CS;
        LAS float* part = (LAS float*)(F.lds + 2 * BATCH * CS * 2);
#pragma unroll 1
        for (int it = 0; it < 2; ++it) {
            f32x4 cv[8];
#pragma unroll
            for (int j = 0; j < 8; ++j) cv[j] = ((const GAS f32x4*)A.in[1])[tid + NWAVES * 64 * (8 * it + j)];
#pragma unroll
            for (int j = 0; j < 8; ++j) { const int i4 = (tid + NWAVES * 64 * (8 * it + j)) * 4, bb = i4 >> 10, kk = i4 & (D - 1);
                unsigned hw[4], lw[4];
#pragma unroll
                for (int e = 0; e < 4; ++e) { const float v = siluf(cv[j][e]); hw[e] = f2bf(v); lw[e] = f2bf(v - bf2f((unsigned short)hw[e])); }
                *(LAS v2u*)(chi + bb * CS + kk) = (v2u){hw[0] | (hw[1] << 16), hw[2] | (hw[3] << 16)}; *(LAS v2u*)(clo + bb * CS + kk) = (v2u){lw[0] | (lw[1] << 16), lw[2] | (lw[3] << 16)}; }
        }
        __syncthreads();
        const int l = wgi / (MODW / 64), cg = wgi - l * (MODW / 64), cq = wave & 3, kh = wave >> 2, r = lane & 15, q = lane >> 4;
        const float* aw = A.in[2] + (size_t)l * D * MODW + (size_t)(kh * 512 + 8 * q) * MODW + cg * 64 + cq * 16 + r;
        f32x4 acc[2] = {(f32x4){0.f, 0.f, 0.f, 0.f}, (f32x4){0.f, 0.f, 0.f, 0.f}};
#pragma unroll 1
        for (int kc = 0; kc < 4; ++kc) {
            float wv[4][8];
#pragma unroll
            for (int ks = 0; ks < 4; ++ks)
#pragma unroll
                for (int e = 0; e < 8; ++e) wv[ks][e] = aw[(size_t)(128 * kc + 32 * ks + e) * MODW];
#pragma unroll
            for (int ks = 0; ks < 4; ++ks) {
                bf16x8 ahi, alo;
#pragma unroll
                for (int e = 0; e < 8; ++e) { const unsigned short hb = (unsigned short)f2bf(wv[ks][e]); ahi[e] = (short)hb; alo[e] = (short)f2bf(wv[ks][e] - bf2f(hb)); }
                const int k0 = kh * 512 + 128 * kc + 32 * ks + 8 * q;
#pragma unroll
                for (int bt = 0; bt < 2; ++bt) {
                    const bf16x8 bhi = *(const LAS bf16x8*)(chi + (16 * bt + r) * CS + k0), blo = *(const LAS bf16x8*)(clo + (16 * bt + r) * CS + k0);
                    acc[bt] = __builtin_amdgcn_mfma_f32_16x16x32_bf16(ahi, bhi, acc[bt], 0, 0, 0);
                    acc[bt] = __builtin_amdgcn_mfma_f32_16x16x32_bf16(ahi, blo, acc[bt], 0, 0, 0);
                    acc[bt] = __builtin_amdgcn_mfma_f32_16x16x32_bf16(alo, bhi, acc[bt], 0, 0, 0);
                }
            }
        }
#pragma unroll
        for (int bt = 0; bt < 2; ++bt) *(LAS f32x4*)(part + (kh * 32 + 16 * bt + r) * 64 + cq * 16 + 4 * q) = acc[bt];
        __syncthreads();
        float* mod = (float*)(A.ws + WS_MOD);
        for (int o = tid; o < 32 * 64; o += NWAVES * 64) { const int bb = o >> 6, c = o & 63;
            mod[((size_t)l * BATCH + bb) * MODW + cg * 64 + c] = (part[bb * 64 + c] + part[(32 + bb) * 64 + c]) + A.in[3][(size_t)l * MODW + cg * 64 + c]; }
        __syncthreads();
    }
}

__device__ __forceinline__ float reduce16(float (&v)[16], int lane) {
#define R16_STEP(S, MSK) { const bool up = (lane & (MSK)) != 0; _Pragma("unroll") for (int i = 0; i < (S); ++i) { const float keep = up ? v[i + (S)] : v[i], send = up ? v[i] : v[i + (S)]; v[i] = keep + __shfl_xor(send, (MSK)); } }
    R16_STEP(8, 32) R16_STEP(4, 16) R16_STEP(2, 8) R16_STEP(1, 4)
#undef R16_STEP
    float r = v[0]; r += __shfl_xor(r, 1); r += __shfl_xor(r, 2); return r;
}
template <bool GATES>
__device__ __forceinline__ void norm_phase(Ctx& F, const float* src, const float* nw, const float* modl, int shift_off, int scale_off, bf16* hn, float* gates, const float* wgl, const float* bgl) {
    PHASE_TID();
    LAS float* wgs = (LAS float*)F.lds;
    if (GATES) { for (int i = tid; i < 16 * D / 4; i += NWAVES * 64) ((LAS f32x4*)wgs)[i] = ((const f32x4*)wgl)[i]; __syncthreads(); }
    const int gw = F.vcu * NWAVES + wave, NGW = F.G * NWAVES;
    f32x4 w[4];
#pragma unroll
    for (int j = 0; j < 4; ++j) w[j] = *(const f32x4*)(nw + 256 * j + 4 * lane);
    for (int item = gw; item < M / 32; item += NGW) {
        const int row0 = item * 32, b = row0 >> 11;
        f32x4 sc[4], sh[4];
#pragma unroll
        for (int j = 0; j < 4; ++j) { sc[j] = *(const f32x4*)(modl + (size_t)b * MODW + scale_off + 256 * j + 4 * lane); sh[j] = *(const f32x4*)(modl + (size_t)b * MODW + shift_off + 256 * j + 4 * lane);
            sc[j] = (sc[j] + 1.0f) * w[j]; }
        f32x4 xn[4];
#pragma unroll
        for (int j = 0; j < 4; ++j) xn[j] = *(const GAS f32x4*)(src + (size_t)row0 * D + 256 * j + 4 * lane);
        for (int r = 0; r < 32; ++r) {
            asm volatile("" ::: "memory");
            f32x4 x[4];
#pragma unroll
            for (int j = 0; j < 4; ++j) x[j] = xn[j];
            if (r + 1 < 32) {
#pragma unroll
                for (int j = 0; j < 4; ++j) xn[j] = *(const GAS f32x4*)(src + (size_t)(row0 + r + 1) * D + 256 * j + 4 * lane);
            }
            float ss = 0.f;
#pragma unroll
            for (int j = 0; j < 4; ++j) ss += (x[j].x * x[j].x + x[j].y * x[j].y) + (x[j].z * x[j].z + x[j].w * x[j].w);
            const float rstd = rsqrtf(wave_sum(ss) * (1.f / D) + RMS_EPS);
#pragma unroll
            for (int j = 0; j < 4; ++j) x[j] = x[j] * rstd * sc[j] + sh[j];
            GAS unsigned long long* o8 = (GAS unsigned long long*)(hn + (size_t)(row0 + r) * D) + lane;
#pragma unroll
            for (int j = 0; j < 4; ++j) o8[64 * j] = (unsigned long long)pk2(x[j].x, x[j].y) | ((unsigned long long)pk2(x[j].z, x[j].w) << 32);
            if (GATES) {
                float a[16];
#pragma unroll
                for (int g = 0; g < 16; ++g) { float s = 0.f;
#pragma unroll
                    for (int j = 0; j < 4; ++j) { const f32x4 wv = *(const LAS f32x4*)(wgs + g * D + 256 * j + 4 * lane); s += (x[j].x * wv.x + x[j].y * wv.y) + (x[j].z * wv.z + x[j].w * wv.w); }
                    a[g] = s; }
                const float tot = reduce16(a, lane);
                const int g = ((lane >> 5) & 1) * 8 + ((lane >> 4) & 1) * 4 + ((lane >> 3) & 1) * 2 + ((lane >> 2) & 1);
                if ((lane & 3) == 0) gates[(size_t)(row0 + r) * 16 + g] = tot + bgl[g];
            }
        }
    }
}

__device__ __forceinline__ void norm_gates_phase(Ctx& F, const float* src, const float* nw, const float* modl, int shift_off, int scale_off, bf16* hn, float* gates, const float* wgl, const float* bgl) {
    PHASE_TID();
    constexpr int RS = 2064;
    LAS unsigned char* tA = F.lds;
    LAS unsigned char* tB = F.lds + 2 * 16 * RS;
    LAS float* part = (LAS float*)(F.lds + 3 * 16 * RS);
    for (int i = tid; i < 16 * 256; i += NWAVES * 64) { const int g = i >> 8, k4 = i & 255; const f32x4 w4 = *(const f32x4*)(wgl + g * D + 4 * k4);
        *(LAS v2u*)(tB + g * RS + 8 * k4) = (v2u){pg8::cvt_pk_bf16(w4[0], w4[1]), pg8::cvt_pk_bf16(w4[2], w4[3])}; }
    f32x4 w[4];
#pragma unroll
    for (int j = 0; j < 4; ++j) w[j] = *(const f32x4*)(nw + 256 * j + 4 * lane);
    const int r = lane & 15, q = lane >> 4;
    for (int wgi = F.vcu; wgi < M / 256; wgi += F.G) {
        const int rowb = wgi * 256, b = rowb >> 11;
        f32x4 sc[4], sh[4];
#pragma unroll
        for (int j = 0; j < 4; ++j) { sc[j] = *(const f32x4*)(modl + (size_t)b * MODW + scale_off + 256 * j + 4 * lane); sh[j] = *(const f32x4*)(modl + (size_t)b * MODW + shift_off + 256 * j + 4 * lane);
            sc[j] = (sc[j] + 1.0f) * w[j]; }
        f32x4 xn[2][4];
#pragma unroll
        for (int rr = 0; rr < 2; ++rr)
#pragma unroll
            for (int j = 0; j < 4; ++j) xn[rr][j] = *(const GAS f32x4*)(src + (size_t)(rowb + 2 * wave + rr) * D + 256 * j + 4 * lane);
        for (int R = 0; R < 16; ++R) {
            const int row0 = rowb + 16 * R; LAS unsigned char* tAr = tA + (R & 1) * 16 * RS;
            f32x4 x[2][4];
#pragma unroll
            for (int rr = 0; rr < 2; ++rr)
#pragma unroll
                for (int j = 0; j < 4; ++j) x[rr][j] = xn[rr][j];
            if (R + 1 < 16) {
#pragma unroll
                for (int rr = 0; rr < 2; ++rr)
#pragma unroll
                    for (int j = 0; j < 4; ++j) xn[rr][j] = *(const GAS f32x4*)(src + (size_t)(row0 + 16 + 2 * wave + rr) * D + 256 * j + 4 * lane);
            }
#pragma unroll
            for (int rr = 0; rr < 2; ++rr) {
                float ss = 0.f;
#pragma unroll
                for (int j = 0; j < 4; ++j) ss += (x[rr][j].x * x[rr][j].x + x[rr][j].y * x[rr][j].y) + (x[rr][j].z * x[rr][j].z + x[rr][j].w * x[rr][j].w);
                const float rstd = rsqrtf(wave_sum(ss) * (1.f / D) + RMS_EPS);
                GAS unsigned long long* o8 = (GAS unsigned long long*)(hn + (size_t)(row0 + 2 * wave + rr) * D) + lane;
#pragma unroll
                for (int j = 0; j < 4; ++j) { const f32x4 hv = x[rr][j] * rstd * sc[j] + sh[j];
                    const v2u pk = (v2u){pg8::cvt_pk_bf16(hv.x, hv.y), pg8::cvt_pk_bf16(hv.z, hv.w)};
                    o8[64 * j] = (unsigned long long)pk.x | ((unsigned long long)pk.y << 32);
                    *(LAS v2u*)(tAr + (2 * wave + rr) * RS + (256 * j + 4 * lane) * 2) = pk; }
            }
            __syncthreads();
            f32x4 acc = (f32x4){0.f, 0.f, 0.f, 0.f};
#pragma unroll
            for (int ks = 0; ks < 4; ++ks) { const int kb = (128 * wave + 32 * ks + 8 * q) * 2;
                acc = __builtin_amdgcn_mfma_f32_16x16x32_bf16(*(const LAS bf16x8*)(tAr + r * RS + kb), *(const LAS bf16x8*)(tB + r * RS + kb), acc, 0, 0, 0); }
            *(LAS f32x4*)(part + wave * 256 + 64 * q + 4 * r) = acc;
            __syncthreads();
            if (tid < 256) { const int g = tid >> 4, rq = tid & 15;
                float s = bgl[g];
#pragma unroll
                for (int w8 = 0; w8 < 8; ++w8) s += part[w8 * 256 + 64 * (rq >> 2) + 4 * g + (rq & 3)];
                gates[(size_t)(row0 + rq) * 16 + g] = s; }
        }
        __syncthreads();
    }
}
__device__ __forceinline__ void final_norm_phase(Ctx& F, float* x, const float* nw) {
    PHASE_TID();
    const int gw = F.vcu * NWAVES + wave, NGW = F.G * NWAVES;
    f32x4 w[4];
#pragma unroll
    for (int j = 0; j < 4; ++j) w[j] = *(const f32x4*)(nw + 256 * j + 4 * lane);
    for (int row = gw; row < M; row += NGW) {
        GAS f32x4* xr = (GAS f32x4*)(x + (size_t)row * D) + lane;
        f32x4 v[4]; float ss = 0.f;
#pragma unroll
        for (int j = 0; j < 4; ++j) { v[j] = xr[64 * j]; ss += (v[j].x * v[j].x + v[j].y * v[j].y) + (v[j].z * v[j].z + v[j].w * v[j].w); }
        const float rstd = rsqrtf(wave_sum(ss) * (1.f / D) + RMS_EPS);
#pragma unroll
        for (int j = 0; j < 4; ++j) xr[64 * j] = v[j] * rstd * w[j];
    }
}

__device__ __forceinline__ void unpack8(const v4u& v, float (&o)[8]) {
#pragma unroll
    for (int e = 0; e < 4; ++e) { o[2 * e] = bf2f((unsigned short)(v[e] & 0xffffu)); o[2 * e + 1] = bf2f((unsigned short)(v[e] >> 16)); }
}
__device__ __forceinline__ void ffn_glu_phase(Ctx& F, const bf16* u, bf16* g, const float* cw, const float* cb) {
    PHASE_TID();
    constexpr int RB = 16, NCH = DFF / 8, NRB = FROWS / RB;
    const int gt = F.vcu * (NWAVES * 64) + tid, NGT = F.G * NWAVES * 64;
    for (int it = gt; it < NRB * NCH; it += NGT) {
        const int rb = it / NCH, ch = it - rb * NCH, f0 = ch * 8, row0 = rb * RB;
        const int cg0 = (f0 >> 7) * 256 + (f0 & 127);
        float wg_[3][8], wv_[3][8], bgv[8], bvv[8];
#pragma unroll
        for (int j = 0; j < 3; ++j)
#pragma unroll
            for (int e = 0; e < 8; ++e) { wg_[j][e] = cw[(size_t)j * 2 * DFF + f0 + e]; wv_[j][e] = cw[(size_t)j * 2 * DFF + DFF + f0 + e]; }
#pragma unroll
        for (int e = 0; e < 8; ++e) { bgv[e] = cb[f0 + e]; bvv[e] = cb[DFF + f0 + e]; }
        float g1[8], g2[8], v1[8], v2[8];
        const int t0 = row0 & (SEQ - 1);
#pragma unroll
        for (int e = 0; e < 8; ++e) { g1[e] = g2[e] = v1[e] = v2[e] = 0.f; }
        if (t0 >= 2) {
            const v4u a1 = *(const GAS v4u*)(u + (size_t)(row0 - 1) * 2 * DFF + cg0), a2 = *(const GAS v4u*)(u + (size_t)(row0 - 2) * 2 * DFF + cg0);
            const v4u b1 = *(const GAS v4u*)(u + (size_t)(row0 - 1) * 2 * DFF + cg0 + 128), b2 = *(const GAS v4u*)(u + (size_t)(row0 - 2) * 2 * DFF + cg0 + 128);
#pragma unroll
            for (int e = 0; e < 4; ++e) { g1[2 * e] = bf2f(a1[e] & 0xffff); g1[2 * e + 1] = bf2f(a1[e] >> 16); g2[2 * e] = bf2f(a2[e] & 0xffff); g2[2 * e + 1] = bf2f(a2[e] >> 16);
                v1[2 * e] = bf2f(b1[e] & 0xffff); v1[2 * e + 1] = bf2f(b1[e] >> 16); v2[2 * e] = bf2f(b2[e] & 0xffff); v2[2 * e + 1] = bf2f(b2[e] >> 16); }
        }
        for (int r = 0; r < RB; ++r) {
            const v4u a0 = *(const GAS v4u*)(u + (size_t)(row0 + r) * 2 * DFF + cg0), b0 = *(const GAS v4u*)(u + (size_t)(row0 + r) * 2 * DFF + cg0 + 128);
            float g0[8], v0[8], o[8];
#pragma unroll
            for (int e = 0; e < 4; ++e) { g0[2 * e] = bf2f(a0[e] & 0xffff); g0[2 * e + 1] = bf2f(a0[e] >> 16); v0[2 * e] = bf2f(b0[e] & 0xffff); v0[2 * e + 1] = bf2f(b0[e] >> 16); }
#pragma unroll
            for (int e = 0; e < 8; ++e) { const float cgv = bgv[e] + wg_[2][e] * g0[e] + wg_[1][e] * g1[e] + wg_[0][e] * g2[e]; const float cvv = bvv[e] + wv_[2][e] * v0[e] + wv_[1][e] * v1[e] + wv_[0][e] * v2[e];
                o[e] = siluf(cgv) * cvv; g2[e] = g1[e]; g1[e] = g0[e]; v2[e] = v1[e]; v1[e] = v0[e]; }
            v4u w; w.x = pk2(o[0], o[1]); w.y = pk2(o[2], o[3]); w.z = pk2(o[4], o[5]); w.w = pk2(o[6], o[7]);
            *(GAS v4u*)(g + (size_t)(row0 + r) * DFF + f0) = w;
        }
    }
}

__device__ __forceinline__ void ffn_fix_phase(Ctx& F, const bf16* S, bf16* G, const float* cw, const float* cb) {
    PHASE_TID();
    constexpr int NCH = DFF / 8, NG = M / 64;
    const int gt = F.vcu * (NWAVES * 64) + tid, NGT = F.G * NWAVES * 64;
    for (int it = gt; it < NG * NCH; it += NGT) {
        const int g64 = it / NCH, ch = it - g64 * NCH, f0 = ch * 8, col = (f0 >> 7) * 256 + (f0 & 127);
        const bool first = (g64 & 31) == 0;
        float c0g[8], c0v[8], c1g[8], c1v[8], p2g[8], p2v[8], p3g[8], p3v[8];
        { const bf16* sp = S + (size_t)g64 * 4 * (2 * DFF) + col;
          const v4u a = *(const GAS v4u*)sp, b = *(const GAS v4u*)(sp + 128), c = *(const GAS v4u*)(sp + 2 * DFF), d = *(const GAS v4u*)(sp + 2 * DFF + 128);
          unpack8(a, c0g); unpack8(b, c0v); unpack8(c, c1g); unpack8(d, c1v); }
        if (!first) { const bf16* sp = S + ((size_t)(g64 - 1) * 4 + 2) * (2 * DFF) + col;
          const v4u a = *(const GAS v4u*)sp, b = *(const GAS v4u*)(sp + 128), c = *(const GAS v4u*)(sp + 2 * DFF), d = *(const GAS v4u*)(sp + 2 * DFF + 128);
          unpack8(a, p2g); unpack8(b, p2v); unpack8(c, p3g); unpack8(d, p3v); }
        else {
#pragma unroll
            for (int e = 0; e < 8; ++e) { p2g[e] = p2v[e] = p3g[e] = p3v[e] = 0.f; } }
        float o0[8], o1[8];
#pragma unroll
        for (int e = 0; e < 8; ++e) {
            const float wg0 = cw[f0 + e], wg1 = cw[2 * DFF + f0 + e], wg2 = cw[4 * DFF + f0 + e], wv0 = cw[DFF + f0 + e], wv1 = cw[3 * DFF + f0 + e], wv2 = cw[5 * DFF + f0 + e], bg = cb[f0 + e], bv = cb[DFF + f0 + e];
            const float g0 = bg + wg2 * c0g[e] + wg1 * p3g[e] + wg0 * p2g[e], v0 = bv + wv2 * c0v[e] + wv1 * p3v[e] + wv0 * p2v[e];
            const float g1 = bg + wg2 * c1g[e] + wg1 * c0g[e] + wg0 * p3g[e], v1 = bv + wv2 * c1v[e] + wv1 * c0v[e] + wv0 * p3v[e];
            o0[e] = siluf(g0) * v0; o1[e] = siluf(g1) * v1;
        }
        v4u w0, w1; w0.x = pk2(o0[0], o0[1]); w0.y = pk2(o0[2], o0[3]); w0.z = pk2(o0[4], o0[5]); w0.w = pk2(o0[6], o0[7]); w1.x = pk2(o1[0], o1[1]); w1.y = pk2(o1[2], o1[3]); w1.z = pk2(o1[4], o1[5]); w1.w = pk2(o1[6], o1[7]);
        *(GAS v4u*)(G + (size_t)(g64 * 64) * DFF + f0) = w0; *(GAS v4u*)(G + (size_t)(g64 * 64 + 1) * DFF + f0) = w1;
    }
}

constexpr int IMG_QM = 0, IMG_KM = 16384, IMG_VM = 32768, IMG_P = 49152, IMG_HQT = 57344, IMG_HKT = 73728, IMG_HV = 90112, PH_OFF = 106496, MF_OFF = 110592, HAB_OFF = 130048, OBB_OFF = 146432;
constexpr int MF_N = 0, MF_DFL = 128, MF_QN = 192, MF_RS = 256, MF_NRED = 384, MF_E7 = 1408, MF_E157 = 1920, MF_CW = 2432, MF_WN = 3712, MF_S0 = 3968  , MF_G = 4288  , MF_END = 4672;
static_assert(MF_OFF + MF_END * 4 <= HAB_OFF && OBB_OFF + 16384 <= MISC_OFF, "mixer LDS map");
constexpr int PO_MQ = 0, PO_MK = 128, PO_MV = 256, PO_HI = 384, PO_HQ = 512, PO_HF = 640, PO_CA = 768, PO_CB = 896;
typedef short s16x4 __attribute__((ext_vector_type(4)));
typedef short v4i16_t __attribute__((ext_vector_type(4)));
__device__ __forceinline__ unsigned offb(unsigned row, unsigned ch) { return 256u * row + 16u * (ch ^ (((row & 3u) << 2) | ((row >> 2) & 3u))); }
__device__ __forceinline__ bf16x8 ld16(LAS unsigned char* p) { return *(const LAS bf16x8*)p; }
__device__ __forceinline__ s16x4 ld8(LAS unsigned char* p) { return *(const LAS s16x4*)p; }
__device__ __forceinline__ s16x4 ldtr(LAS unsigned char* p) { return __builtin_bit_cast(s16x4, __builtin_amdgcn_ds_read_tr16_b64_v4i16((LAS v4i16_t*)p)); }
__device__ __forceinline__ bf16x8 cat8(s16x4 a, s16x4 b) { bf16x8 r; r[0] = a[0]; r[1] = a[1]; r[2] = a[2]; r[3] = a[3]; r[4] = b[0]; r[5] = b[1]; r[6] = b[2]; r[7] = b[3]; return r; }
__device__ __forceinline__ bf16x8 frag_row(LAS unsigned char* img, int row0, int ks, int lane) { return ld16(img + offb(row0 + (lane & 15), 4 * ks + (lane >> 4))); }
struct RowAddr { unsigned rb, rx; };
__device__ __forceinline__ RowAddr make_row_addr(int lane) { const unsigned r = lane & 15, q = lane >> 4; RowAddr a; a.rb = 256u * r; a.rx = 16u * (q ^ (((r & 3u) << 2) | ((r >> 2) & 3u))); return a; }
__device__ __forceinline__ bf16x8 frag_row2(LAS unsigned char* img, int row0, int ks, const RowAddr& a) { return ld16(img + 256 * row0 + (a.rb + (a.rx ^ (64u * ks)))); }
struct FragAddr { unsigned tb, tx0, tx1, hb0, hb1, hx0, hx1, qb, qy; };
__device__ __forceinline__ FragAddr make_frag_addr(int lane) {
    FragAddr f; const unsigned g = lane >> 4, qq = (lane & 15) >> 2, p = lane & 3, pb = p >> 1, r = lane & 15, q = lane >> 4;
    auto xs = [](unsigned row) { return ((row & 3u) << 2) | ((row >> 2) & 3u); };
    const unsigned ra = 8 * g + qq;
    f.tb = 256u * ra + 8u * (p & 1); f.tx0 = 16u * (pb ^ xs(ra)); f.tx1 = 16u * (pb ^ xs(ra + 4));
    const unsigned h0 = ra & 15u, h1 = (ra + 4) & 15u;
    f.hb0 = 256u * h0 + 8u * (p & 1); f.hb1 = 256u * h1 + 8u * (p & 1); f.hx0 = 16u * (pb ^ xs(h0)); f.hx1 = 16u * (pb ^ xs(h1));
    f.qb = 256u * r + 8u * (q & 1); f.qy = (16u * (q >> 1)) ^ (16u * xs(r));
    return f;
}
__device__ __forceinline__ bf16x8 frag_tr31(LAS unsigned char* img, int row0, int c, const FragAddr& f) {
    return cat8(ldtr(img + 256 * row0 + (f.tb + (f.tx0 ^ (32u * c)))), ldtr(img + 256 * row0 + 1024 + (f.tb + (f.tx1 ^ (32u * c)))));
}
__device__ __forceinline__ bf16x8 frag_tr15(LAS unsigned char* img, int row0, int c, const FragAddr& f) {
    return cat8(ldtr(img + 256 * row0 + (f.hb0 + (f.hx0 ^ (32u * c)))), ldtr(img + 256 * row0 + (f.hb1 + (f.hx1 ^ (32u * c)))));
}
__device__ __forceinline__ bf16x8 frag_q2(LAS unsigned char* img, int row0, int ks, const FragAddr& f) {
    return cat8(ld8(img + 256 * row0 + (f.qb + ((64u * ks) ^ f.qy))), ld8(img + 256 * row0 + (f.qb + ((64u * ks + 32u) ^ f.qy))));
}
__device__ __forceinline__ bf16x8 pack_acc(const f32x4& lo, const f32x4& hi) {
    v4u w; w.x = pg8::cvt_pk_bf16(lo[0], lo[1]); w.y = pg8::cvt_pk_bf16(lo[2], lo[3]); w.z = pg8::cvt_pk_bf16(hi[0], hi[1]); w.w = pg8::cvt_pk_bf16(hi[2], hi[3]);
    return __builtin_bit_cast(bf16x8, w);
}
__device__ __forceinline__ f32x4 mfma16(const bf16x8& a, const bf16x8& b, const f32x4& c) { return __builtin_amdgcn_mfma_f32_16x16x32_bf16(a, b, c, 0, 0, 0); }
__device__ __forceinline__ float rcpf_(float x) { return __builtin_amdgcn_rcpf(x); }
__device__ __forceinline__ float sigf(float x) { return rcpf_(1.f + __expf(-x)); }
__device__ __forceinline__ float silf(float x) { return x * rcpf_(1.f + __expf(-x)); }
__device__ __forceinline__ unsigned pkbf(float lo, float hi) { return pg8::cvt_pk_bf16(lo, hi); }
typedef __bf16 bf16x2_t __attribute__((ext_vector_type(2)));
__device__ __forceinline__ float dot2bf(unsigned a, unsigned b, float c) { return __builtin_amdgcn_fdot2_f32_bf16(__builtin_bit_cast(bf16x2_t, a), __builtin_bit_cast(bf16x2_t, b), c, false); }

#define MX_DPPF(v, ctrl) __builtin_bit_cast(float, __builtin_amdgcn_update_dpp(0, __builtin_bit_cast(int, (float)(v)), ctrl, 0xf, 0xf, false))
__device__ __forceinline__ float sum8_dpp(float x) { x += MX_DPPF(x, 0xB1); x += MX_DPPF(x, 0x4E); x += MX_DPPF(x, 0x141); return x; }
#define LN_FRESH(name) int name = lane; asm volatile("" : "+v"(name))
template <bool DRY>
__device__ __forceinline__ void mixer_fast_phase(Ctx& F, int layer, int seg) {
    PHASE_TID();
    ARGS();
    const bf16* Pcur = (const bf16*)(A.ws + WS_P + (size_t)(seg & PBUF_MASK) * P_BYTES);
    bf16* Halo = (bf16*)(A.ws + WS_HALO);
    const float* gates = (const float*)(A.ws + WS_GATES);
    const float* lbp = (const float*)(A.ws + WS_LB);
    bf16* Y = (bf16*)(A.ws + WS_Y);
    float* stC = (float*)(A.ws + WS_STC); float* stS = (float*)(A.ws + WS_STS); float* stN = (float*)(A.ws + WS_STN); float* stM = (float*)(A.ws + WS_STM);
    const float* cw = A.in[7] + (size_t)layer * 4 * 2048; const float* cb = A.in[8] + (size_t)layer * 2048;
    LAS unsigned char* L = F.lds;
    LAS float* MF = (LAS float*)(L + MF_OFF);
    for (int bhi = blockIdx.x; bhi < BATCH * NH; bhi += F.G) {
        const int bh = pg8::wg_bh(bhi), b = bh >> 3, h = bh & 7;
        { int l_; asm volatile("v_mbcnt_lo_u32_b32 %0, -1, 0\n\tv_mbcnt_hi_u32_b32 %0, -1, %0" : "=v"(l_)); tid = wave * 64 + l_; }
        for (int i = tid; i < 768; i += NWAVES * 64) { const int blk = i / 384, kind = (i % 384) >> 7, e = i & 127, cc = blk * 1024 + h * 128 + e;
            ((LAS unsigned*)(MF + MF_CW))[i] = kind < 2 ? pkbf(cw[(size_t)(2 * kind) * 2048 + cc], cw[(size_t)(2 * kind + 1) * 2048 + cc]) : __builtin_bit_cast(unsigned, cb[cc]); }
        for (int i = tid; i < 1024; i += NWAVES * 64) ((LAS unsigned*)(L + PH_OFF))[i] = 0u;
        if (tid < 128) MF[MF_WN + tid] = A.in[9][(size_t)layer * D + h * 128 + tid];
        if (tid >= 128 && tid < 256) MF[MF_WN + tid] = A.in[11][(size_t)layer * D + h * 128 + tid - 128];
        f32x4 Cacc[8], Sacc[8]; float mst;
        if (seg == 0) {
#pragma unroll
            for (int mb = 0; mb < 8; ++mb) { Cacc[mb] = (f32x4){0.f, 0.f, 0.f, 0.f}; Sacc[mb] = (f32x4){0.f, 0.f, 0.f, 0.f}; }
            mst = 0.f; if (tid < 128) MF[MF_N + tid] = 0.f;
        } else {
            int lane_l; asm volatile("v_mbcnt_lo_u32_b32 %0, -1, 0\n\tv_mbcnt_hi_u32_b32 %0, -1, %0" : "=v"(lane_l));
#pragma unroll
            for (int mb = 0; mb < 8; ++mb)
#pragma unroll
                for (int e = 0; e < 4; ++e) { Cacc[mb][e] = stC[((size_t)(bh * 8 + wave) * 32 + mb * 4 + e) * 64 + lane_l]; Sacc[mb][e] = stS[((size_t)(bh * 8 + wave) * 32 + mb * 4 + e) * 64 + lane_l]; }
            mst = stM[bh]; if (tid < 128) MF[MF_N + tid] = stN[bh * 128 + tid];
        }
        __syncthreads();
        v4u rawq3[2], rawk3[2], rawv[2], rawh[2]; unsigned rawhq[8], rawf[8];
#define MIX_LOAD_RAW(CC) do { int l_; asm volatile("v_mbcnt_lo_u32_b32 %0, -1, 0\n\tv_mbcnt_hi_u32_b32 %0, -1, %0" : "=v"(l_)); const int tid_ = wave * 64 + l_; \
              \
            const GAS char* pb_ = (const GAS char*)(Pcur + (size_t)(b * SEGT + 64 * (CC)) * PW + h * HB); \
            const unsigned o0_ = (unsigned)(((tid_ >> 4) * PW + (tid_ & 15) * 8) * 2); \
            _Pragma("unroll") for (int pass = 0; pass < 2; ++pass) { const GAS char* pp_ = pb_ + (size_t)(32 * pass) * PW * 2; \
                rawq3[pass] = *(const GAS v4u*)(pp_ + o0_ + PO_MQ * 2); rawk3[pass] = *(const GAS v4u*)(pp_ + o0_ + PO_MK * 2); rawv[pass] = *(const GAS v4u*)(pp_ + o0_ + PO_MV * 2); rawh[pass] = *(const GAS v4u*)(pp_ + o0_ + PO_HI * 2); } \
            { const GAS char* pr_ = pb_ + (size_t)(16 * (wave & 3) + 8 * (wave >> 2)) * PW * 2; const unsigned o1_ = 4u * (unsigned)l_; \
              _Pragma("unroll") for (int i = 0; i < 8; ++i) { rawhq[i] = *(const GAS unsigned*)(pr_ + (size_t)i * PW * 2 + o1_ + PO_HQ * 2); rawf[i] = *(const GAS unsigned*)(pr_ + (size_t)i * PW * 2 + o1_ + PO_HF * 2); } } } while (0)
#define MIX_STEP0(CC) do { int l_; asm volatile("v_mbcnt_lo_u32_b32 %0, -1, 0\n\tv_mbcnt_hi_u32_b32 %0, -1, %0" : "=v"(l_)); \
            const float gi = gi_n * (2.f / 15.f), gf = gf_n * (2.f / 15.f); \
            { const int cn2_ = (CC) + 1 < SEGT / 64 ? (CC) + 1 : (CC); const size_t g_ = (size_t)b * SEQ + seg * SEGT + 64 * cn2_ + l_; gi_n = gates[g_ * 16 + h]; gf_n = gates[g_ * 16 + 8 + h]; } \
            const float li = 15.f - 30.f * rcpf_(1.f + __expf(gi)); const float zf = 15.f - 30.f * rcpf_(1.f + __expf(gf)); \
            const float lf = fminf(zf, 0.f) - __logf(1.f + __expf(-fabsf(zf))); float bc = lf; \
            _Pragma("unroll") for (int d = 1; d < 64; d <<= 1) { const float t_ = __shfl_up(bc, d); if (l_ >= d) bc += t_; } \
            const float a_ = li - bc; float am = a_; \
            _Pragma("unroll") for (int o = 1; o < 64; o <<= 1) am = fmaxf(am, __shfl_xor(am, o)); \
            const float abar = fmaxf(mst, am); LAS float* sl_ = MF + MF_S0 + ((CC) & 1) * 160; \
            sl_[l_] = __expf(a_ - abar) * 0.08838834764831845f; sl_[64 + l_] = __expf(-(bc + abar)); if (l_ == 0) sl_[128] = __expf(mst - abar); \
            mst = __shfl(bc, 63) + abar; } while (0)
        MIX_LOAD_RAW(0);
        float gi_n = 0.f, gf_n = 0.f;
        if (wave == 1) { int l0; asm volatile("v_mbcnt_lo_u32_b32 %0, -1, 0\n\tv_mbcnt_hi_u32_b32 %0, -1, %0" : "=v"(l0)); const size_t g0 = (size_t)b * SEQ + seg * SEGT + l0; gi_n = gates[g0 * 16 + h]; gf_n = gates[g0 * 16 + 8 + h];
            MIX_STEP0(0); }
        __syncthreads();
        for (int c = 0; c < SEGT / 64; ++c) {
            const int tl0 = 64 * c; const size_t grow0 = (size_t)b * SEQ + seg * SEGT + tl0;
            int lane; asm volatile("v_mbcnt_lo_u32_b32 %0, -1, 0\n\tv_mbcnt_hi_u32_b32 %0, -1, %0" : "=v"(lane)); const int tid = wave * 64 + lane;
            const int r = lane & 15, q = lane >> 4;
            const int t4 = tid >> 3, c8 = tid & 7;
            const bf16* pc = Pcur + (size_t)(b * SEGT + tl0 + t4) * PW + h * HB + 16 * c8;
            const v4u ca0 = *(const GAS v4u*)(pc + PO_CA), ca1 = *(const GAS v4u*)(pc + PO_CA + 8), cb0 = *(const GAS v4u*)(pc + PO_CB), cb1 = *(const GAS v4u*)(pc + PO_CB + 8);
            const LAS float* S0 = MF + MF_S0 + (c & 1) * 160;
            const float decay = S0[128];
#pragma unroll
            for (int pass = 0; pass < 2; ++pass) {
                const int t = (tid >> 4) + 32 * pass, ch = tid & 15;
                const float rf = S0[t];
#pragma unroll
                for (int blk = 0; blk < 2; ++blk) {
                    float acc[8];
                    { const f32x4 b0 = *(const LAS f32x4*)(MF + MF_CW + blk * 384 + 256 + ch * 8), b1 = *(const LAS f32x4*)(MF + MF_CW + blk * 384 + 256 + ch * 8 + 4);
                      acc[0] = b0[0]; acc[1] = b0[1]; acc[2] = b0[2]; acc[3] = b0[3]; acc[4] = b1[0]; acc[5] = b1[1]; acc[6] = b1[2]; acc[7] = b1[3]; }
                    v4u rw[4];
                    if (c != 0) {
                        const bf16* pw_ = Pcur + (size_t)(b * SEGT + tl0 + t - 3) * PW + h * HB + (blk == 0 ? PO_MQ : PO_MK) + ch * 8;
#pragma unroll
                        for (int j = 0; j < 3; ++j) rw[j] = *(const GAS v4u*)(pw_ + (size_t)j * PW);
                    } else {
#pragma unroll
                    for (int j = 0; j < 3; ++j) { const int tq = tl0 + t - 3 + j; rw[j] = (v4u){0u, 0u, 0u, 0u};
                        if (seg * SEGT + tq >= 0) rw[j] = *(const GAS v4u*)(tq >= 0 ? Pcur + (size_t)(b * SEGT + tq) * PW + h * HB + (blk == 0 ? PO_MQ : PO_MK) + ch * 8 : Halo + (size_t)(bh * 3 + 3 + tq) * 256 + blk * 128 + ch * 8); }
                    }
                    rw[3] = blk == 0 ? rawq3[pass] : rawk3[pass];
                    { const v4u wa0 = *(const LAS v4u*)(MF + MF_CW + blk * 384 + ch * 8), wa1 = *(const LAS v4u*)(MF + MF_CW + blk * 384 + ch * 8 + 4), wb0 = *(const LAS v4u*)(MF + MF_CW + blk * 384 + 128 + ch * 8), wb1 = *(const LAS v4u*)(MF + MF_CW + blk * 384 + 128 + ch * 8 + 4);
#pragma unroll
                      for (int d = 0; d < 4; ++d) {
                        const unsigned lo01 = __builtin_amdgcn_perm(rw[1][d], rw[0][d], 0x05040100u), hi01 = __builtin_amdgcn_perm(rw[1][d], rw[0][d], 0x07060302u);
                        const unsigned lo23 = __builtin_amdgcn_perm(rw[3][d], rw[2][d], 0x05040100u), hi23 = __builtin_amdgcn_perm(rw[3][d], rw[2][d], 0x07060302u);
                        const unsigned w01l = d < 2 ? wa0[2 * d] : wa1[2 * d - 4], w01h = d < 2 ? wa0[2 * d + 1] : wa1[2 * d - 3], w23l = d < 2 ? wb0[2 * d] : wb1[2 * d - 4], w23h = d < 2 ? wb0[2 * d + 1] : wb1[2 * d - 3];
                        acc[2 * d] = dot2bf(lo23, w23l, dot2bf(lo01, w01l, acc[2 * d])); acc[2 * d + 1] = dot2bf(hi23, w23h, dot2bf(hi01, w01h, acc[2 * d + 1]));
                      } }
                    const float sc = blk == 0 ? 1.f : rf;
                    v4u o;
#pragma unroll
                    for (int d = 0; d < 4; ++d) { typedef float f32x2c __attribute__((ext_vector_type(2)));
                        const f32x2c a2 = (f32x2c){acc[2 * d], acc[2 * d + 1]}, e2 = a2 * -1.4426950408889634f;
                        const f32x2c d2 = (f32x2c){__builtin_amdgcn_exp2f(e2.x), __builtin_amdgcn_exp2f(e2.y)} + 1.f;
                        const f32x2c o2 = a2 * (f32x2c){rcpf_(d2.x), rcpf_(d2.y)} * sc;
                        o[d] = pkbf(o2.x, o2.y); }
                    *(LAS v4u*)(L + (blk == 0 ? IMG_QM : IMG_KM) + offb(t, ch)) = o;
                }
                *(LAS v4u*)(L + IMG_VM + offb(t, ch)) = rawv[pass];
                *(LAS v4u*)(L + IMG_HV + offb(t, ch)) = rawh[pass];
            }
            {
                const int j = wave & 3, hh = wave >> 2, trow = 16 * j + 8 * hh;
                typedef float f32x2 __attribute__((ext_vector_type(2)));
                f32x2 lbv = (f32x2){0.f, 0.f}; if (layer != 0) lbv = *(const GAS f32x2*)(lbp + h * 128 + 2 * lane);
                const f32x2 oml = 1.f - lbv;
                f32x2 fv[8], kv[8], qv[8];
#pragma unroll
                for (int i = 0; i < 8; ++i) {
                    const f32x2 xf = (f32x2){__builtin_bit_cast(float, rawf[i] << 16), __builtin_bit_cast(float, rawf[i] & 0xffff0000u)}, xq = (f32x2){__builtin_bit_cast(float, rawhq[i] << 16), __builtin_bit_cast(float, rawhq[i] & 0xffff0000u)};
                    const f32x2 ef = xf * -1.4426950408889634f, eq = xq * -1.4426950408889634f;
                    const f32x2 df = (f32x2){__builtin_amdgcn_exp2f(ef.x), __builtin_amdgcn_exp2f(ef.y)} + 1.f, dq = (f32x2){__builtin_amdgcn_exp2f(eq.x), __builtin_amdgcn_exp2f(eq.y)} + 1.f;
                    const f32x2 sv = (f32x2){rcpf_(df.x), rcpf_(df.y)}, rq = (f32x2){rcpf_(dq.x), rcpf_(dq.y)};
                    fv[i] = lbv + oml * sv;
                    kv[i] = oml - oml * sv;
                    qv[i] = xq * rq;
                }
                f32x2 runv = (f32x2){1.f, 1.f};
#define MIX_HG_STEPS(HH) _Pragma("unroll") for (int ii = 0; ii < 8; ++ii) { \
                    const int i = (HH) ? ii : 7 - ii;                               \
                    if (HH) runv = runv * fv[i]; \
                    const f32x2 rv = (f32x2){rcpf_(runv.x), rcpf_(runv.y)}; \
                    const unsigned xs_ = ((i & 3) << 2) | ((2 * (HH) + (i >> 2)) & 3);     \
                    LAS unsigned char* o_ = hgw + ((16u * xs_) ^ hgx) + 256 * i;            \
                    const f32x2 qo = qv[i] * ((HH) ? runv : rv), ko = kv[i] * ((HH) ? rv : runv); \
                    *(LAS unsigned*)(o_ + IMG_HQT) = pkbf(qo.x, qo.y); \
                    *(LAS unsigned*)(o_ + IMG_HKT) = pkbf(ko.x, ko.y); \
                    if (!(HH)) runv = runv * fv[i]; }
                LAS unsigned char* hgw = L + 256 * trow + 4 * (lane & 3); const unsigned hgx = 16u * (unsigned)(lane >> 2);
                if (hh) { MIX_HG_STEPS(1) } else { MIX_HG_STEPS(0) }
#undef MIX_HG_STEPS
                *(LAS f32x2*)(MF + (hh ? MF_E157 : MF_E7) + j * 128 + 2 * lane) = runv;
            }
            __syncthreads();
            const RowAddr RA = make_row_addr(lane);
            {
                const int tb = wave >> 1; float psum = 0.f;
#pragma unroll
                for (int s2 = 0; s2 < 2; ++s2) {
                    const int sb = 2 * (wave & 1) + s2; LN_FRESH(ln);
                    if (sb >= 2 && tb < 2) continue;
                    f32x4 acc = (f32x4){0.f, 0.f, 0.f, 0.f};
                    if (sb <= tb) {
#pragma unroll
                    for (int ks = 0; ks < 4; ++ks) acc = mfma16(frag_row2(L + IMG_KM, 16 * sb, ks, RA), frag_row2(L + IMG_QM, 16 * tb, ks, RA), acc);
                    }
                    const int t = 16 * tb + r, s0 = 16 * sb + 4 * q;
                    float v[4];
#pragma unroll
                    for (int e = 0; e < 4; ++e) { v[e] = (s0 + e <= t) ? acc[e] : 0.f; psum += v[e]; }
                    v2u w; w.x = pkbf(v[0], v[1]); w.y = pkbf(v[2], v[3]);
                    *(LAS v2u*)(L + IMG_P + 128 * t + 16 * ((2 * sb + (q >> 1)) ^ (t & 7)) + 8 * (q & 1)) = w;
                }
                psum += __shfl_xor(psum, 16); psum += __shfl_xor(psum, 32);
                if (q == 0) MF[MF_RS + 2 * (16 * tb + r) + (wave & 1)] = psum;
            }
            {
                const int t = tid >> 3, part = tid & 7;
                const v4u a0 = *(const LAS v4u*)(L + IMG_QM + offb(t, 2 * part)), a1 = *(const LAS v4u*)(L + IMG_QM + offb(t, 2 * part + 1));
                float x0[8], x1[8]; unpack8(a0, x0); unpack8(a1, x1);
                f32x4 dv = (f32x4){0.f, 0.f, 0.f, 0.f};
#pragma unroll
                for (int e4 = 0; e4 < 2; ++e4) { const f32x4 n0 = *(const LAS f32x4*)(MF + MF_N + 16 * part + 4 * e4), n1 = *(const LAS f32x4*)(MF + MF_N + 16 * part + 8 + 4 * e4);
                    dv += (f32x4){x0[4 * e4], x0[4 * e4 + 1], x0[4 * e4 + 2], x0[4 * e4 + 3]} * n0 + (f32x4){x1[4 * e4], x1[4 * e4 + 1], x1[4 * e4 + 2], x1[4 * e4 + 3]} * n1; }
                float d = (dv[0] + dv[1]) + (dv[2] + dv[3]);
                d = sum8_dpp(d);
                if (part == 0) MF[MF_QN + t] = d;
            }
            if (tid < 384) MF[MF_G + tid] = MF[MF_E7 + 128 + tid] * MF[MF_E157 + tid];
            if (wave == 1 && c + 1 < SEGT / 64) MIX_STEP0(c + 1);
#pragma unroll
            for (int jj = 0; jj < 2; ++jj) {
                const int j = jj == 0 ? (wave == 3 ? 0 : wave == 5 ? 1 : wave == 0 ? 2 : -1) : (wave == 3 ? 3 : -1);
                if (j < 0) continue;
                LN_FRESH(ln);
                f32x4 acc = (f32x4){0.f, 0.f, 0.f, 0.f};
#pragma unroll
                for (int ks = 0; ks < 4; ++ks) acc = mfma16(frag_row2(L + IMG_HKT, 16 * j, ks, RA), frag_row2(L + IMG_HQT, 16 * j, ks, RA), acc);
                float v[4];
#pragma unroll
                for (int e = 0; e < 4; ++e) v[e] = (4 * q + e <= r) ? acc[e] : 0.f;
                v2u w; w.x = pkbf(v[0], v[1]); w.y = pkbf(v[2], v[3]);
                *(LAS v2u*)(L + PH_OFF + j * 1024 + r * 64 + 8 * q) = w;
            }
            __syncthreads();
            f32x4 hval[4], oacc[4];
            FragAddr FA = make_frag_addr(lane);
#define FA_LAUNDER() asm volatile("" : "+v"(FA.tb), "+v"(FA.tx0), "+v"(FA.tx1), "+v"(FA.hb0), "+v"(FA.hb1), "+v"(FA.hx0), "+v"(FA.hx1), "+v"(FA.qb), "+v"(FA.qy))
            {
                f32x4 Cd[8];
#pragma unroll
                for (int mb = 0; mb < 8; ++mb) Cd[mb] = Cacc[mb] * decay;
                bf16x8 bC[4], bV[2];
#pragma unroll
                for (int ks = 0; ks < 4; ++ks) bC[ks] = pack_acc(Cd[2 * ks], Cd[2 * ks + 1]);
#pragma unroll
                for (int ks = 0; ks < 2; ++ks) bV[ks] = frag_tr31(L + IMG_VM, 32 * ks, wave, FA);
#pragma unroll
                for (int mt = 0; mt < 4; ++mt) {
                    f32x4 acc = (f32x4){0.f, 0.f, 0.f, 0.f}; FA_LAUNDER();
                    bf16x8 aQ[4], aP[2];
#pragma unroll
                    for (int ks = 0; ks < 4; ++ks) aQ[ks] = frag_q2(L + IMG_QM, 16 * mt, ks, FA);
#pragma unroll
                    for (int ks = 0; ks < 2; ++ks) if (ks == 0 || mt >= 2) { const int t = 16 * mt + r; aP[ks] = ld16(L + IMG_P + 128 * t + 16 * ((4 * ks + q) ^ (t & 7))); }
#pragma unroll
                    for (int ks = 0; ks < 4; ++ks) acc = mfma16(aQ[ks], bC[ks], acc);
#pragma unroll
                    for (int ks = 0; ks < 2; ++ks) if (ks == 0 || mt >= 2) acc = mfma16(aP[ks], bV[ks], acc);
                    const int t0 = 16 * mt + 4 * q;
                    const f32x4 r0 = *(const LAS f32x4*)(MF + MF_RS + 2 * t0), r1 = *(const LAS f32x4*)(MF + MF_RS + 2 * t0 + 4), qn4 = *(const LAS f32x4*)(MF + MF_QN + t0), df4 = *(const LAS f32x4*)(S0 + 64 + t0);
                    const float den0 = r0[0] + r0[1] + decay * qn4[0], den1 = r0[2] + r0[3] + decay * qn4[1], den2 = r1[0] + r1[1] + decay * qn4[2], den3 = r1[2] + r1[3] + decay * qn4[3];
                    hval[mt][0] = acc[0] * rcpf_(fmaxf(fabsf(den0), df4[0])); hval[mt][1] = acc[1] * rcpf_(fmaxf(fabsf(den1), df4[1])); hval[mt][2] = acc[2] * rcpf_(fmaxf(fabsf(den2), df4[2])); hval[mt][3] = acc[3] * rcpf_(fmaxf(fabsf(den3), df4[3]));
                }
#pragma unroll
                for (int mh = 0; mh < 2; ++mh) {
                    FA_LAUNDER();
                    bf16x8 aK[4][2];
#pragma unroll
                    for (int m4 = 0; m4 < 4; ++m4)
#pragma unroll
                        for (int ks = 0; ks < 2; ++ks) aK[m4][ks] = frag_tr31(L + IMG_KM, 32 * ks, 4 * mh + m4, FA);
#pragma unroll
                    for (int m4 = 0; m4 < 4; ++m4) { f32x4 acc = Cd[4 * mh + m4];
#pragma unroll
                        for (int ks = 0; ks < 2; ++ks) acc = mfma16(aK[m4][ks], bV[ks], acc);
                        Cacc[4 * mh + m4] = acc; }
                }
                {
                    const int ch = tid & 15, sg = tid >> 4;
                    const v4u a0 = *(const LAS v4u*)(L + IMG_KM + offb(2 * sg, ch)), a1 = *(const LAS v4u*)(L + IMG_KM + offb(2 * sg + 1, ch));
                    float x0[8], x1[8]; unpack8(a0, x0); unpack8(a1, x1);
                    float ps[8];
#pragma unroll
                    for (int e = 0; e < 8; ++e) { ps[e] = x0[e] + x1[e]; ps[e] += __shfl_xor(ps[e], 16); ps[e] += __shfl_xor(ps[e], 32); }
                    if (lane < 16) { *(LAS f32x4*)(MF + MF_NRED + wave * 128 + 8 * ch) = (f32x4){ps[0], ps[1], ps[2], ps[3]}; *(LAS f32x4*)(MF + MF_NRED + wave * 128 + 8 * ch + 4) = (f32x4){ps[4], ps[5], ps[6], ps[7]}; }
                }
            }
#pragma unroll
            for (int j = 0; j < 4; ++j) {
                FA_LAUNDER();
                bf16x8 aQ[4], aK[8];
#pragma unroll
                for (int ks = 0; ks < 4; ++ks) aQ[ks] = frag_q2(L + IMG_HQT, 16 * j, ks, FA);
                const bf16x8 aP = ld16(L + PH_OFF + j * 1024 + r * 64 + 16 * q);
                bf16x8 bVh = frag_tr15(L + IMG_HV, 16 * j, wave, FA);
#pragma unroll
                for (int mb = 0; mb < 8; ++mb) aK[mb] = frag_tr15(L + IMG_HKT, 16 * j, mb, FA);
                if (q >= 2) bVh = (bf16x8){0, 0, 0, 0, 0, 0, 0, 0};
                f32x4 T[8];
#pragma unroll
                for (int mb = 0; mb < 8; ++mb) T[mb] = Sacc[mb] * *(const LAS f32x4*)(MF + (j == 0 ? MF_E7 : MF_G + (j - 1) * 128) + 16 * mb + 4 * q);
                f32x4 acc = (f32x4){0.f, 0.f, 0.f, 0.f};
#pragma unroll
                for (int ks = 0; ks < 4; ++ks) acc = mfma16(aQ[ks], pack_acc(T[2 * ks], T[2 * ks + 1]), acc);
                acc = mfma16(aP, bVh, acc);
                oacc[j] = acc;
#pragma unroll
                for (int mb = 0; mb < 8; ++mb) { Sacc[mb] = mfma16(aK[mb], bVh, T[mb]); if (j == 3) Sacc[mb] = Sacc[mb] * *(const LAS f32x4*)(MF + MF_E157 + 3 * 128 + 16 * mb + 4 * q); }
            }
            {
            { const int cn_ = c + 1 < SEGT / 64 ? c + 1 : c; MIX_LOAD_RAW(cn_); }
            {
                const int dvc = 16 * wave + r; LAS unsigned char* ob_ = L + HAB_OFF + 1024 * q + 2 * (dvc & 7); const unsigned oa_ = 16u * (unsigned)((dvc >> 3) ^ q);
#pragma unroll
                for (int e = 0; e < 4; ++e) { LAS unsigned char* pe_ = ob_ + (oa_ ^ (64u * e)) + 256 * e;
#pragma unroll
                    for (int mt = 0; mt < 4; ++mt) { const unsigned w_ = pkbf(hval[mt][e], oacc[mt][e]);
                        *(LAS unsigned short*)(pe_ + 4096 * mt) = (unsigned short)(w_ & 0xffffu); *(LAS unsigned short*)(pe_ + (OBB_OFF - HAB_OFF) + 4096 * mt) = (unsigned short)(w_ >> 16); } }
            }
            __syncthreads();
            if (tid < 128) { float s = decay * MF[MF_N + tid];
#pragma unroll
                for (int w = 0; w < 8; ++w) s += MF[MF_NRED + w * 128 + tid];
                MF[MF_N + tid] = s; }
            {
                float ha[16], ob[16], ca[16], cb[16];
                { const v4u a0 = *(const LAS v4u*)(L + HAB_OFF + offb(t4, 2 * c8)), a1 = *(const LAS v4u*)(L + HAB_OFF + offb(t4, 2 * c8 + 1)), b0 = *(const LAS v4u*)(L + OBB_OFF + offb(t4, 2 * c8)), b1 = *(const LAS v4u*)(L + OBB_OFF + offb(t4, 2 * c8 + 1));
                  float x[8]; unpack8(a0, x);
#pragma unroll
                  for (int e = 0; e < 8; ++e) ha[e] = x[e];
                  unpack8(a1, x);
#pragma unroll
                  for (int e = 0; e < 8; ++e) ha[8 + e] = x[e];
                  unpack8(b0, x);
#pragma unroll
                  for (int e = 0; e < 8; ++e) ob[e] = x[e];
                  unpack8(b1, x);
#pragma unroll
                  for (int e = 0; e < 8; ++e) ob[8 + e] = x[e];
                  unpack8(ca0, x);
#pragma unroll
                  for (int e = 0; e < 8; ++e) ca[e] = x[e];
                  unpack8(ca1, x);
#pragma unroll
                  for (int e = 0; e < 8; ++e) ca[8 + e] = x[e];
                  unpack8(cb0, x);
#pragma unroll
                  for (int e = 0; e < 8; ++e) cb[e] = x[e];
                  unpack8(cb1, x);
#pragma unroll
                  for (int e = 0; e < 8; ++e) cb[8 + e] = x[e]; }
                float ssa = 0.f, ssb = 0.f;
#pragma unroll
                for (int e = 0; e < 16; ++e) { ssa += ha[e] * ha[e]; ssb += ob[e] * ob[e]; }
                ssa = sum8_dpp(ssa); ssb = sum8_dpp(ssb);
                const float ra = rsqrtf(ssa * (1.f / 128.f) + RMS_EPS), rb = rsqrtf(ssb * (1.f / 128.f) + RMS_EPS);
                float y[16];
#pragma unroll
                for (int e4 = 0; e4 < 4; ++e4) { const f32x4 wa = *(const LAS f32x4*)(MF + MF_WN + 16 * c8 + 4 * e4), wb = *(const LAS f32x4*)(MF + MF_WN + 128 + 16 * c8 + 4 * e4);
#pragma unroll
                    for (int e = 0; e < 4; ++e) y[4 * e4 + e] = ca[4 * e4 + e] * (ha[4 * e4 + e] * ra * wa[e]) + cb[4 * e4 + e] * (ob[4 * e4 + e] * rb * wb[e]); }
                v4u o0, o1; o0.x = pkbf(y[0], y[1]); o0.y = pkbf(y[2], y[3]); o0.z = pkbf(y[4], y[5]); o0.w = pkbf(y[6], y[7]); o1.x = pkbf(y[8], y[9]); o1.y = pkbf(y[10], y[11]); o1.z = pkbf(y[12], y[13]); o1.w = pkbf(y[14], y[15]);
                bf16* yp = Y + (grow0 + t4) * D + h * 128 + 16 * c8;
                if (!DRY) { *(GAS v4u*)yp = o0; *(GAS v4u*)(yp + 8) = o1; } else { asm volatile("" :: "v"(o0), "v"(o1)); }
            }
            }
        }
        { int l_h; asm volatile("v_mbcnt_lo_u32_b32 %0, -1, 0\n\tv_mbcnt_hi_u32_b32 %0, -1, %0" : "=v"(l_h)); const int th = wave * 64 + l_h;
          if (!DRY && th < 96) { const int row = th >> 5, c16 = th & 31; *(GAS v4u*)(Halo + (size_t)(bh * 3 + row) * 256 + c16 * 8) = *(const GAS v4u*)(Pcur + (size_t)(b * SEGT + SEGT - 3 + row) * PW + h * HB + c16 * 8); } }
        int lane_s; asm volatile("v_mbcnt_lo_u32_b32 %0, -1, 0\n\tv_mbcnt_hi_u32_b32 %0, -1, %0" : "=v"(lane_s));
#pragma unroll
        for (int mb = 0; mb < 8; ++mb)
#pragma unroll
            for (int e = 0; e < 4; ++e) { if (!DRY) { stC[((size_t)(bh * 8 + wave) * 32 + mb * 4 + e) * 64 + lane_s] = Cacc[mb][e]; stS[((size_t)(bh * 8 + wave) * 32 + mb * 4 + e) * 64 + lane_s] = Sacc[mb][e]; } else { asm volatile("" :: "v"(Cacc[mb][e]), "v"(Sacc[mb][e])); } }
        __syncthreads();
        if (!DRY) { const int tid_s = wave * 64 + lane_s; if (tid_s < 128) stN[bh * 128 + tid_s] = MF[MF_N + tid_s];
        if (tid_s == 64) stM[bh] = mst; }
        __syncthreads();
    }
}

__global__ void __launch_bounds__(NWAVES * 64, 2) fwd_kernel(Args kernel_args_unused) {
    extern __shared__ __attribute__((aligned(16))) unsigned char lds[];
    Ctx F;
    F.lds = (LAS unsigned char*)lds;
    F.wave_s = __builtin_amdgcn_readfirstlane(threadIdx.x >> 6);
    F.G = gridDim.x; { const int bx = blockIdx.x; F.vcu = (F.G % 8 == 0) ? (bx % 8) * (F.G / 8) + bx / 8 : bx; }
    volatile LAS unsigned* MISC = (volatile LAS unsigned*)(F.lds + MISC_OFF);
    if (threadIdx.x < 64) MISC[threadIdx.x] = 0u;
    __syncthreads();
    unsigned bar_x;
    { ARGS(); const XcdBarrier b0 = xcd_barrier_post((unsigned*)((gu32*)(A.ws + WS_CTL) + CW_BAR), MISC + 8); bar_x = b0.x; }
#define GRID_BAR() do { ARGS(); XcdBarrier bb; bb.bar = (unsigned*)((gu32*)(A.ws + WS_CTL) + CW_BAR); bb.x = bar_x; asm volatile("" : "+s"(bb.x)); bb.st = (volatile LAS unsigned*)(F.lds + MISC_OFF) + 8; int l_b; asm volatile("v_mbcnt_lo_u32_b32 %0, -1, 0\n\tv_mbcnt_hi_u32_b32 %0, -1, %0" : "=v"(l_b)); const bool lead_b = (F.wave_s == 0) && (l_b == 0); xcd_barrier(bb, lead_b); } while (0)

    p0_prologue(F);
    GRID_BAR();

    for (int layer = 0; layer < DEPTH; ++layer) {
#define PHASE_PTRS() ARGS(); const float* src = layer == 0 ? A.in[0] : (const float*)A.out; const float* modl = (const float*)(A.ws + WS_MOD) + (size_t)layer * BATCH * MODW; bf16* hn = (bf16*)(A.ws + WS_HN); (void)src; (void)modl; (void)hn
        { PHASE_PTRS();
        norm_gates_phase(F, src, A.in[4] + (size_t)layer * D, modl, 0, D, hn, (float*)(A.ws + WS_GATES), (const float*)(A.ws + WS_WG) + (size_t)layer * 16 * D, (const float*)(A.ws + WS_BG) + layer * 16); }
        GRID_BAR();
#if defined(SEG_STAGGER) && SEG_STAGGER > 0
        {
            const unsigned long long t0_ = __builtin_amdgcn_s_memrealtime(), dt_ = (unsigned long long)((blockIdx.x >> 3) & 7) * SEG_STAGGER;
            while (__builtin_amdgcn_s_memrealtime() - t0_ < dt_) __builtin_amdgcn_s_sleep(8);
        }
#endif
        for (int seg = 0; seg < NSEG; ++seg) {
            {
                PHASE_PTRS();
                pg8::Gemm g{hn, (const bf16*)(A.ws + WS_WIN) + (size_t)layer * NPROJ * D, SEGROWS, NPROJ, D, SEG_SH, SEQ / 256, seg * (SEGT / 256), SEGT / 256 - 1};
                pg8::OwnOrder S; S.init(F.G, (int)blockIdx.x, SEGT / 256);
                pg8::EpiInProj E{(bf16*)(A.ws + WS_P + (size_t)(seg & PBUF_MASK) * P_BYTES), PW, (const float*)(A.ws + WS_BIASP) + (size_t)layer * NPROJ, -1};
                pg8::gemm_phase<pg8::EpiInProj, pg8::OwnOrder, PG8_ALIGN, PG8_SP2>(F.lds + RING_OFF, g, S, E, F.wave_s);
            }
            asm volatile("s_waitcnt vmcnt(0)" ::: "memory"); __syncthreads();
            mixer_fast_phase<false>(F, layer, seg);
            asm volatile("s_waitcnt vmcnt(0)" ::: "memory"); __syncthreads();
        }
        GRID_BAR();
        {
            PHASE_PTRS();
            pg8::Gemm g{(const bf16*)(A.ws + WS_Y), (const bf16*)(A.ws + WS_WOUT) + (size_t)layer * D * D, M, D, D, 0, 1, 0, 0};
            pg8::StaticOrder S; S.init(M, D, F.G, (int)blockIdx.x);
            pg8::EpiResid E{src, A.out, D, modl + 2 * D, MODW, 0, -1};
            pg8::gemm_phase<pg8::EpiResid, pg8::StaticOrder, PG8_ALIGN, PG8_SP2>(F.lds + RING_OFF, g, S, E, F.wave_s);
        }
        GRID_BAR();
        { PHASE_PTRS();
        norm_phase<false>(F, (const float*)A.out, A.in[13] + (size_t)layer * D, modl, 3 * D, 4 * D, hn, nullptr, nullptr, nullptr); }
        GRID_BAR();
        {
            PHASE_PTRS();
            pg8::Gemm g{hn, (const bf16*)(A.ws + WS_WUP) + (size_t)layer * 2 * DFF * D, M, 2 * DFF, D, 0, 1, 0, 0};
            pg8::StaticOrder S; S.init(M, 2 * DFF, F.G, (int)blockIdx.x);
            pg8::EpiUpGlu E{(bf16*)(A.ws + WS_G), (bf16*)(A.ws + WS_S), A.in[15] + (size_t)layer * 3 * 2 * DFF, A.in[16] + (size_t)layer * 2 * DFF, DFF, -1};
            pg8::gemm_phase<pg8::EpiUpGlu, pg8::StaticOrder, PG8_ALIGN, PG8_SP2>(F.lds + RING_OFF, g, S, E, F.wave_s);
        }
        GRID_BAR();
        { ARGS(); ffn_fix_phase(F, (const bf16*)(A.ws + WS_S), (bf16*)(A.ws + WS_G), A.in[15] + (size_t)layer * 3 * 2 * DFF, A.in[16] + (size_t)layer * 2 * DFF); }
        GRID_BAR();
        {
            PHASE_PTRS();
            pg8::Gemm g{(const bf16*)(A.ws + WS_G), (const bf16*)(A.ws + WS_WDN) + (size_t)layer * D * DFF, M, D, DFF, 0, 1, 0, 0};
            pg8::StaticOrder S; S.init(M, D, F.G, (int)blockIdx.x);
            pg8::EpiResid E{(const float*)A.out, A.out, D, modl + 5 * D, MODW, 0, -1};
            pg8::gemm_phase<pg8::EpiResid, pg8::StaticOrder, PG8_ALIGN, PG8_SP2>(F.lds + RING_OFF, g, S, E, F.wave_s);
        }
        GRID_BAR();
    }
    { ARGS(); final_norm_phase(F, A.out, A.in[18]); }

#undef GRID_BAR
}

extern "C" void kernel_launch(void* const* d_in, const int* in_sizes, int n_in, void* d_out, int out_size, void* d_ws, size_t ws_size, hipStream_t stream) {
    static int grid = 0;
    if (grid == 0) {
        if (n_in != 19 || in_sizes[0] != M * D || out_size != M * D || ws_size < WS_END) { fprintf(stderr, "kernel_launch: unexpected shapes (n_in %d, in0 %d, out %d, ws %zu; need ws >= %zu); nothing launched\n", n_in, n_in > 0 ? in_sizes[0] : -1, out_size, ws_size, (size_t)WS_END); grid = -1; return; }
        int dev = 0, cus = 0, per_cu = 0;
        if (hipGetDevice(&dev) != hipSuccess || hipDeviceGetAttribute(&cus, hipDeviceAttributeMultiprocessorCount, dev) != hipSuccess) { grid = -1; return; }
        if (hipFuncSetAttribute((const void*)fwd_kernel, hipFuncAttributeMaxDynamicSharedMemorySize, LDS_BYTES) != hipSuccess) { fprintf(stderr, "kernel_launch: hipFuncSetAttribute failed\n"); grid = -1; return; }
        if (hipOccupancyMaxActiveBlocksPerMultiprocessor(&per_cu, (const void*)fwd_kernel, NWAVES * 64, LDS_BYTES) != hipSuccess || per_cu < 1)
            fprintf(stderr, "kernel_launch: note: occupancy query reports %d workgroups per CU\n", per_cu);
        (void)hipGetLastError();
        grid = cus;
    }
    if (grid < 0) return;
    if (hipMemsetAsync((char*)d_ws + WS_CTL, 0, CTL_ZERO_BYTES, stream) != hipSuccess) return;
    Args a{};
    for (int i = 0; i < 19; ++i) a.in[i] = (const float*)d_in[i];
    a.out = (float*)d_out; a.ws = (unsigned char*)d_ws;
    hipLaunchKernelGGL(fwd_kernel, dim3(grid), dim3(NWAVES * 64), LDS_BYTES, stream, a);
}
```

```cpp
#include <hip/hip_runtime.h>
#include <cstdio>
#include <cstdint>
namespace pg8 {
#define PG8_LAS __attribute__((address_space(3)))
typedef unsigned short bf16_t;
typedef short bf16x8 __attribute__((ext_vector_type(8)));
typedef float f32x4 __attribute__((ext_vector_type(4)));
typedef unsigned u32x4 __attribute__((ext_vector_type(4)));
constexpr int BM = 256, BK = 64, HALF = 128, HTB = HALF * BK * 2  , STAGE_BYTES = 8 * HTB, NXCD = 8, WGM = 8;

__host__ __device__ __forceinline__ int lds_byte(int r, int c) { const int st = (r >> 4) * 2 + (c >> 5), rr = r & 15, cc = c & 31, ob = rr * 64 + cc * 2; return st * 1024 + (ob ^ (((ob >> 9) & 1) << 5)); }
__host__ __device__ __forceinline__ void stage_rc(int b, int& R, int& C) { const int st = b / 1024, sb = b % 1024, swz = sb ^ (((sb >> 9) & 1) << 5); R = (st >> 1) * 16 + swz / 64; C = (st & 1) * 32 + (swz % 64) / 2; }
__host__ __device__ __forceinline__ int perm32(int rho) { const int n = rho >> 4, i = rho & 15; return 8 * (i >> 2) + 4 * n + (i & 3); }

struct Unit { int pm, pn; };
struct Gemm { const bf16_t* A; const bf16_t* Bt; int M, N, K; int a_sh, a_mul, a_add, a_mask;
    __device__ __forceinline__ int atile(int pm) const { return (pm >> a_sh) * a_mul + a_add + (pm & a_mask); } };

struct StaticOrder {
    int nM, nN, nwg, G, c;
    __host__ __device__ void init(int M, int N, int G_, int c_) { nM = M / BM; nN = N / BM; nwg = nM * nN; G = G_; c = c_; }
    __host__ __device__ bool next(int i, Unit& u) const {
        const long L = (long)i * G + c; if (L >= nwg) return false;
        int wgid = (int)L; { const int q = nwg / NXCD, r = nwg % NXCD, xcd = wgid % NXCD, off = wgid / NXCD; wgid = (xcd < r ? xcd * (q + 1) : r * (q + 1) + (xcd - r) * q) + off; }
        const int nig = WGM * nN, gid = wgid / nig, fm = gid * WGM, gsz = (nM - fm) < WGM ? (nM - fm) : WGM;
        u.pm = fm + ((wgid % nig) % gsz); u.pn = (wgid % nig) / gsz; return true;
    }
    __device__ __forceinline__ void a_ready(const Unit&) const {}
    __device__ __forceinline__ void done(const Unit&) const {}
};

__host__ __device__ __forceinline__ int wg_bh(int i) { return (i & 7) * 32 + (i >> 3); }
struct OwnOrder {
    int G, c, MT;
    __host__ __device__ void init(int G_, int c_, int MT_) { G = G_; c = c_; MT = MT_; }
    __host__ __device__ bool next(int i, Unit& u) const {
        const int upb = MT * 5, k = i / upb, j = i - k * upb, bhi = c + k * G; if (bhi >= 256) return false;
        const int bh = wg_bh(bhi), b = bh >> 3, h = bh & 7;
        u.pm = b * MT + j / 5; u.pn = 5 * h + j % 5; return true;
    }
    __device__ __forceinline__ void a_ready(const Unit&) const {}
    __device__ __forceinline__ void done(const Unit&) const {}
};

__device__ __forceinline__ unsigned cvt_pk_bf16(float lo, float hi) { unsigned r; asm volatile("v_cvt_pk_bf16_f32 %0, %1, %2" : "=v"(r) : "v"(lo), "v"(hi)); return r; }

struct EpiBf16B {
    static constexpr bool PERM = true, AFTER_DRAIN = false; static constexpr int TID = 4;
    bf16_t* O; int ldc; const float* bias;
    __device__ __forceinline__ void operator()(const f32x4 (&acc)[2][2][4][2], const Unit& u, int wr, int wc, int fr, int fq) const {
        const int row0 = u.pm * BM + wr * 64 + fr; const int col0 = u.pn * BM + wc * 32 + 8 * fq;
        f32x4 bv[2][2];
#pragma unroll
        for (int bj = 0; bj < 2; ++bj)
#pragma unroll
            for (int n = 0; n < 2; ++n) bv[bj][n] = bias ? *(const f32x4*)(bias + col0 + bj * HALF + 4 * n) : (f32x4){0.f, 0.f, 0.f, 0.f};
#pragma unroll
        for (int ai = 0; ai < 2; ++ai)
#pragma unroll
            for (int m = 0; m < 4; ++m) { bf16_t* rowp = O + (size_t)(row0 + ai * HALF + m * 16) * ldc + col0;
#pragma unroll
                for (int bj = 0; bj < 2; ++bj) { const f32x4 v0 = acc[ai][bj][m][0] + bv[bj][0], v1 = acc[ai][bj][m][1] + bv[bj][1];
                    u32x4 w; w.x = cvt_pk_bf16(v0[0], v0[1]); w.y = cvt_pk_bf16(v0[2], v0[3]); w.z = cvt_pk_bf16(v1[0], v1[1]); w.w = cvt_pk_bf16(v1[2], v1[3]);
                    *(u32x4*)(rowp + bj * HALF) = w; } }
    }
};
struct EpiResid {
    static constexpr bool PERM = false, AFTER_DRAIN = false; static constexpr int TID = 3;
    const float* res; float* out; int ldc; const float* gate; int gstride; int row_off; int pm_mask;
    __device__ __forceinline__ void operator()(const f32x4 (&acc)[2][2][4][2], const Unit& u, int wr, int wc, int fr, int fq) const {
        const int rbase = row_off + u.pm * BM; const int b = rbase >> 11;
        const int row0 = rbase + wr * 64 + fr, col0 = u.pn * BM + wc * 32 + 4 * fq;
        const float* gp = gate + (size_t)b * gstride + col0;
        f32x4 gv[2][2];
#pragma unroll
        for (int bj = 0; bj < 2; ++bj)
#pragma unroll
            for (int n = 0; n < 2; ++n) gv[bj][n] = *(const f32x4*)(gp + bj * HALF + n * 16);
        const size_t fold = (size_t)(u.pm & ~pm_mask) * BM * ldc;
#pragma unroll
        for (int ai = 0; ai < 2; ++ai) {
            f32x4 rv[4][2][2];
#pragma unroll
            for (int m = 0; m < 4; ++m)
#pragma unroll
                for (int bj = 0; bj < 2; ++bj)
#pragma unroll
                    for (int n = 0; n < 2; ++n) rv[m][bj][n] = *(const f32x4*)(res + (size_t)(row0 + ai * HALF + m * 16) * ldc + col0 + bj * HALF + n * 16);
            asm volatile("" ::: "memory");
#pragma unroll
            for (int m = 0; m < 4; ++m)
#pragma unroll
                for (int bj = 0; bj < 2; ++bj)
#pragma unroll
                    for (int n = 0; n < 2; ++n) *(f32x4*)(out + ((size_t)(row0 + ai * HALF + m * 16) * ldc - fold) + col0 + bj * HALF + n * 16) = rv[m][bj][n] + gv[bj][n] * acc[ai][bj][m][n];
            asm volatile("" ::: "memory");
        }
    }
};


struct EpiInProj {
    static constexpr bool PERM = true, AFTER_DRAIN = false, HAS_INIT = true; static constexpr int TID = 1;
    bf16_t* O; int ldc; const float* bias; int pm_mask;
    __device__ __forceinline__ void load_init(const Unit& u, int wc, int fq, f32x4 (&bi)[2][2]) const {
        const int cin = wc * 32 + 8 * fq;
#pragma unroll
        for (int bj = 0; bj < 2; ++bj)
#pragma unroll
            for (int n = 0; n < 2; ++n) bi[bj][n] = *(const f32x4*)(bias + u.pn * BM + bj * HALF + cin + 4 * n);
    }
    __device__ __forceinline__ void apply_init(f32x4 (&acc)[2][2][4][2], const f32x4 (&bi)[2][2]) const {
#pragma unroll
        for (int bj = 0; bj < 2; ++bj)
#pragma unroll
            for (int n = 0; n < 2; ++n) { const f32x4 bvv = bi[bj][n];
#pragma unroll
                for (int ai = 0; ai < 2; ++ai)
#pragma unroll
                    for (int m = 0; m < 4; ++m) { f32x4 z_; asm volatile("v_mov_b64 %0, %2\n\tv_mov_b64 %1, %3" : "=v"(*(double*)&z_), "=v"(*((double*)&z_ + 1)) : "v"(*(const double*)&bvv), "v"(*((const double*)&bvv + 1))); acc[ai][bj][m][n] = z_; } }
    }
    __device__ __forceinline__ void init(f32x4 (&acc)[2][2][4][2], const Unit& u, int wc, int fq) const { f32x4 bi[2][2]; load_init(u, wc, fq, bi); apply_init(acc, bi); }
    __device__ __forceinline__ void operator()(const f32x4 (&acc)[2][2][4][2], const Unit& u, int wr, int wc, int fr, int fq) const {
        const int head = u.pn / 5, part = u.pn - 5 * head;
        const int row0 = (u.pm & pm_mask) * BM + wr * 64 + fr, cin = wc * 32 + 8 * fq;
        if (part < 3) {
#pragma unroll
            for (int ai = 0; ai < 2; ++ai)
#pragma unroll
                for (int m = 0; m < 4; ++m) { bf16_t* rowp = O + (size_t)(row0 + ai * HALF + m * 16) * ldc + head * 1024 + part * 256 + cin;
#pragma unroll
                    for (int bj = 0; bj < 2; ++bj) { const f32x4 v0 = acc[ai][bj][m][0], v1 = acc[ai][bj][m][1];
                        u32x4 w; w.x = cvt_pk_bf16(v0[0], v0[1]); w.y = cvt_pk_bf16(v0[2], v0[3]); w.z = cvt_pk_bf16(v1[0], v1[1]); w.w = cvt_pk_bf16(v1[2], v1[3]);
                        if (pm_mask == -2) { asm volatile("" :: "v"(w)); } else *(u32x4*)(rowp + bj * HALF) = w; } }
        } else {
            const bool silu0 = part == 4;
#pragma unroll
            for (int ai = 0; ai < 2; ++ai)
#pragma unroll
                for (int m = 0; m < 4; ++m) { bf16_t* rowp = O + (size_t)(row0 + ai * HALF + m * 16) * ldc + head * 1024 + 768 + (part - 3) * 128 + cin;
                    float c[8];
#pragma unroll
                    for (int n = 0; n < 2; ++n) { const f32x4 x0 = acc[ai][0][m][n], x1 = acc[ai][1][m][n];
                        const f32x4 t0 = x0 * -1.4426950408889634f, t1 = x1 * -1.4426950408889634f;
                        const f32x4 d0 = (f32x4){__builtin_amdgcn_exp2f(t0[0]), __builtin_amdgcn_exp2f(t0[1]), __builtin_amdgcn_exp2f(t0[2]), __builtin_amdgcn_exp2f(t0[3])} + 1.f;
                        const f32x4 d1 = (f32x4){__builtin_amdgcn_exp2f(t1[0]), __builtin_amdgcn_exp2f(t1[1]), __builtin_amdgcn_exp2f(t1[2]), __builtin_amdgcn_exp2f(t1[3])} + 1.f;
                        const f32x4 dd = d0 * d1;
                        f32x4 s01 = (f32x4){__builtin_amdgcn_rcpf(dd[0]), __builtin_amdgcn_rcpf(dd[1]), __builtin_amdgcn_rcpf(dd[2]), __builtin_amdgcn_rcpf(dd[3])};
                        if (silu0) { asm volatile("" ::: "memory"); s01 = s01 * x0; }
#pragma unroll
                        for (int e = 0; e < 4; ++e) c[4 * n + e] = s01[e]; }
                    u32x4 w; w.x = cvt_pk_bf16(c[0], c[1]); w.y = cvt_pk_bf16(c[2], c[3]); w.z = cvt_pk_bf16(c[4], c[5]); w.w = cvt_pk_bf16(c[6], c[7]);
                    if (pm_mask == -2) { asm volatile("" :: "v"(w)); } else *(u32x4*)rowp = w; }
        }
    }
};

struct EpiUpGlu {
    static constexpr bool PERM = true, AFTER_DRAIN = false; static constexpr int TID = 2;
    bf16_t* G; bf16_t* S; const float* cw; const float* cb; int nf; int pm_mask;
    __device__ __forceinline__ void operator()(const f32x4 (&acc)[2][2][4][2], const Unit& u, int wr, int wc, int fr, int fq) const {
        const int cin = wc * 32 + 8 * fq, f0 = u.pn * HALF + cin;
        if (fr < 2 || fr >= 14) {
            const int m = fr < 2 ? 0 : 3, rr = fr < 2 ? fr : fr - 12;
#pragma unroll
            for (int ai = 0; ai < 2; ++ai) { const int g64 = (u.pm & pm_mask) * 4 + 2 * ai + wr; bf16_t* sp = S + ((size_t)g64 * 4 + rr) * (2 * nf) + u.pn * BM + cin;
#pragma unroll
                for (int bj = 0; bj < 2; ++bj) { const f32x4 v0 = fr < 2 ? acc[ai][bj][0][0] : acc[ai][bj][3][0], v1 = fr < 2 ? acc[ai][bj][0][1] : acc[ai][bj][3][1];
                    u32x4 w; w.x = cvt_pk_bf16(v0[0], v0[1]); w.y = cvt_pk_bf16(v0[2], v0[3]); w.z = cvt_pk_bf16(v1[0], v1[1]); w.w = cvt_pk_bf16(v1[2], v1[3]);
                    *(u32x4*)(sp + bj * HALF) = w; } }
            (void)m;
        }
        unsigned outp[2][4][4];
#define UG_MIRROR(x) __builtin_bit_cast(float, __builtin_amdgcn_update_dpp(0, __builtin_bit_cast(int, (x)), 0x140, 0xf, 0xf, true))
#define UG_SWAP01(x) __builtin_bit_cast(float, __builtin_amdgcn_update_dpp(0, __builtin_bit_cast(int, (x)), 0xB1, 0xf, 0xf, true))
#define UG_SHR1(old, x) __builtin_bit_cast(float, __builtin_amdgcn_update_dpp(__builtin_bit_cast(int, (old)), __builtin_bit_cast(int, (x)), 0x111, 0xf, 0xf, false))
#define UG_SHR2(old, x) __builtin_bit_cast(float, __builtin_amdgcn_update_dpp(__builtin_bit_cast(int, (old)), __builtin_bit_cast(int, (x)), 0x112, 0xf, 0xf, false))
        typedef float f32x2u __attribute__((ext_vector_type(2)));
#define UG_P2(v4, ep) ((f32x2u){(v4)[2 * (ep)], (v4)[2 * (ep) + 1]})
#pragma unroll
        for (int n = 0; n < 2; ++n) {
            const f32x4 wg0 = *(const f32x4*)(cw + f0 + 4 * n), wg1 = *(const f32x4*)(cw + 2 * nf + f0 + 4 * n), wg2 = *(const f32x4*)(cw + 4 * nf + f0 + 4 * n);
            const f32x4 wv0 = *(const f32x4*)(cw + nf + f0 + 4 * n), wv1 = *(const f32x4*)(cw + 3 * nf + f0 + 4 * n), wv2 = *(const f32x4*)(cw + 5 * nf + f0 + 4 * n);
            const f32x4 bg = *(const f32x4*)(cb + f0 + 4 * n), bv = *(const f32x4*)(cb + nf + f0 + 4 * n);
#pragma unroll
            for (int ai = 0; ai < 2; ++ai) {
                float o[4][4];
#pragma unroll
                for (int ep = 0; ep < 2; ++ep) {
                    const f32x2u g0 = UG_P2(wg0, ep), g1 = UG_P2(wg1, ep), g2 = UG_P2(wg2, ep), v0 = UG_P2(wv0, ep), v1 = UG_P2(wv1, ep), v2 = UG_P2(wv2, ep), b_g = UG_P2(bg, ep), b_v = UG_P2(bv, ep);
                    f32x2u mg = (f32x2u){0.f, 0.f}, mv = (f32x2u){0.f, 0.f};
#pragma unroll
                    for (int m = 0; m < 4; ++m) {
                        const f32x2u xg = UG_P2(acc[ai][0][m][n], ep), xv = UG_P2(acc[ai][1][m][n], ep);
                        const float xg0 = xg.x, xg1 = xg.y, xv0 = xv.x, xv1 = xv.y, mg0 = mg.x, mg1 = mg.y, mv0 = mv.x, mv1 = mv.y;
                        const f32x2u pg2 = (f32x2u){UG_SHR2(UG_SWAP01(mg0), xg0), UG_SHR2(UG_SWAP01(mg1), xg1)}, pv2 = (f32x2u){UG_SHR2(UG_SWAP01(mv0), xv0), UG_SHR2(UG_SWAP01(mv1), xv1)};
                        const f32x2u pg1 = (f32x2u){UG_SHR1(mg0, xg0), UG_SHR1(mg1, xg1)}, pv1 = (f32x2u){UG_SHR1(mv0, xv0), UG_SHR1(mv1, xv1)};
                        const f32x2u cg = b_g + g2 * xg + g1 * pg1 + g0 * pg2;
                        const f32x2u cv = b_v + v2 * xv + v1 * pv1 + v0 * pv2;
                        const f32x2u ex = cg * -1.4426950408889634f;
                        const f32x2u den = (f32x2u){__builtin_amdgcn_exp2f(ex.x), __builtin_amdgcn_exp2f(ex.y)} + 1.f;
                        const f32x2u r = (f32x2u){__builtin_amdgcn_rcpf(den.x), __builtin_amdgcn_rcpf(den.y)};
                        const f32x2u ov = cg * r * cv;
                        o[m][2 * ep] = ov.x; o[m][2 * ep + 1] = ov.y;
                        mg = (f32x2u){UG_MIRROR(xg0), UG_MIRROR(xg1)}; mv = (f32x2u){UG_MIRROR(xv0), UG_MIRROR(xv1)};
                    }
                }
#pragma unroll
                for (int m = 0; m < 4; ++m) { outp[ai][m][2 * n] = cvt_pk_bf16(o[m][0], o[m][1]); outp[ai][m][2 * n + 1] = cvt_pk_bf16(o[m][2], o[m][3]); }
            }
        }
#undef UG_P2
#undef UG_MIRROR
#undef UG_SWAP01
#undef UG_SHR1
#undef UG_SHR2
#pragma unroll
        for (int ai = 0; ai < 2; ++ai)
#pragma unroll
            for (int m = 0; m < 4; ++m) if (m > 0 || fr >= 2) { u32x4 w; w.x = outp[ai][m][0]; w.y = outp[ai][m][1]; w.z = outp[ai][m][2]; w.w = outp[ai][m][3];
                *(u32x4*)(G + (size_t)((u.pm & pm_mask) * BM + ai * HALF + wr * 64 + m * 16 + fr) * nf + f0) = w; }
    }
};

template <bool PERM_> struct EpiNull {
    static constexpr bool PERM = PERM_, AFTER_DRAIN = false; static constexpr int TID = 5;
    __device__ __forceinline__ void operator()(const f32x4 (&acc)[2][2][4][2], const Unit&, int, int, int, int) const {
#pragma unroll
        for (int a = 0; a < 2; ++a)
#pragma unroll
            for (int b = 0; b < 2; ++b)
#pragma unroll
                for (int m = 0; m < 4; ++m)
#pragma unroll
                    for (int n = 0; n < 2; ++n) asm volatile("" :: "v"(acc[a][b][m][n]));
    }
};
template <class E, class = void> struct epi_has_init { static constexpr bool value = false; };
template <class E> struct epi_has_init<E, decltype((void)E::HAS_INIT)> { static constexpr bool value = E::HAS_INIT; };
template <class Epi, class Sched, bool ALIGN_EPI = false, bool SP2 = false>
__device__ __forceinline__ void gemm_phase(PG8_LAS unsigned char* lds, const Gemm g, const Sched& S, const Epi& E, const int wave_id  ) {
    int tid_l; asm volatile("v_mbcnt_lo_u32_b32 %0, -1, 0\n\tv_mbcnt_hi_u32_b32 %0, -1, %0" : "=v"(tid_l)); tid_l += wave_id * 64;
    const int tid = tid_l, wid = __builtin_amdgcn_readfirstlane(tid >> 6), lane = tid & 63, wr = wid >> 2, wc = wid & 3, fr = lane & 15, fq = lane >> 4;
    const int K = g.K, nt = K / BK;
    unsigned voffA[2], voffB[2];
#pragma unroll
    for (int i = 0; i < 2; ++i) { int R, C; stage_rc(tid * 16 + i * 8192, R, C); const int Rb = Epi::PERM ? ((R & ~31) + perm32(R & 31)) : R;
        voffA[i] = (unsigned)(R * K + C) * 2u; voffB[i] = (unsigned)(Rb * K + C) * 2u; }
    const size_t kstep = (size_t)(BK * 2);
    const size_t hstep = (size_t)HALF * K * 2;
    const size_t tstep = 2 * hstep;
    const unsigned ldsw = (unsigned)wid * 1024u;
    const int aoff = lds_byte(wr * 64 + fr, fq * 8), boff = lds_byte(wc * 32 + fr, fq * 8);
#define PG8_SA(b, h) (((b) * 2 + (h)) * HTB)
#define PG8_SB(b, h) ((4 + (b) * 2 + (h)) * HTB)
#define PG8_STAGE(bufoff, gbase, voff) do { _Pragma("unroll") for (int _i = 0; _i < 2; ++_i) \
        __builtin_amdgcn_global_load_lds((const unsigned*)((const char*)(gbase) + (voff)[_i]), (PG8_LAS unsigned*)(lds + (bufoff) + ldsw + _i * 8192), 16, 0, 0); } while (0)
#define PG8_LDA(dst, b, h) do { _Pragma("unroll") for (int m = 0; m < 4; ++m) _Pragma("unroll") for (int k = 0; k < 2; ++k) dst[m][k] = *(const PG8_LAS bf16x8*)(lds + PG8_SA(b, h) + aoff + m * 2048 + k * 1024); } while (0)
#define PG8_LDB(dst, b, h) do { _Pragma("unroll") for (int n = 0; n < 2; ++n) _Pragma("unroll") for (int k = 0; k < 2; ++k) dst[n][k] = *(const PG8_LAS bf16x8*)(lds + PG8_SB(b, h) + boff + n * 2048 + k * 1024); } while (0)
#define PG8_MMA(ai, bj, At, Bt) do { __builtin_amdgcn_s_setprio(1); _Pragma("unroll") for (int m = 0; m < 4; ++m) _Pragma("unroll") for (int n = 0; n < 2; ++n) _Pragma("unroll") for (int k = 0; k < 2; ++k) \
        acc[ai][bj][m][n] = __builtin_amdgcn_mfma_f32_16x16x32_bf16(Bt[n][k], At[m][k], acc[ai][bj][m][n], 0, 0, 0); __builtin_amdgcn_s_setprio(0); } while (0)
#define PG8_WAIT_V(n) asm volatile("s_waitcnt vmcnt(" #n ")" ::: "memory")
#define PG8_WAIT_L(n) asm volatile("s_waitcnt lgkmcnt(" #n ")" ::: "memory")
#define PG8_BAR __builtin_amdgcn_s_barrier()
#define PG8_SCHED __builtin_amdgcn_sched_barrier(0)
    Unit cur, nxt; int ui = 0;
    if (!S.next(0, cur)) return;
    f32x4 acc[2][2][4][2];
    if constexpr (epi_has_init<Epi>::value) E.init(acc, cur, wc, fq);
    else {
#pragma unroll
    for (int a = 0; a < 2; ++a)
#pragma unroll
        for (int b = 0; b < 2; ++b)
#pragma unroll
            for (int m = 0; m < 4; ++m)
#pragma unroll
                for (int n = 0; n < 2; ++n) { f32x4 z_; asm volatile("v_mov_b64 %0, 0\n\tv_mov_b64 %1, 0" : "=v"(*(double*)&z_), "=v"(*((double*)&z_ + 1))); acc[a][b][m][n] = z_; }
    }
    bf16x8 At[4][2], B0[2][2], B1[2][2];
    const char* cA = (const char*)g.A + (size_t)g.atile(cur.pm) * tstep; const char* cB = (const char*)g.Bt + (size_t)cur.pn * tstep;
    S.a_ready(cur);
#if defined(PG8_STAGGER) && PG8_STAGGER > 0
    {
        const unsigned long long t0_ = __builtin_amdgcn_s_memrealtime(), dt_ = (unsigned long long)((blockIdx.x >> 3) & 7) * PG8_STAGGER;
        while (__builtin_amdgcn_s_memrealtime() - t0_ < dt_) __builtin_amdgcn_s_sleep(8);
    }
#endif
    if constexpr (SP2) {
        PG8_STAGE(PG8_SB(0, 0), cB, voffB); PG8_STAGE(PG8_SB(0, 1), cB + hstep, voffB); PG8_STAGE(PG8_SA(0, 0), cA, voffA); PG8_STAGE(PG8_SA(0, 1), cA + hstep, voffA);
        if (wr == 1) PG8_BAR;
        PG8_WAIT_V(2); PG8_BAR;
        PG8_STAGE(PG8_SB(1, 0), cB + kstep, voffB); PG8_STAGE(PG8_SA(1, 0), cA + kstep, voffA); PG8_STAGE(PG8_SB(1, 1), cB + hstep + kstep, voffB);
        PG8_WAIT_V(6); PG8_BAR;
    } else {
        PG8_STAGE(PG8_SB(0, 0), cB, voffB); PG8_STAGE(PG8_SA(0, 0), cA, voffA); PG8_STAGE(PG8_SB(0, 1), cB + hstep, voffB); PG8_STAGE(PG8_SA(0, 1), cA + hstep, voffA);
        if (wr == 1) PG8_BAR;
        PG8_WAIT_V(4); PG8_BAR;
        PG8_STAGE(PG8_SB(1, 0), cB + kstep, voffB); PG8_STAGE(PG8_SA(1, 0), cA + kstep, voffA); PG8_STAGE(PG8_SB(1, 1), cB + hstep + kstep, voffB);
        PG8_WAIT_V(6); PG8_BAR;
    }
    for (;;) {
        const bool has_next = S.next(ui + 1, nxt);
        const char* nA = has_next ? (const char*)g.A + (size_t)g.atile(nxt.pm) * tstep : cA; const char* nB = has_next ? (const char*)g.Bt + (size_t)nxt.pn * tstep : cB;
        for (int t = 0; t < nt; t += 2) {
            const bool last = (t == nt - 2);
            const char* a1 = cA + (size_t)(t + 1) * kstep;
            const char* a2 = last ? nA : cA + (size_t)(t + 2) * kstep; const char* b2 = last ? nB : cB + (size_t)(t + 2) * kstep;
            const char* a3 = a2 + kstep; const char* b3 = b2 + kstep;
            if (last && has_next) S.a_ready(nxt);
            if constexpr (SP2) {
            PG8_LDB(B0, 0, 0); PG8_LDB(B1, 0, 1); PG8_SCHED; PG8_LDA(At, 0, 0); PG8_STAGE(PG8_SA(1, 1), a1 + hstep, voffA);
            PG8_WAIT_V(8); PG8_WAIT_L(0); PG8_BAR; PG8_MMA(0, 0, At, B0); PG8_MMA(0, 1, At, B1); PG8_BAR; PG8_SCHED;
            PG8_LDA(At, 0, 1); PG8_STAGE(PG8_SB(0, 0), b2, voffB); PG8_STAGE(PG8_SB(0, 1), b2 + hstep, voffB); PG8_STAGE(PG8_SA(0, 0), a2, voffA);
            PG8_WAIT_V(8); PG8_WAIT_L(0); PG8_BAR; PG8_MMA(1, 0, At, B0); PG8_MMA(1, 1, At, B1); PG8_BAR; PG8_SCHED;
            PG8_LDB(B0, 1, 0); PG8_LDB(B1, 1, 1); PG8_SCHED; PG8_LDA(At, 1, 0); PG8_STAGE(PG8_SA(0, 1), a2 + hstep, voffA);
            PG8_WAIT_V(8); PG8_WAIT_L(0); PG8_BAR; PG8_MMA(0, 0, At, B0); PG8_MMA(0, 1, At, B1); PG8_BAR; PG8_SCHED;
            PG8_LDA(At, 1, 1); PG8_STAGE(PG8_SB(1, 0), b3, voffB); PG8_STAGE(PG8_SB(1, 1), b3 + hstep, voffB); PG8_STAGE(PG8_SA(1, 0), a3, voffA);
            PG8_WAIT_V(8); PG8_WAIT_L(0); PG8_BAR; PG8_MMA(1, 0, At, B0); PG8_MMA(1, 1, At, B1); PG8_BAR; PG8_SCHED;
            } else {
            PG8_LDB(B0, 0, 0); PG8_SCHED; PG8_LDA(At, 0, 0); PG8_STAGE(PG8_SA(1, 1), a1 + hstep, voffA);
            PG8_WAIT_L(8); PG8_BAR; PG8_WAIT_L(0); PG8_MMA(0, 0, At, B0); PG8_BAR; PG8_SCHED;
            PG8_LDB(B1, 0, 1); PG8_STAGE(PG8_SB(0, 0), b2, voffB);
            PG8_BAR; PG8_WAIT_L(0); PG8_MMA(0, 1, At, B1); PG8_BAR;
            PG8_LDA(At, 0, 1); PG8_STAGE(PG8_SA(0, 0), a2, voffA);
            PG8_BAR; PG8_WAIT_L(0); PG8_MMA(1, 0, At, B0); PG8_BAR; PG8_SCHED;
            PG8_STAGE(PG8_SB(0, 1), b2 + hstep, voffB);
            PG8_WAIT_V(6); PG8_BAR; PG8_MMA(1, 1, At, B1); PG8_BAR;
            PG8_LDB(B0, 1, 0); PG8_SCHED; PG8_LDA(At, 1, 0); PG8_STAGE(PG8_SA(0, 1), a2 + hstep, voffA);
            PG8_WAIT_L(8); PG8_BAR; PG8_WAIT_L(0); PG8_MMA(0, 0, At, B0); PG8_BAR; PG8_SCHED;
            PG8_LDB(B1, 1, 1); PG8_STAGE(PG8_SB(1, 0), b3, voffB);
            PG8_BAR; PG8_WAIT_L(0); PG8_MMA(0, 1, At, B1); PG8_BAR;
            PG8_LDA(At, 1, 1); PG8_STAGE(PG8_SA(1, 0), a3, voffA);
            PG8_BAR; PG8_WAIT_L(0); PG8_MMA(1, 0, At, B0); PG8_BAR; PG8_SCHED;
            PG8_STAGE(PG8_SB(1, 1), b3 + hstep, voffB);
            PG8_WAIT_V(6); PG8_BAR; PG8_MMA(1, 1, At, B1); PG8_BAR;
            }
        }
        if constexpr (ALIGN_EPI) { if (wr == 0) PG8_BAR; }
        f32x4 binit[2][2]; if constexpr (epi_has_init<Epi>::value) E.load_init(has_next ? nxt : cur, wc, fq, binit); else { (void)binit; }
        if constexpr (!Epi::AFTER_DRAIN) { E(acc, cur, wr, wc, fr, fq); S.done(cur); }
        if (!has_next) break;
        if constexpr (epi_has_init<Epi>::value) E.apply_init(acc, binit);
        else {
#pragma unroll
        for (int a = 0; a < 2; ++a)
#pragma unroll
            for (int b = 0; b < 2; ++b)
#pragma unroll
                for (int m = 0; m < 4; ++m)
#pragma unroll
                    for (int n = 0; n < 2; ++n) { f32x4 z_; asm volatile("v_mov_b64 %0, 0\n\tv_mov_b64 %1, 0" : "=v"(*(double*)&z_), "=v"(*((double*)&z_ + 1))); acc[a][b][m][n] = z_; }
        }
        cur = nxt; cA = nA; cB = nB; ++ui;
        if constexpr (ALIGN_EPI) { if (wr == 1) PG8_BAR; }
    }
    PG8_WAIT_V(0);
    if constexpr (!ALIGN_EPI) { if (wr == 0) PG8_BAR; }
    PG8_BAR;
    if constexpr (Epi::AFTER_DRAIN) { E.fused(acc, cur, wr, wc, fr, fq, lds, wid, lane); S.done(cur); }
#undef PG8_SA
#undef PG8_SB
#undef PG8_STAGE
#undef PG8_LDA
#undef PG8_LDB
#undef PG8_MMA
#undef PG8_WAIT_V
#undef PG8_WAIT_L
#undef PG8_BAR
#undef PG8_SCHED
}
}

#ifndef PG8_SP2
#define PG8_SP2 true
#endif
#ifndef PG8_ALIGN
#define PG8_ALIGN true
#endif

constexpr int NWAVES = 8;
constexpr int D = 1024, BATCH = 32, SEQ = 2048, M = BATCH * SEQ, DEPTH = 2, NH = 8, HD = 128, DFF = 2816;
constexpr int PROJW = 10256;
constexpr int NPROJ = 10240, WHB = 1280;
constexpr int PW = 8192, HB = 1024;
constexpr int NSEG = 2, SEGT = SEQ / NSEG, SEGROWS = BATCH * SEGT;
constexpr int SEG_SH = (SEGT == 256) ? 0 : (SEGT == 512) ? 1 : 2;
constexpr int FSEG = 2, FROWS = M / FSEG;
constexpr float RMS_EPS = 1e-6f;
constexpr int MODW = 6 * D;

constexpr size_t MiB = 1u << 20;
constexpr size_t WS_CTL = 0, CTL_ZERO_BYTES = 1 * MiB;
constexpr size_t WS_WIN = 2 * MiB;
constexpr size_t WS_WOUT = 42 * MiB;
constexpr size_t WS_WUP = 46 * MiB;
constexpr size_t WS_WDN = 68 * MiB;
constexpr size_t WS_WG = 79 * MiB;
constexpr size_t WS_BIASP = 79 * MiB + 256 * 1024;
constexpr size_t WS_BG = 79 * MiB + 512 * 1024;
constexpr size_t WS_LB = 79 * MiB + 768 * 1024;
constexpr size_t WS_MOD = 80 * MiB;
constexpr size_t WS_GATES = 84 * MiB;
constexpr size_t WS_STC = 88 * MiB;
constexpr size_t WS_STS = 104 * MiB;
constexpr size_t WS_STN = 120 * MiB;
constexpr size_t WS_STM = 121 * MiB;
constexpr size_t WS_HALO = 121 * MiB + 512 * 1024;
constexpr size_t WS_HN = 122 * MiB;
constexpr size_t WS_Y = 250 * MiB;
constexpr size_t WS_P = 378 * MiB;
constexpr size_t P_BYTES = (size_t)SEGROWS * PW * 2;
constexpr size_t WS_G = 250 * MiB;
constexpr size_t WS_S = 620 * MiB;
constexpr size_t WS_END = 890 * MiB;
constexpr int PBUF_MASK = 0;
static_assert(WS_P + (PBUF_MASK + 1) * P_BYTES <= 890 * MiB && WS_G + (size_t)M * DFF * 2 <= WS_S && WS_S + (size_t)(M / 64) * 4 * 2 * DFF * 2 <= WS_END, "ws map");
constexpr int CW_TMO = 0, CW_CODE = 1, CW_BAR = 4096;

constexpr int LDS_BYTES = 160 * 1024;
constexpr int RING_OFF = 0;
constexpr int MISC_OFF = 159 * 1024;

#define GAS __attribute__((address_space(1)))
#define LAS __attribute__((address_space(3)))
typedef unsigned short bf16;
typedef unsigned v4u __attribute__((ext_vector_type(4)));
typedef unsigned v2u __attribute__((ext_vector_type(2)));
typedef float f32x4 __attribute__((ext_vector_type(4)));
typedef short bf16x8 __attribute__((ext_vector_type(8)));
typedef GAS unsigned gu32;
#define RLX_AGENT __ATOMIC_RELAXED, __HIP_MEMORY_SCOPE_AGENT
#define LDS_WAIT() asm volatile("s_waitcnt lgkmcnt(0)" ::: "memory")
#define VM_WAIT() asm volatile("s_waitcnt vmcnt(0)" ::: "memory")
__device__ __forceinline__ unsigned f2bf(float f) { unsigned u = __builtin_bit_cast(unsigned, f); return (u + 0x7fffu + ((u >> 16) & 1u)) >> 16; }
__device__ __forceinline__ unsigned pk2(float lo, float hi) { return f2bf(lo) | (f2bf(hi) << 16); }
__device__ __forceinline__ float bf2f(unsigned short b) { return __builtin_bit_cast(float, ((unsigned)b) << 16); }
__device__ __forceinline__ float sigm(float x) { return 1.f / (1.f + __expf(-x)); }
__device__ __forceinline__ float siluf(float x) { return x / (1.f + __expf(-x)); }
__device__ __forceinline__ float softcap15(float z) { return 15.f * tanhf(z * (1.f / 15.f)); }
__device__ __forceinline__ float logsigm(float z) { return fminf(z, 0.f) - log1pf(expf(-fabsf(z))); }
__device__ __forceinline__ float wave_sum(float v) {
#pragma unroll
    for (int o = 1; o < 64; o <<= 1) v += __shfl_xor(v, o);
    return v;
}

#define PHASE_TID() int tid; asm volatile("v_mbcnt_lo_u32_b32 %0, -1, 0\n\tv_mbcnt_hi_u32_b32 %0, -1, %0" : "=v"(tid)); tid += F.wave_s * 64; const int lane = tid & 63, wave = F.wave_s; (void)lane; (void)wave
#define XB_TMO      128
#define XB_XCNT(j)  (256  + 64 * (j))
#define XB_XSUB(j)  (1280 + 64 * (j))
#define XB_XGEN(j)  (2304 + 64 * (j))
#define XB_TOP      3328
#define XB_TOPGEN   3392
#define XCD_BAR_WORDS 3456
#define XB_SPIN_CAP (1u << 18)

__device__ __forceinline__ unsigned xb_ld(unsigned* p)              { return __hip_atomic_load(p, __ATOMIC_RELAXED, __HIP_MEMORY_SCOPE_AGENT); }
__device__ __forceinline__ unsigned xb_add(unsigned* p, unsigned v) { return __hip_atomic_fetch_add(p, v, __ATOMIC_RELAXED, __HIP_MEMORY_SCOPE_AGENT); }
__device__ __forceinline__ unsigned xb_xcc_id() { return (unsigned)__builtin_amdgcn_s_getreg((3 << 11) | 20) & 0xFu; }
#define XB_SPIN(cond, bar) do { unsigned _sp = 0; while (cond) { __builtin_amdgcn_s_sleep(1); \
    if ((++_sp & 255u) == 0u) { if (xb_ld(&(bar)[XB_TMO])) break; if (_sp > XB_SPIN_CAP) { atomicAdd(&(bar)[XB_TMO], 1u); break; } } } } while (0)

struct XcdBarrier {
    unsigned* bar; unsigned x;
    volatile LAS unsigned* st;
};

__device__ __forceinline__ XcdBarrier xcd_barrier_post(unsigned* bar, volatile LAS unsigned* st) {
    XcdBarrier b; b.bar = bar; b.x = xb_xcc_id(); b.st = st;
    if (threadIdx.x == 0) (void)xb_add(&bar[XB_XCNT(b.x)], 1u);
    return b;
}
__device__ __forceinline__ void xcd_barrier_complete(unsigned* bar, unsigned x, unsigned& nloc, unsigned& nx) {
    const unsigned G = gridDim.x * gridDim.y * gridDim.z;
    unsigned sum, cnt, mine, sp = 0u;
    for (;;) {
        sum = 0u; cnt = 0u; mine = 0u;
#pragma unroll
        for (unsigned j = 0; j < 16; ++j) { const unsigned c = xb_ld(&bar[XB_XCNT(j)]); sum += c; cnt += (c > 0u) ? 1u : 0u; mine = (j == x) ? c : mine; }
        if (sum == G) break;
        __builtin_amdgcn_s_sleep(1);
        if ((++sp & 255u) == 0u) { if (xb_ld(&bar[XB_TMO])) break; if (sp > XB_SPIN_CAP) { atomicAdd(&bar[XB_TMO], 1u); break; } }
    }
    nloc = mine > 0u ? mine : 1u; nx = cnt > 0u ? cnt : 1u;
}

__device__ __forceinline__ void xcd_barrier(const XcdBarrier& b, const bool leader  ) {
    asm volatile("s_waitcnt vmcnt(0)" ::: "memory");
    __syncthreads();
    if (leader) {
        unsigned* bar = b.bar;
        __builtin_amdgcn_s_waitcnt(0);
        unsigned nloc = b.st[0], nx = b.st[1];
        if (nloc == 0u) { xcd_barrier_complete(bar, b.x, nloc, nx); b.st[0] = nloc; b.st[1] = nx; }
        const unsigned old = xb_add(&bar[XB_XSUB(b.x)], 1u);
        const unsigned gen = old / nloc;
        if (old + 1u == (gen + 1u) * nloc) {
            __builtin_amdgcn_fence(__ATOMIC_RELEASE, "agent");
            asm volatile("s_waitcnt vmcnt(0)" ::: "memory");
            const unsigned og = xb_add(&bar[XB_TOP], 1u);
            const unsigned tg = og / nx;
            if (og + 1u == (tg + 1u) * nx) xb_add(&bar[XB_TOPGEN], 1u);
            else XB_SPIN(xb_ld(&bar[XB_TOPGEN]) == tg, bar);
            __builtin_amdgcn_fence(__ATOMIC_ACQUIRE, "agent");
            xb_add(&bar[XB_XGEN(b.x)], 1u);
            asm volatile("s_waitcnt vmcnt(0)" ::: "memory");
        } else {
            XB_SPIN(xb_ld(&bar[XB_XGEN(b.x)]) == gen, bar);
            __builtin_amdgcn_fence(__ATOMIC_ACQUIRE, "agent");
            asm volatile("s_waitcnt vmcnt(0)" ::: "memory");
        }
    }
    __syncthreads();
}

struct Ctx {
    LAS unsigned char* lds;
    int vcu, G, wave_s;
};
struct Args { const float* in[19]; float* out; unsigned char* ws; };
typedef const Args __attribute__((address_space(4))) CArgs;
__device__ __forceinline__ CArgs& getargs() { CArgs* p = (CArgs*)__builtin_amdgcn_kernarg_segment_ptr(); asm volatile("" : "+s"(p)); return *p; }
#define ARGS() CArgs& A = getargs()

struct P0Item { const float* src; bf16* dst; int ldw, K; };
__device__ __forceinline__ void p0_item_load(const P0Item& I, int lane, f32x4 (&v)[8]) {
#pragma unroll
    for (int i = 0; i < 8; ++i) v[i] = *(const GAS f32x4*)(I.src + (size_t)(8 * i + (lane >> 3)) * I.ldw + 4 * (lane & 7));
}
__device__ __forceinline__ void p0_item_store(const P0Item& I, int lane, const f32x4 (&v)[8], LAS float* scr) {
#pragma unroll
    for (int i = 0; i < 8; ++i) { LAS float* d = scr + (8 * i + (lane >> 3)) * 33 + 4 * (lane & 7); d[0] = v[i][0]; d[1] = v[i][1]; d[2] = v[i][2]; d[3] = v[i][3]; }
    LDS_WAIT(); asm volatile("" ::: "memory");
    const int c = lane & 7;
#pragma unroll
    for (int j = 0; j < 4; ++j) { const int n = (lane >> 3) + 8 * j; const LAS float* s = scr + (8 * c) * 33 + n;
        v4u o; o.x = pg8::cvt_pk_bf16(s[0 * 33], s[1 * 33]); o.y = pg8::cvt_pk_bf16(s[2 * 33], s[3 * 33]); o.z = pg8::cvt_pk_bf16(s[4 * 33], s[5 * 33]); o.w = pg8::cvt_pk_bf16(s[6 * 33], s[7 * 33]);
        *(GAS v4u*)(I.dst + (size_t)n * I.K + 8 * c) = o; }
    LDS_WAIT(); asm volatile("" ::: "memory");
}
__device__ __forceinline__ int in_src_col(int dstrow) {
    const int h = dstrow / WHB, rem = dstrow - h * WHB, blk = rem >> 7, j = rem & 127;
    int base;
    switch (blk) { case 0: base = 0; break; case 1: base = 1024; break; case 2: base = 2048; break; case 3: base = 6160; break; case 4: base = 4112; break;
                   case 5: base = 5136; break; case 6: base = 3072; break; case 7: base = 8208; break; case 8: base = 7184; break; default: base = 9232; break; }
    return base + h * 128 + j;
}
__device__ __forceinline__ void p0_prologue(Ctx& F) {
    PHASE_TID();
    ARGS();
    LAS float* scr = (LAS float*)(F.lds + wave * 16384);
    const int gw = F.vcu * NWAVES + wave, NGW = F.G * NWAVES;
    constexpr int I_IN = 320 * 16, I_OUT = 32 * 16, I_UP = 176 * 16, I_DN = 32 * 44, I_L = I_IN + I_OUT + I_UP + I_DN;
    auto item_of = [&](int it) {
        asm volatile("" : "+v"(it));
        P0Item I; const int l = it / I_L; int r = it - l * I_L;
        if (r < I_IN) { const int rg = r >> 4, kb = r & 15; I.ldw = PROJW; I.K = D; I.src = A.in[5] + (size_t)l * D * PROJW + (size_t)(64 * kb) * PROJW + in_src_col(32 * rg); I.dst = (bf16*)(A.ws + WS_WIN) + (size_t)l * NPROJ * D + (size_t)(32 * rg) * D + 64 * kb; return I; } r -= I_IN;
        if (r < I_OUT) { const int rg = r >> 4, kb = r & 15; I.ldw = D; I.K = D; I.src = A.in[12] + (size_t)l * D * D + (size_t)(64 * kb) * D + 32 * rg; I.dst = (bf16*)(A.ws + WS_WOUT) + (size_t)l * D * D + (size_t)(32 * rg) * D + 64 * kb; return I; } r -= I_OUT;
        if (r < I_UP) { const int rg = r >> 4, kb = r & 15; const int row0 = 32 * rg, pn = row0 >> 8, half = (row0 >> 7) & 1, j0 = row0 & 127; I.ldw = 2 * DFF; I.K = D;
            I.src = A.in[14] + (size_t)l * D * 2 * DFF + (size_t)(64 * kb) * (2 * DFF) + half * DFF + pn * 128 + j0; I.dst = (bf16*)(A.ws + WS_WUP) + (size_t)l * 2 * DFF * D + (size_t)row0 * D + 64 * kb; return I; } r -= I_UP;
        { const int rg = r / 44, kb = r - rg * 44; I.ldw = D; I.K = DFF; I.src = A.in[17] + (size_t)l * DFF * D + (size_t)(64 * kb) * D + 32 * rg; I.dst = (bf16*)(A.ws + WS_WDN) + (size_t)l * D * DFF + (size_t)(32 * rg) * DFF + 64 * kb; return I; }
    };
    {
        f32x4 va[8], vb[8]; int it = gw;
        P0Item Ia = item_of(it < 2 * I_L ? it : 0), Ib = Ia;
        if (it < 2 * I_L) p0_item_load(Ia, lane, va);
        while (it < 2 * I_L) {
            const int itb = it + NGW, itc = itb + NGW;
            if (itb < 2 * I_L) { Ib = item_of(itb); p0_item_load(Ib, lane, vb); }
            p0_item_store(Ia, lane, va, scr);
            if (itb >= 2 * I_L) break;
            if (itc < 2 * I_L) { Ia = item_of(itc); p0_item_load(Ia, lane, va); }
            p0_item_store(Ib, lane, vb, scr);
            it = itc;
        }
    }
    const int gt = F.vcu * (NWAVES * 64) + tid, NGT = F.G * NWAVES * 64;
    float* wg = (float*)(A.ws + WS_WG); float* biasp = (float*)(A.ws + WS_BIASP); float* bg = (float*)(A.ws + WS_BG); float* lb = (float*)(A.ws + WS_LB);
    for (int i = gt; i < 2 * D * 16; i += NGT) { const int g = i & 15, k = (i >> 4) & (D - 1), l = i >> 14; wg[(size_t)(l * 16 + g) * D + k] = A.in[5][((size_t)l * D + k) * PROJW + 4096 + g]; }
    for (int i = gt; i < 2 * NPROJ; i += NGT) { const int l = i / NPROJ, c = i - l * NPROJ; biasp[i] = A.in[6][(size_t)l * PROJW + in_src_col(c)]; }
    for (int i = gt; i < 32; i += NGT) { const int l = i >> 4, g = i & 15; bg[i] = A.in[6][(size_t)l * PROJW + 4096 + g]; }
    for (int i = gt; i < D; i += NGT) { const float z0 = A.in[10][i], z1 = A.in[10][D + i]; lb[i] = 1.f / (1.f + expf(z0 - z1)); }
    __syncthreads();
    for (int wgi = F.vcu; wgi < 2 * (MODW / 64); wgi += F.G) {
        constexpr int CS = D + 8;
        LAS unsigned short* chi = (LAS unsigned short*)F.lds; LAS unsigned short* clo = chi + BATCH * CS;
        LAS float* part = (LAS float*)(F.lds + 2 * BATCH * CS * 2);
#pragma unroll 1
        for (int it = 0; it < 2; ++it) {
            f32x4 cv[8];
#pragma unroll
            for (int j = 0; j < 8; ++j) cv[j] = ((const GAS f32x4*)A.in[1])[tid + NWAVES * 64 * (8 * it + j)];
#pragma unroll
            for (int j = 0; j < 8; ++j) { const int i4 = (tid + NWAVES * 64 * (8 * it + j)) * 4, bb = i4 >> 10, kk = i4 & (D - 1);
                unsigned hw[4], lw[4];
#pragma unroll
                for (int e = 0; e < 4; ++e) { const float v = siluf(cv[j][e]); hw[e] = f2bf(v); lw[e] = f2bf(v - bf2f((unsigned short)hw[e])); }
                *(LAS v2u*)(chi + bb * CS + kk) = (v2u){hw[0] | (hw[1] << 16), hw[2] | (hw[3] << 16)}; *(LAS v2u*)(clo + bb * CS + kk) = (v2u){lw[0] | (lw[1] << 16), lw[2] | (lw[3] << 16)}; }
        }
        __syncthreads();
        const int l = wgi / (MODW / 64), cg = wgi - l * (MODW / 64), cq = wave & 3, kh = wave >> 2, r = lane & 15, q = lane >> 4;
        const float* aw = A.in[2] + (size_t)l * D * MODW + (size_t)(kh * 512 + 8 * q) * MODW + cg * 64 + cq * 16 + r;
        f32x4 acc[2] = {(f32x4){0.f, 0.f, 0.f, 0.f}, (f32x4){0.f, 0.f, 0.f, 0.f}};
#pragma unroll 1
        for (int kc = 0; kc < 4; ++kc) {
            float wv[4][8];
#pragma unroll
            for (int ks = 0; ks < 4; ++ks)
#pragma unroll
                for (int e = 0; e < 8; ++e) wv[ks][e] = aw[(size_t)(128 * kc + 32 * ks + e) * MODW];
#pragma unroll
            for (int ks = 0; ks < 4; ++ks) {
                bf16x8 ahi, alo;
#pragma unroll
                for (int e = 0; e < 8; ++e) { const unsigned short hb = (unsigned short)f2bf(wv[ks][e]); ahi[e] = (short)hb; alo[e] = (short)f2bf(wv[ks][e] - bf2f(hb)); }
                const int k0 = kh * 512 + 128 * kc + 32 * ks + 8 * q;
#pragma unroll
                for (int bt = 0; bt < 2; ++bt) {
                    const bf16x8 bhi = *(const LAS bf16x8*)(chi + (16 * bt + r) * CS + k0), blo = *(const LAS bf16x8*)(clo + (16 * bt + r) * CS + k0);
                    acc[bt] = __builtin_amdgcn_mfma_f32_16x16x32_bf16(ahi, bhi, acc[bt], 0, 0, 0);
                    acc[bt] = __builtin_amdgcn_mfma_f32_16x16x32_bf16(ahi, blo, acc[bt], 0, 0, 0);
                    acc[bt] = __builtin_amdgcn_mfma_f32_16x16x32_bf16(alo, bhi, acc[bt], 0, 0, 0);
                }
            }
        }
#pragma unroll
        for (int bt = 0; bt < 2; ++bt) *(LAS f32x4*)(part + (kh * 32 + 16 * bt + r) * 64 + cq * 16 + 4 * q) = acc[bt];
        __syncthreads();
        float* mod = (float*)(A.ws + WS_MOD);
        for (int o = tid; o < 32 * 64; o += NWAVES * 64) { const int bb = o >> 6, c = o & 63;
            mod[((size_t)l * BATCH + bb) * MODW + cg * 64 + c] = (part[bb * 64 + c] + part[(32 + bb) * 64 + c]) + A.in[3][(size_t)l * MODW + cg * 64 + c]; }
        __syncthreads();
    }
}

__device__ __forceinline__ float reduce16(float (&v)[16], int lane) {
#define R16_STEP(S, MSK) { const bool up = (lane & (MSK)) != 0; _Pragma("unroll") for (int i = 0; i < (S); ++i) { const float keep = up ? v[i + (S)] : v[i], send = up ? v[i] : v[i + (S)]; v[i] = keep + __shfl_xor(send, (MSK)); } }
    R16_STEP(8, 32) R16_STEP(4, 16) R16_STEP(2, 8) R16_STEP(1, 4)
#undef R16_STEP
    float r = v[0]; r += __shfl_xor(r, 1); r += __shfl_xor(r, 2); return r;
}
template <bool GATES>
__device__ __forceinline__ void norm_phase(Ctx& F, const float* src, const float* nw, const float* modl, int shift_off, int scale_off, bf16* hn, float* gates, const float* wgl, const float* bgl) {
    PHASE_TID();
    LAS float* wgs = (LAS float*)F.lds;
    if (GATES) { for (int i = tid; i < 16 * D / 4; i += NWAVES * 64) ((LAS f32x4*)wgs)[i] = ((const f32x4*)wgl)[i]; __syncthreads(); }
    const int gw = F.vcu * NWAVES + wave, NGW = F.G * NWAVES;
    f32x4 w[4];
#pragma unroll
    for (int j = 0; j < 4; ++j) w[j] = *(const f32x4*)(nw + 256 * j + 4 * lane);
    for (int item = gw; item < M / 32; item += NGW) {
        const int row0 = item * 32, b = row0 >> 11;
        f32x4 sc[4], sh[4];
#pragma unroll
        for (int j = 0; j < 4; ++j) { sc[j] = *(const f32x4*)(modl + (size_t)b * MODW + scale_off + 256 * j + 4 * lane); sh[j] = *(const f32x4*)(modl + (size_t)b * MODW + shift_off + 256 * j + 4 * lane);
            sc[j] = (sc[j] + 1.0f) * w[j]; }
        f32x4 xn[4];
#pragma unroll
        for (int j = 0; j < 4; ++j) xn[j] = *(const GAS f32x4*)(src + (size_t)row0 * D + 256 * j + 4 * lane);
        for (int r = 0; r < 32; ++r) {
            asm volatile("" ::: "memory");
            f32x4 x[4];
#pragma unroll
            for (int j = 0; j < 4; ++j) x[j] = xn[j];
            if (r + 1 < 32) {
#pragma unroll
                for (int j = 0; j < 4; ++j) xn[j] = *(const GAS f32x4*)(src + (size_t)(row0 + r + 1) * D + 256 * j + 4 * lane);
            }
            float ss = 0.f;
#pragma unroll
            for (int j = 0; j < 4; ++j) ss += (x[j].x * x[j].x + x[j].y * x[j].y) + (x[j].z * x[j].z + x[j].w * x[j].w);
            const float rstd = rsqrtf(wave_sum(ss) * (1.f / D) + RMS_EPS);
#pragma unroll
            for (int j = 0; j < 4; ++j) x[j] = x[j] * rstd * sc[j] + sh[j];
            GAS unsigned long long* o8 = (GAS unsigned long long*)(hn + (size_t)(row0 + r) * D) + lane;
#pragma unroll
            for (int j = 0; j < 4; ++j) o8[64 * j] = (unsigned long long)pk2(x[j].x, x[j].y) | ((unsigned long long)pk2(x[j].z, x[j].w) << 32);
            if (GATES) {
                float a[16];
#pragma unroll
                for (int g = 0; g < 16; ++g) { float s = 0.f;
#pragma unroll
                    for (int j = 0; j < 4; ++j) { const f32x4 wv = *(const LAS f32x4*)(wgs + g * D + 256 * j + 4 * lane); s += (x[j].x * wv.x + x[j].y * wv.y) + (x[j].z * wv.z + x[j].w * wv.w); }
                    a[g] = s; }
                const float tot = reduce16(a, lane);
                const int g = ((lane >> 5) & 1) * 8 + ((lane >> 4) & 1) * 4 + ((lane >> 3) & 1) * 2 + ((lane >> 2) & 1);
                if ((lane & 3) == 0) gates[(size_t)(row0 + r) * 16 + g] = tot + bgl[g];
            }
        }
    }
}

__device__ __forceinline__ void norm_gates_phase(Ctx& F, const float* src, const float* nw, const float* modl, int shift_off, int scale_off, bf16* hn, float* gates, const float* wgl, const float* bgl) {
    PHASE_TID();
    constexpr int RS = 2064;
    LAS unsigned char* tA = F.lds;
    LAS unsigned char* tB = F.lds + 2 * 16 * RS;
    LAS float* part = (LAS float*)(F.lds + 3 * 16 * RS);
    {
        f32x4 w8[8];
#pragma unroll
        for (int j = 0; j < 8; ++j) { const int i = tid + NWAVES * 64 * j, g = i >> 8, k4 = i & 255; w8[j] = *(const GAS f32x4*)(wgl + g * D + 4 * k4); }
#pragma unroll
        for (int j = 0; j < 8; ++j) { const int i = tid + NWAVES * 64 * j, g = i >> 8, k4 = i & 255;
            *(LAS v2u*)(tB + g * RS + 8 * k4) = (v2u){pg8::cvt_pk_bf16(w8[j][0], w8[j][1]), pg8::cvt_pk_bf16(w8[j][2], w8[j][3])}; }
    }
    f32x4 w[4];
#pragma unroll
    for (int j = 0; j < 4; ++j) w[j] = *(const f32x4*)(nw + 256 * j + 4 * lane);
    const int r = lane & 15, q = lane >> 4;
    for (int wgi = F.vcu; wgi < M / 256; wgi += F.G) {
        const int rowb = wgi * 256, b = rowb >> 11;
        f32x4 sc[4], sh[4];
#pragma unroll
        for (int j = 0; j < 4; ++j) { sc[j] = *(const f32x4*)(modl + (size_t)b * MODW + scale_off + 256 * j + 4 * lane); sh[j] = *(const f32x4*)(modl + (size_t)b * MODW + shift_off + 256 * j + 4 * lane);
            sc[j] = (sc[j] + 1.0f) * w[j]; }
        f32x4 xn[2][4];
#pragma unroll
        for (int rr = 0; rr < 2; ++rr)
#pragma unroll
            for (int j = 0; j < 4; ++j) xn[rr][j] = *(const GAS f32x4*)(src + (size_t)(rowb + 2 * wave + rr) * D + 256 * j + 4 * lane);
        for (int R = 0; R < 16; ++R) {
            const int row0 = rowb + 16 * R; LAS unsigned char* tAr = tA + (R & 1) * 16 * RS;
            f32x4 x[2][4];
#pragma unroll
            for (int rr = 0; rr < 2; ++rr)
#pragma unroll
                for (int j = 0; j < 4; ++j) x[rr][j] = xn[rr][j];
            if (R + 1 < 16) {
#pragma unroll
                for (int rr = 0; rr < 2; ++rr)
#pragma unroll
                    for (int j = 0; j < 4; ++j) xn[rr][j] = *(const GAS f32x4*)(src + (size_t)(row0 + 16 + 2 * wave + rr) * D + 256 * j + 4 * lane);
            }
#pragma unroll
            for (int rr = 0; rr < 2; ++rr) {
                float ss = 0.f;
#pragma unroll
                for (int j = 0; j < 4; ++j) ss += (x[rr][j].x * x[rr][j].x + x[rr][j].y * x[rr][j].y) + (x[rr][j].z * x[rr][j].z + x[rr][j].w * x[rr][j].w);
                const float rstd = rsqrtf(wave_sum(ss) * (1.f / D) + RMS_EPS);
                GAS unsigned long long* o8 = (GAS unsigned long long*)(hn + (size_t)(row0 + 2 * wave + rr) * D) + lane;
#pragma unroll
                for (int j = 0; j < 4; ++j) { const f32x4 hv = x[rr][j] * rstd * sc[j] + sh[j];
                    const v2u pk = (v2u){pg8::cvt_pk_bf16(hv.x, hv.y), pg8::cvt_pk_bf16(hv.z, hv.w)};
                    o8[64 * j] = (unsigned long long)pk.x | ((unsigned long long)pk.y << 32);
                    *(LAS v2u*)(tAr + (2 * wave + rr) * RS + (256 * j + 4 * lane) * 2) = pk; }
            }
            __syncthreads();
            f32x4 acc = (f32x4){0.f, 0.f, 0.f, 0.f};
#pragma unroll
            for (int ks = 0; ks < 4; ++ks) { const int kb = (128 * wave + 32 * ks + 8 * q) * 2;
                acc = __builtin_amdgcn_mfma_f32_16x16x32_bf16(*(const LAS bf16x8*)(tAr + r * RS + kb), *(const LAS bf16x8*)(tB + r * RS + kb), acc, 0, 0, 0); }
            *(LAS f32x4*)(part + wave * 256 + 64 * q + 4 * r) = acc;
            __syncthreads();
            if (tid < 256) { const int g = tid >> 4, rq = tid & 15;
                float s = bgl[g];
#pragma unroll
                for (int w8 = 0; w8 < 8; ++w8) s += part[w8 * 256 + 64 * (rq >> 2) + 4 * g + (rq & 3)];
                gates[(size_t)(row0 + rq) * 16 + g] = s; }
        }
        __syncthreads();
    }
}
__device__ __forceinline__ void final_norm_phase(Ctx& F, float* x, const float* nw) {
    PHASE_TID();
    const int gw = F.vcu * NWAVES + wave, NGW = F.G * NWAVES;
    f32x4 w[4];
#pragma unroll
    for (int j = 0; j < 4; ++j) w[j] = *(const f32x4*)(nw + 256 * j + 4 * lane);
    for (int row = gw; row < M; row += NGW) {
        GAS f32x4* xr = (GAS f32x4*)(x + (size_t)row * D) + lane;
        f32x4 v[4]; float ss = 0.f;
#pragma unroll
        for (int j = 0; j < 4; ++j) { v[j] = xr[64 * j]; ss += (v[j].x * v[j].x + v[j].y * v[j].y) + (v[j].z * v[j].z + v[j].w * v[j].w); }
        const float rstd = rsqrtf(wave_sum(ss) * (1.f / D) + RMS_EPS);
#pragma unroll
        for (int j = 0; j < 4; ++j) xr[64 * j] = v[j] * rstd * w[j];
    }
}

__device__ __forceinline__ void unpack8(const v4u& v, float (&o)[8]) {
#pragma unroll
    for (int e = 0; e < 4; ++e) { o[2 * e] = bf2f((unsigned short)(v[e] & 0xffffu)); o[2 * e + 1] = bf2f((unsigned short)(v[e] >> 16)); }
}
__device__ __forceinline__ void ffn_glu_phase(Ctx& F, const bf16* u, bf16* g, const float* cw, const float* cb) {
    PHASE_TID();
    constexpr int RB = 16, NCH = DFF / 8, NRB = FROWS / RB;
    const int gt = F.vcu * (NWAVES * 64) + tid, NGT = F.G * NWAVES * 64;
    for (int it = gt; it < NRB * NCH; it += NGT) {
        const int rb = it / NCH, ch = it - rb * NCH, f0 = ch * 8, row0 = rb * RB;
        const int cg0 = (f0 >> 7) * 256 + (f0 & 127);
        float wg_[3][8], wv_[3][8], bgv[8], bvv[8];
#pragma unroll
        for (int j = 0; j < 3; ++j)
#pragma unroll
            for (int e = 0; e < 8; ++e) { wg_[j][e] = cw[(size_t)j * 2 * DFF + f0 + e]; wv_[j][e] = cw[(size_t)j * 2 * DFF + DFF + f0 + e]; }
#pragma unroll
        for (int e = 0; e < 8; ++e) { bgv[e] = cb[f0 + e]; bvv[e] = cb[DFF + f0 + e]; }
        float g1[8], g2[8], v1[8], v2[8];
        const int t0 = row0 & (SEQ - 1);
#pragma unroll
        for (int e = 0; e < 8; ++e) { g1[e] = g2[e] = v1[e] = v2[e] = 0.f; }
        if (t0 >= 2) {
            const v4u a1 = *(const GAS v4u*)(u + (size_t)(row0 - 1) * 2 * DFF + cg0), a2 = *(const GAS v4u*)(u + (size_t)(row0 - 2) * 2 * DFF + cg0);
            const v4u b1 = *(const GAS v4u*)(u + (size_t)(row0 - 1) * 2 * DFF + cg0 + 128), b2 = *(const GAS v4u*)(u + (size_t)(row0 - 2) * 2 * DFF + cg0 + 128);
#pragma unroll
            for (int e = 0; e < 4; ++e) { g1[2 * e] = bf2f(a1[e] & 0xffff); g1[2 * e + 1] = bf2f(a1[e] >> 16); g2[2 * e] = bf2f(a2[e] & 0xffff); g2[2 * e + 1] = bf2f(a2[e] >> 16);
                v1[2 * e] = bf2f(b1[e] & 0xffff); v1[2 * e + 1] = bf2f(b1[e] >> 16); v2[2 * e] = bf2f(b2[e] & 0xffff); v2[2 * e + 1] = bf2f(b2[e] >> 16); }
        }
        for (int r = 0; r < RB; ++r) {
            const v4u a0 = *(const GAS v4u*)(u + (size_t)(row0 + r) * 2 * DFF + cg0), b0 = *(const GAS v4u*)(u + (size_t)(row0 + r) * 2 * DFF + cg0 + 128);
            float g0[8], v0[8], o[8];
#pragma unroll
            for (int e = 0; e < 4; ++e) { g0[2 * e] = bf2f(a0[e] & 0xffff); g0[2 * e + 1] = bf2f(a0[e] >> 16); v0[2 * e] = bf2f(b0[e] & 0xffff); v0[2 * e + 1] = bf2f(b0[e] >> 16); }
#pragma unroll
            for (int e = 0; e < 8; ++e) { const float cgv = bgv[e] + wg_[2][e] * g0[e] + wg_[1][e] * g1[e] + wg_[0][e] * g2[e]; const float cvv = bvv[e] + wv_[2][e] * v0[e] + wv_[1][e] * v1[e] + wv_[0][e] * v2[e];
                o[e] = siluf(cgv) * cvv; g2[e] = g1[e]; g1[e] = g0[e]; v2[e] = v1[e]; v1[e] = v0[e]; }
            v4u w; w.x = pk2(o[0], o[1]); w.y = pk2(o[2], o[3]); w.z = pk2(o[4], o[5]); w.w = pk2(o[6], o[7]);
            *(GAS v4u*)(g + (size_t)(row0 + r) * DFF + f0) = w;
        }
    }
}

__device__ __forceinline__ void ffn_fix_phase(Ctx& F, const bf16* S, bf16* G, const float* cw, const float* cb) {
    PHASE_TID();
    constexpr int NCH = DFF / 8, NG = M / 64;
    const int gt = F.vcu * (NWAVES * 64) + tid, NGT = F.G * NWAVES * 64;
    for (int it = gt; it < NG * NCH; it += NGT) {
        const int g64 = it / NCH, ch = it - g64 * NCH, f0 = ch * 8, col = (f0 >> 7) * 256 + (f0 & 127);
        const bool first = (g64 & 31) == 0;
        float c0g[8], c0v[8], c1g[8], c1v[8], p2g[8], p2v[8], p3g[8], p3v[8];
        { const bf16* sp = S + (size_t)g64 * 4 * (2 * DFF) + col;
          const v4u a = *(const GAS v4u*)sp, b = *(const GAS v4u*)(sp + 128), c = *(const GAS v4u*)(sp + 2 * DFF), d = *(const GAS v4u*)(sp + 2 * DFF + 128);
          unpack8(a, c0g); unpack8(b, c0v); unpack8(c, c1g); unpack8(d, c1v); }
        if (!first) { const bf16* sp = S + ((size_t)(g64 - 1) * 4 + 2) * (2 * DFF) + col;
          const v4u a = *(const GAS v4u*)sp, b = *(const GAS v4u*)(sp + 128), c = *(const GAS v4u*)(sp + 2 * DFF), d = *(const GAS v4u*)(sp + 2 * DFF + 128);
          unpack8(a, p2g); unpack8(b, p2v); unpack8(c, p3g); unpack8(d, p3v); }
        else {
#pragma unroll
            for (int e = 0; e < 8; ++e) { p2g[e] = p2v[e] = p3g[e] = p3v[e] = 0.f; } }
        float o0[8], o1[8];
        f32x4 W6[6][2], B2[2][2];
#pragma unroll
        for (int j = 0; j < 6; ++j) { W6[j][0] = *(const GAS f32x4*)(cw + j * DFF + f0); W6[j][1] = *(const GAS f32x4*)(cw + j * DFF + f0 + 4); }
#pragma unroll
        for (int j = 0; j < 2; ++j) { B2[j][0] = *(const GAS f32x4*)(cb + j * DFF + f0); B2[j][1] = *(const GAS f32x4*)(cb + j * DFF + f0 + 4); }
#pragma unroll
        for (int e = 0; e < 8; ++e) {
            const float wg0 = W6[0][e >> 2][e & 3], wg1 = W6[2][e >> 2][e & 3], wg2 = W6[4][e >> 2][e & 3], wv0 = W6[1][e >> 2][e & 3], wv1 = W6[3][e >> 2][e & 3], wv2 = W6[5][e >> 2][e & 3], bg = B2[0][e >> 2][e & 3], bv = B2[1][e >> 2][e & 3];
            const float g0 = bg + wg2 * c0g[e] + wg1 * p3g[e] + wg0 * p2g[e], v0 = bv + wv2 * c0v[e] + wv1 * p3v[e] + wv0 * p2v[e];
            const float g1 = bg + wg2 * c1g[e] + wg1 * c0g[e] + wg0 * p3g[e], v1 = bv + wv2 * c1v[e] + wv1 * c0v[e] + wv0 * p3v[e];
            o0[e] = g0 * __builtin_amdgcn_rcpf(1.f + __expf(-g0)) * v0; o1[e] = g1 * __builtin_amdgcn_rcpf(1.f + __expf(-g1)) * v1;
        }
        v4u w0, w1; w0.x = pg8::cvt_pk_bf16(o0[0], o0[1]); w0.y = pg8::cvt_pk_bf16(o0[2], o0[3]); w0.z = pg8::cvt_pk_bf16(o0[4], o0[5]); w0.w = pg8::cvt_pk_bf16(o0[6], o0[7]); w1.x = pg8::cvt_pk_bf16(o1[0], o1[1]); w1.y = pg8::cvt_pk_bf16(o1[2], o1[3]); w1.z = pg8::cvt_pk_bf16(o1[4], o1[5]); w1.w = pg8::cvt_pk_bf16(o1[6], o1[7]);
        *(GAS v4u*)(G + (size_t)(g64 * 64) * DFF + f0) = w0; *(GAS v4u*)(G + (size_t)(g64 * 64 + 1) * DFF + f0) = w1;
    }
}

constexpr int IMG_QM = 0, IMG_KM = 16384, IMG_VM = 32768, IMG_P = 49152, IMG_HQT = 57344, IMG_HKT = 73728, IMG_HV = 90112, PH_OFF = 106496, MF_OFF = 110592, HAB_OFF = 130048, OBB_OFF = 146432;
constexpr int MF_N = 0, MF_DFL = 128, MF_QN = 192, MF_RS = 256, MF_NRED = 384, MF_E7 = 1408, MF_E157 = 1920, MF_CW = 2432, MF_WN = 3712, MF_S0 = 3968  , MF_G = 4288  , MF_END = 4672;
static_assert(MF_OFF + MF_END * 4 <= HAB_OFF && OBB_OFF + 16384 <= MISC_OFF, "mixer LDS map");
constexpr int PO_MQ = 0, PO_MK = 128, PO_MV = 256, PO_HI = 384, PO_HQ = 512, PO_HF = 640, PO_CA = 768, PO_CB = 896;
typedef short s16x4 __attribute__((ext_vector_type(4)));
typedef short v4i16_t __attribute__((ext_vector_type(4)));
__device__ __forceinline__ unsigned offb(unsigned row, unsigned ch) { return 256u * row + 16u * (ch ^ (((row & 3u) << 2) | ((row >> 2) & 3u))); }
__device__ __forceinline__ bf16x8 ld16(LAS unsigned char* p) { return *(const LAS bf16x8*)p; }
__device__ __forceinline__ s16x4 ld8(LAS unsigned char* p) { return *(const LAS s16x4*)p; }
__device__ __forceinline__ s16x4 ldtr(LAS unsigned char* p) { return __builtin_bit_cast(s16x4, __builtin_amdgcn_ds_read_tr16_b64_v4i16((LAS v4i16_t*)p)); }
__device__ __forceinline__ bf16x8 cat8(s16x4 a, s16x4 b) { bf16x8 r; r[0] = a[0]; r[1] = a[1]; r[2] = a[2]; r[3] = a[3]; r[4] = b[0]; r[5] = b[1]; r[6] = b[2]; r[7] = b[3]; return r; }
__device__ __forceinline__ bf16x8 frag_row(LAS unsigned char* img, int row0, int ks, int lane) { return ld16(img + offb(row0 + (lane & 15), 4 * ks + (lane >> 4))); }
struct RowAddr { unsigned rb, rx; };
__device__ __forceinline__ RowAddr make_row_addr(int lane) { const unsigned r = lane & 15, q = lane >> 4; RowAddr a; a.rb = 256u * r; a.rx = 16u * (q ^ (((r & 3u) << 2) | ((r >> 2) & 3u))); return a; }
__device__ __forceinline__ bf16x8 frag_row2(LAS unsigned char* img, int row0, int ks, const RowAddr& a) { return ld16(img + 256 * row0 + (a.rb + (a.rx ^ (64u * ks)))); }
struct FragAddr { unsigned tb, tx0, tx1, hb0, hb1, hx0, hx1, qb, qy; };
__device__ __forceinline__ FragAddr make_frag_addr(int lane) {
    FragAddr f; const unsigned g = lane >> 4, qq = (lane & 15) >> 2, p = lane & 3, pb = p >> 1, r = lane & 15, q = lane >> 4;
    auto xs = [](unsigned row) { return ((row & 3u) << 2) | ((row >> 2) & 3u); };
    const unsigned ra = 8 * g + qq;
    f.tb = 256u * ra + 8u * (p & 1); f.tx0 = 16u * (pb ^ xs(ra)); f.tx1 = 16u * (pb ^ xs(ra + 4));
    const unsigned h0 = ra & 15u, h1 = (ra + 4) & 15u;
    f.hb0 = 256u * h0 + 8u * (p & 1); f.hb1 = 256u * h1 + 8u * (p & 1); f.hx0 = 16u * (pb ^ xs(h0)); f.hx1 = 16u * (pb ^ xs(h1));
    f.qb = 256u * r + 8u * (q & 1); f.qy = (16u * (q >> 1)) ^ (16u * xs(r));
    return f;
}
__device__ __forceinline__ bf16x8 frag_tr31(LAS unsigned char* img, int row0, int c, const FragAddr& f) {
    return cat8(ldtr(img + 256 * row0 + (f.tb + (f.tx0 ^ (32u * c)))), ldtr(img + 256 * row0 + 1024 + (f.tb + (f.tx1 ^ (32u * c)))));
}
__device__ __forceinline__ bf16x8 frag_tr15(LAS unsigned char* img, int row0, int c, const FragAddr& f) {
    return cat8(ldtr(img + 256 * row0 + (f.hb0 + (f.hx0 ^ (32u * c)))), ldtr(img + 256 * row0 + (f.hb1 + (f.hx1 ^ (32u * c)))));
}
__device__ __forceinline__ bf16x8 frag_q2(LAS unsigned char* img, int row0, int ks, const FragAddr& f) {
    return cat8(ld8(img + 256 * row0 + (f.qb + ((64u * ks) ^ f.qy))), ld8(img + 256 * row0 + (f.qb + ((64u * ks + 32u) ^ f.qy))));
}
__device__ __forceinline__ bf16x8 pack_acc(const f32x4& lo, const f32x4& hi) {
    v4u w; w.x = pg8::cvt_pk_bf16(lo[0], lo[1]); w.y = pg8::cvt_pk_bf16(lo[2], lo[3]); w.z = pg8::cvt_pk_bf16(hi[0], hi[1]); w.w = pg8::cvt_pk_bf16(hi[2], hi[3]);
    return __builtin_bit_cast(bf16x8, w);
}
__device__ __forceinline__ f32x4 mfma16(const bf16x8& a, const bf16x8& b, const f32x4& c) { return __builtin_amdgcn_mfma_f32_16x16x32_bf16(a, b, c, 0, 0, 0); }
__device__ __forceinline__ float rcpf_(float x) { return __builtin_amdgcn_rcpf(x); }
__device__ __forceinline__ float sigf(float x) { return rcpf_(1.f + __expf(-x)); }
__device__ __forceinline__ float silf(float x) { return x * rcpf_(1.f + __expf(-x)); }
__device__ __forceinline__ unsigned pkbf(float lo, float hi) { return pg8::cvt_pk_bf16(lo, hi); }
typedef __bf16 bf16x2_t __attribute__((ext_vector_type(2)));
__device__ __forceinline__ float dot2bf(unsigned a, unsigned b, float c) { return __builtin_amdgcn_fdot2_f32_bf16(__builtin_bit_cast(bf16x2_t, a), __builtin_bit_cast(bf16x2_t, b), c, false); }

#define MX_DPPF(v, ctrl) __builtin_bit_cast(float, __builtin_amdgcn_update_dpp(0, __builtin_bit_cast(int, (float)(v)), ctrl, 0xf, 0xf, false))
__device__ __forceinline__ float sum8_dpp(float x) { x += MX_DPPF(x, 0xB1); x += MX_DPPF(x, 0x4E); x += MX_DPPF(x, 0x141); return x; }
#define LN_FRESH(name) int name = lane; asm volatile("" : "+v"(name))
template <bool DRY>
__device__ __forceinline__ void mixer_fast_phase(Ctx& F, int layer, int seg) {
    PHASE_TID();
    ARGS();
    const bf16* Pcur = (const bf16*)(A.ws + WS_P + (size_t)(seg & PBUF_MASK) * P_BYTES);
    bf16* Halo = (bf16*)(A.ws + WS_HALO);
    const float* gates = (const float*)(A.ws + WS_GATES);
    const float* lbp = (const float*)(A.ws + WS_LB);
    bf16* Y = (bf16*)(A.ws + WS_Y);
    float* stC = (float*)(A.ws + WS_STC); float* stS = (float*)(A.ws + WS_STS); float* stN = (float*)(A.ws + WS_STN); float* stM = (float*)(A.ws + WS_STM);
    const float* cw = A.in[7] + (size_t)layer * 4 * 2048; const float* cb = A.in[8] + (size_t)layer * 2048;
    LAS unsigned char* L = F.lds;
    LAS float* MF = (LAS float*)(L + MF_OFF);
    for (int bhi = blockIdx.x; bhi < BATCH * NH; bhi += F.G) {
        const int bh = pg8::wg_bh(bhi), b = bh >> 3, h = bh & 7;
        { int l_; asm volatile("v_mbcnt_lo_u32_b32 %0, -1, 0\n\tv_mbcnt_hi_u32_b32 %0, -1, %0" : "=v"(l_)); tid = wave * 64 + l_; }
        for (int i = tid; i < 768; i += NWAVES * 64) { const int blk = i / 384, kind = (i % 384) >> 7, e = i & 127, cc = blk * 1024 + h * 128 + e;
            ((LAS unsigned*)(MF + MF_CW))[i] = kind < 2 ? pkbf(cw[(size_t)(2 * kind) * 2048 + cc], cw[(size_t)(2 * kind + 1) * 2048 + cc]) : __builtin_bit_cast(unsigned, cb[cc]); }
        for (int i = tid; i < 1024; i += NWAVES * 64) ((LAS unsigned*)(L + PH_OFF))[i] = 0u;
        if (tid < 128) MF[MF_WN + tid] = A.in[9][(size_t)layer * D + h * 128 + tid];
        if (tid >= 128 && tid < 256) MF[MF_WN + tid] = A.in[11][(size_t)layer * D + h * 128 + tid - 128];
        f32x4 Cacc[8], Sacc[8]; float mst;
        if (seg == 0) {
#pragma unroll
            for (int mb = 0; mb < 8; ++mb) { Cacc[mb] = (f32x4){0.f, 0.f, 0.f, 0.f}; Sacc[mb] = (f32x4){0.f, 0.f, 0.f, 0.f}; }
            mst = 0.f; if (tid < 128) MF[MF_N + tid] = 0.f;
        } else {
            int lane_l; asm volatile("v_mbcnt_lo_u32_b32 %0, -1, 0\n\tv_mbcnt_hi_u32_b32 %0, -1, %0" : "=v"(lane_l));
#pragma unroll
            for (int mb = 0; mb < 8; ++mb)
#pragma unroll
                for (int e = 0; e < 4; ++e) { Cacc[mb][e] = stC[((size_t)(bh * 8 + wave) * 32 + mb * 4 + e) * 64 + lane_l]; Sacc[mb][e] = stS[((size_t)(bh * 8 + wave) * 32 + mb * 4 + e) * 64 + lane_l]; }
            mst = stM[bh]; if (tid < 128) MF[MF_N + tid] = stN[bh * 128 + tid];
        }
        __syncthreads();
        v4u rawq3[2], rawk3[2], rawv[2], rawh[2]; unsigned rawhq[8], rawf[8];
#define MIX_LOAD_RAW(CC) do { int l_; asm volatile("v_mbcnt_lo_u32_b32 %0, -1, 0\n\tv_mbcnt_hi_u32_b32 %0, -1, %0" : "=v"(l_)); const int tid_ = wave * 64 + l_; \
              \
            const GAS char* pb_ = (const GAS char*)(Pcur + (size_t)(b * SEGT + 64 * (CC)) * PW + h * HB); \
            const unsigned o0_ = (unsigned)(((tid_ >> 4) * PW + (tid_ & 15) * 8) * 2); \
            _Pragma("unroll") for (int pass = 0; pass < 2; ++pass) { const GAS char* pp_ = pb_ + (size_t)(32 * pass) * PW * 2; \
                rawq3[pass] = *(const GAS v4u*)(pp_ + o0_ + PO_MQ * 2); rawk3[pass] = *(const GAS v4u*)(pp_ + o0_ + PO_MK * 2); rawv[pass] = *(const GAS v4u*)(pp_ + o0_ + PO_MV * 2); rawh[pass] = *(const GAS v4u*)(pp_ + o0_ + PO_HI * 2); } \
            { const GAS char* pr_ = pb_ + (size_t)(16 * (wave & 3) + 8 * (wave >> 2)) * PW * 2; const unsigned o1_ = 4u * (unsigned)l_; \
              _Pragma("unroll") for (int i = 0; i < 8; ++i) { rawhq[i] = *(const GAS unsigned*)(pr_ + (size_t)i * PW * 2 + o1_ + PO_HQ * 2); rawf[i] = *(const GAS unsigned*)(pr_ + (size_t)i * PW * 2 + o1_ + PO_HF * 2); } } } while (0)
#define MIX_STEP0(CC) do { int l_; asm volatile("v_mbcnt_lo_u32_b32 %0, -1, 0\n\tv_mbcnt_hi_u32_b32 %0, -1, %0" : "=v"(l_)); \
            const float gi = gi_n * (2.f / 15.f), gf = gf_n * (2.f / 15.f); \
            { const int cn2_ = (CC) + 1 < SEGT / 64 ? (CC) + 1 : (CC); const size_t g_ = (size_t)b * SEQ + seg * SEGT + 64 * cn2_ + l_; gi_n = gates[g_ * 16 + h]; gf_n = gates[g_ * 16 + 8 + h]; } \
            const float li = 15.f - 30.f * rcpf_(1.f + __expf(gi)); const float zf = 15.f - 30.f * rcpf_(1.f + __expf(gf)); \
            const float lf = fminf(zf, 0.f) - __logf(1.f + __expf(-fabsf(zf))); float bc = lf; \
            _Pragma("unroll") for (int d = 1; d < 64; d <<= 1) { const float t_ = __shfl_up(bc, d); if (l_ >= d) bc += t_; } \
            const float a_ = li - bc; float am = a_; \
            _Pragma("unroll") for (int o = 1; o < 64; o <<= 1) am = fmaxf(am, __shfl_xor(am, o)); \
            const float abar = fmaxf(mst, am); LAS float* sl_ = MF + MF_S0 + ((CC) & 1) * 160; \
            sl_[l_] = __expf(a_ - abar) * 0.08838834764831845f; sl_[64 + l_] = __expf(-(bc + abar)); if (l_ == 0) sl_[128] = __expf(mst - abar); \
            mst = __shfl(bc, 63) + abar; } while (0)
        MIX_LOAD_RAW(0);
        float gi_n = 0.f, gf_n = 0.f;
        if (wave == 1) { int l0; asm volatile("v_mbcnt_lo_u32_b32 %0, -1, 0\n\tv_mbcnt_hi_u32_b32 %0, -1, %0" : "=v"(l0)); const size_t g0 = (size_t)b * SEQ + seg * SEGT + l0; gi_n = gates[g0 * 16 + h]; gf_n = gates[g0 * 16 + 8 + h];
            MIX_STEP0(0); }
        __syncthreads();
        for (int c = 0; c < SEGT / 64; ++c) {
            const int tl0 = 64 * c; const size_t grow0 = (size_t)b * SEQ + seg * SEGT + tl0;
            int lane; asm volatile("v_mbcnt_lo_u32_b32 %0, -1, 0\n\tv_mbcnt_hi_u32_b32 %0, -1, %0" : "=v"(lane)); const int tid = wave * 64 + lane;
            const int r = lane & 15, q = lane >> 4;
            const int t4 = tid >> 3, c8 = tid & 7;
            const bf16* pc = Pcur + (size_t)(b * SEGT + tl0 + t4) * PW + h * HB + 16 * c8;
            const v4u ca0 = *(const GAS v4u*)(pc + PO_CA), ca1 = *(const GAS v4u*)(pc + PO_CA + 8), cb0 = *(const GAS v4u*)(pc + PO_CB), cb1 = *(const GAS v4u*)(pc + PO_CB + 8);
            const LAS float* S0 = MF + MF_S0 + (c & 1) * 160;
            const float decay = S0[128];
#pragma unroll
            for (int pass = 0; pass < 2; ++pass) {
                const int t = (tid >> 4) + 32 * pass, ch = tid & 15;
                const float rf = S0[t];
#pragma unroll
                for (int blk = 0; blk < 2; ++blk) {
                    float acc[8];
                    { const f32x4 b0 = *(const LAS f32x4*)(MF + MF_CW + blk * 384 + 256 + ch * 8), b1 = *(const LAS f32x4*)(MF + MF_CW + blk * 384 + 256 + ch * 8 + 4);
                      acc[0] = b0[0]; acc[1] = b0[1]; acc[2] = b0[2]; acc[3] = b0[3]; acc[4] = b1[0]; acc[5] = b1[1]; acc[6] = b1[2]; acc[7] = b1[3]; }
                    v4u rw[4];
                    if (c != 0) {
                        const bf16* pw_ = Pcur + (size_t)(b * SEGT + tl0 + t - 3) * PW + h * HB + (blk == 0 ? PO_MQ : PO_MK) + ch * 8;
#pragma unroll
                        for (int j = 0; j < 3; ++j) rw[j] = *(const GAS v4u*)(pw_ + (size_t)j * PW);
                    } else {
#pragma unroll
                    for (int j = 0; j < 3; ++j) { const int tq = tl0 + t - 3 + j; rw[j] = (v4u){0u, 0u, 0u, 0u};
                        if (seg * SEGT + tq >= 0) rw[j] = *(const GAS v4u*)(tq >= 0 ? Pcur + (size_t)(b * SEGT + tq) * PW + h * HB + (blk == 0 ? PO_MQ : PO_MK) + ch * 8 : Halo + (size_t)(bh * 3 + 3 + tq) * 256 + blk * 128 + ch * 8); }
                    }
                    rw[3] = blk == 0 ? rawq3[pass] : rawk3[pass];
                    { const v4u wa0 = *(const LAS v4u*)(MF + MF_CW + blk * 384 + ch * 8), wa1 = *(const LAS v4u*)(MF + MF_CW + blk * 384 + ch * 8 + 4), wb0 = *(const LAS v4u*)(MF + MF_CW + blk * 384 + 128 + ch * 8), wb1 = *(const LAS v4u*)(MF + MF_CW + blk * 384 + 128 + ch * 8 + 4);
#pragma unroll
                      for (int d = 0; d < 4; ++d) {
                        const unsigned lo01 = __builtin_amdgcn_perm(rw[1][d], rw[0][d], 0x05040100u), hi01 = __builtin_amdgcn_perm(rw[1][d], rw[0][d], 0x07060302u);
                        const unsigned lo23 = __builtin_amdgcn_perm(rw[3][d], rw[2][d], 0x05040100u), hi23 = __builtin_amdgcn_perm(rw[3][d], rw[2][d], 0x07060302u);
                        const unsigned w01l = d < 2 ? wa0[2 * d] : wa1[2 * d - 4], w01h = d < 2 ? wa0[2 * d + 1] : wa1[2 * d - 3], w23l = d < 2 ? wb0[2 * d] : wb1[2 * d - 4], w23h = d < 2 ? wb0[2 * d + 1] : wb1[2 * d - 3];
                        acc[2 * d] = dot2bf(lo23, w23l, dot2bf(lo01, w01l, acc[2 * d])); acc[2 * d + 1] = dot2bf(hi23, w23h, dot2bf(hi01, w01h, acc[2 * d + 1]));
                      } }
                    const float sc = blk == 0 ? 1.f : rf;
                    v4u o;
#pragma unroll
                    for (int d = 0; d < 4; ++d) { typedef float f32x2c __attribute__((ext_vector_type(2)));
                        const f32x2c a2 = (f32x2c){acc[2 * d], acc[2 * d + 1]}, e2 = a2 * -1.4426950408889634f;
                        const f32x2c d2 = (f32x2c){__builtin_amdgcn_exp2f(e2.x), __builtin_amdgcn_exp2f(e2.y)} + 1.f;
                        const f32x2c o2 = a2 * (f32x2c){rcpf_(d2.x), rcpf_(d2.y)} * sc;
                        o[d] = pkbf(o2.x, o2.y); }
                    *(LAS v4u*)(L + (blk == 0 ? IMG_QM : IMG_KM) + offb(t, ch)) = o;
                }
                *(LAS v4u*)(L + IMG_VM + offb(t, ch)) = rawv[pass];
                *(LAS v4u*)(L + IMG_HV + offb(t, ch)) = rawh[pass];
            }
            {
                const int j = wave & 3, hh = wave >> 2, trow = 16 * j + 8 * hh;
                typedef float f32x2 __attribute__((ext_vector_type(2)));
                f32x2 lbv = (f32x2){0.f, 0.f}; if (layer != 0) lbv = *(const GAS f32x2*)(lbp + h * 128 + 2 * lane);
                const f32x2 oml = 1.f - lbv;
                f32x2 fv[8], kv[8], qv[8];
#pragma unroll
                for (int i = 0; i < 8; ++i) {
                    const f32x2 xf = (f32x2){__builtin_bit_cast(float, rawf[i] << 16), __builtin_bit_cast(float, rawf[i] & 0xffff0000u)}, xq = (f32x2){__builtin_bit_cast(float, rawhq[i] << 16), __builtin_bit_cast(float, rawhq[i] & 0xffff0000u)};
                    const f32x2 ef = xf * -1.4426950408889634f, eq = xq * -1.4426950408889634f;
                    const f32x2 df = (f32x2){__builtin_amdgcn_exp2f(ef.x), __builtin_amdgcn_exp2f(ef.y)} + 1.f, dq = (f32x2){__builtin_amdgcn_exp2f(eq.x), __builtin_amdgcn_exp2f(eq.y)} + 1.f;
                    const f32x2 sv = (f32x2){rcpf_(df.x), rcpf_(df.y)}, rq = (f32x2){rcpf_(dq.x), rcpf_(dq.y)};
                    fv[i] = lbv + oml * sv;
                    kv[i] = oml - oml * sv;
                    qv[i] = xq * rq;
                }
                f32x2 runv = (f32x2){1.f, 1.f};
#define MIX_HG_STEPS(HH) _Pragma("unroll") for (int ii = 0; ii < 8; ++ii) { \
                    const int i = (HH) ? ii : 7 - ii;                               \
                    if (HH) runv = runv * fv[i]; \
                    const f32x2 rv = (f32x2){rcpf_(runv.x), rcpf_(runv.y)}; \
                    const unsigned xs_ = ((i & 3) << 2) | ((2 * (HH) + (i >> 2)) & 3);     \
                    LAS unsigned char* o_ = hgw + ((16u * xs_) ^ hgx) + 256 * i;            \
                    const f32x2 qo = qv[i] * ((HH) ? runv : rv), ko = kv[i] * ((HH) ? rv : runv); \
                    *(LAS unsigned*)(o_ + IMG_HQT) = pkbf(qo.x, qo.y); \
                    *(LAS unsigned*)(o_ + IMG_HKT) = pkbf(ko.x, ko.y); \
                    if (!(HH)) runv = runv * fv[i]; }
                LAS unsigned char* hgw = L + 256 * trow + 4 * (lane & 3); const unsigned hgx = 16u * (unsigned)(lane >> 2);
                if (hh) { MIX_HG_STEPS(1) } else { MIX_HG_STEPS(0) }
#undef MIX_HG_STEPS
                *(LAS f32x2*)(MF + (hh ? MF_E157 : MF_E7) + j * 128 + 2 * lane) = runv;
            }
            __syncthreads();
            const RowAddr RA = make_row_addr(lane);
            {
                const int tb = wave >> 1, sb0 = 2 * (wave & 1); float psum = 0.f;
                const bool do0 = sb0 <= tb, do1 = sb0 + 1 <= tb, wr1 = !(sb0 >= 2 && tb < 2);
                bf16x8 fQ[4], fK0[4], fK1[4];
                if (do0) {
                    const int rowk1 = do1 ? 16 * sb0 + 16 : 16 * sb0;
#pragma unroll
                    for (int ks = 0; ks < 4; ++ks) { fQ[ks] = frag_row2(L + IMG_QM, 16 * tb, ks, RA); fK0[ks] = frag_row2(L + IMG_KM, 16 * sb0, ks, RA); fK1[ks] = frag_row2(L + IMG_KM, rowk1, ks, RA); }
                    asm volatile("" ::: "memory");
                }
                f32x4 acc0 = (f32x4){0.f, 0.f, 0.f, 0.f}, acc1 = (f32x4){0.f, 0.f, 0.f, 0.f};
                if (do0) {
                    if (do1) {
#pragma unroll
                        for (int ks = 0; ks < 4; ++ks) { acc0 = mfma16(fK0[ks], fQ[ks], acc0); acc1 = mfma16(fK1[ks], fQ[ks], acc1); }
                    } else {
#pragma unroll
                        for (int ks = 0; ks < 4; ++ks) acc0 = mfma16(fK0[ks], fQ[ks], acc0);
                    }
                }
                if (wr1) {
                    const int t = 16 * tb + r;
#pragma unroll
                    for (int s2 = 0; s2 < 2; ++s2) {
                        const int sb = sb0 + s2, s0 = 16 * sb + 4 * q;
                        const f32x4 acc = s2 == 0 ? acc0 : acc1;
                        float v[4];
#pragma unroll
                        for (int e = 0; e < 4; ++e) { v[e] = (s0 + e <= t) ? acc[e] : 0.f; psum += v[e]; }
                        v2u w; w.x = pkbf(v[0], v[1]); w.y = pkbf(v[2], v[3]);
                        *(LAS v2u*)(L + IMG_P + 128 * t + 16 * ((2 * sb + (q >> 1)) ^ (t & 7)) + 8 * (q & 1)) = w;
                    }
                }
                psum += __shfl_xor(psum, 16); psum += __shfl_xor(psum, 32);
                if (q == 0) MF[MF_RS + 2 * (16 * tb + r) + (wave & 1)] = psum;
            }
            {
                const int t = tid >> 3, part = tid & 7;
                const v4u a0 = *(const LAS v4u*)(L + IMG_QM + offb(t, 2 * part)), a1 = *(const LAS v4u*)(L + IMG_QM + offb(t, 2 * part + 1));
                float x0[8], x1[8]; unpack8(a0, x0); unpack8(a1, x1);
                f32x4 dv = (f32x4){0.f, 0.f, 0.f, 0.f};
#pragma unroll
                for (int e4 = 0; e4 < 2; ++e4) { const f32x4 n0 = *(const LAS f32x4*)(MF + MF_N + 16 * part + 4 * e4), n1 = *(const LAS f32x4*)(MF + MF_N + 16 * part + 8 + 4 * e4);
                    dv += (f32x4){x0[4 * e4], x0[4 * e4 + 1], x0[4 * e4 + 2], x0[4 * e4 + 3]} * n0 + (f32x4){x1[4 * e4], x1[4 * e4 + 1], x1[4 * e4 + 2], x1[4 * e4 + 3]} * n1; }
                float d = (dv[0] + dv[1]) + (dv[2] + dv[3]);
                d = sum8_dpp(d);
                if (part == 0) MF[MF_QN + t] = d;
            }
            if (tid < 384) MF[MF_G + tid] = MF[MF_E7 + 128 + tid] * MF[MF_E157 + tid];
            if (wave == 1 && c + 1 < SEGT / 64) MIX_STEP0(c + 1);
#pragma unroll
            for (int jj = 0; jj < 2; ++jj) {
                const int j = jj == 0 ? (wave == 3 ? 0 : wave == 5 ? 1 : wave == 0 ? 2 : -1) : (wave == 3 ? 3 : -1);
                if (j < 0) continue;
                LN_FRESH(ln);
                f32x4 acc = (f32x4){0.f, 0.f, 0.f, 0.f};
#pragma unroll
                for (int ks = 0; ks < 4; ++ks) acc = mfma16(frag_row2(L + IMG_HKT, 16 * j, ks, RA), frag_row2(L + IMG_HQT, 16 * j, ks, RA), acc);
                float v[4];
#pragma unroll
                for (int e = 0; e < 4; ++e) v[e] = (4 * q + e <= r) ? acc[e] : 0.f;
                v2u w; w.x = pkbf(v[0], v[1]); w.y = pkbf(v[2], v[3]);
                *(LAS v2u*)(L + PH_OFF + j * 1024 + r * 64 + 8 * q) = w;
            }
            __syncthreads();
            f32x4 hval[4], oacc[4];
            FragAddr FA = make_frag_addr(lane);
#define FA_LAUNDER() asm volatile("" : "+v"(FA.tb), "+v"(FA.tx0), "+v"(FA.tx1), "+v"(FA.hb0), "+v"(FA.hb1), "+v"(FA.hx0), "+v"(FA.hx1), "+v"(FA.qb), "+v"(FA.qy))
            {
                f32x4 Cd[8];
#pragma unroll
                for (int mb = 0; mb < 8; ++mb) Cd[mb] = Cacc[mb] * decay;
                bf16x8 bC[4], bV[2];
#pragma unroll
                for (int ks = 0; ks < 4; ++ks) bC[ks] = pack_acc(Cd[2 * ks], Cd[2 * ks + 1]);
#pragma unroll
                for (int ks = 0; ks < 2; ++ks) bV[ks] = frag_tr31(L + IMG_VM, 32 * ks, wave, FA);
#pragma unroll
                for (int mt = 0; mt < 4; ++mt) {
                    f32x4 acc = (f32x4){0.f, 0.f, 0.f, 0.f}; FA_LAUNDER();
                    bf16x8 aQ[4], aP[2];
#pragma unroll
                    for (int ks = 0; ks < 4; ++ks) aQ[ks] = frag_q2(L + IMG_QM, 16 * mt, ks, FA);
#pragma unroll
                    for (int ks = 0; ks < 2; ++ks) if (ks == 0 || mt >= 2) { const int t = 16 * mt + r; aP[ks] = ld16(L + IMG_P + 128 * t + 16 * ((4 * ks + q) ^ (t & 7))); }
#pragma unroll
                    for (int ks = 0; ks < 4; ++ks) acc = mfma16(aQ[ks], bC[ks], acc);
#pragma unroll
                    for (int ks = 0; ks < 2; ++ks) if (ks == 0 || mt >= 2) acc = mfma16(aP[ks], bV[ks], acc);
                    const int t0 = 16 * mt + 4 * q;
                    const f32x4 r0 = *(const LAS f32x4*)(MF + MF_RS + 2 * t0), r1 = *(const LAS f32x4*)(MF + MF_RS + 2 * t0 + 4), qn4 = *(const LAS f32x4*)(MF + MF_QN + t0), df4 = *(const LAS f32x4*)(S0 + 64 + t0);
                    const float den0 = r0[0] + r0[1] + decay * qn4[0], den1 = r0[2] + r0[3] + decay * qn4[1], den2 = r1[0] + r1[1] + decay * qn4[2], den3 = r1[2] + r1[3] + decay * qn4[3];
                    hval[mt][0] = acc[0] * rcpf_(fmaxf(fabsf(den0), df4[0])); hval[mt][1] = acc[1] * rcpf_(fmaxf(fabsf(den1), df4[1])); hval[mt][2] = acc[2] * rcpf_(fmaxf(fabsf(den2), df4[2])); hval[mt][3] = acc[3] * rcpf_(fmaxf(fabsf(den3), df4[3]));
                }
#pragma unroll
                for (int mh = 0; mh < 2; ++mh) {
                    FA_LAUNDER();
                    bf16x8 aK[4][2];
#pragma unroll
                    for (int m4 = 0; m4 < 4; ++m4)
#pragma unroll
                        for (int ks = 0; ks < 2; ++ks) aK[m4][ks] = frag_tr31(L + IMG_KM, 32 * ks, 4 * mh + m4, FA);
#pragma unroll
                    for (int m4 = 0; m4 < 4; ++m4) { f32x4 acc = Cd[4 * mh + m4];
#pragma unroll
                        for (int ks = 0; ks < 2; ++ks) acc = mfma16(aK[m4][ks], bV[ks], acc);
                        Cacc[4 * mh + m4] = acc; }
                }
                {
                    FA_LAUNDER();
                    const bf16x8 ones = (bf16x8){0x3F80, 0x3F80, 0x3F80, 0x3F80, 0x3F80, 0x3F80, 0x3F80, 0x3F80};
                    f32x4 ns = (f32x4){0.f, 0.f, 0.f, 0.f};
#pragma unroll
                    for (int ks = 0; ks < 2; ++ks) ns = mfma16(frag_tr31(L + IMG_KM, 32 * ks, wave, FA), ones, ns);
                    if (r == 0) *(LAS f32x4*)(MF + MF_NRED + 16 * wave + 4 * q) = ns;
                }
            }
#pragma unroll
            for (int j = 0; j < 4; ++j) {
                FA_LAUNDER();
                bf16x8 aQ[4], aK[8];
#pragma unroll
                for (int ks = 0; ks < 4; ++ks) aQ[ks] = frag_q2(L + IMG_HQT, 16 * j, ks, FA);
                const bf16x8 aP = ld16(L + PH_OFF + j * 1024 + r * 64 + 16 * q);
                bf16x8 bVh = frag_tr15(L + IMG_HV, 16 * j, wave, FA);
#pragma unroll
                for (int mb = 0; mb < 8; ++mb) aK[mb] = frag_tr15(L + IMG_HKT, 16 * j, mb, FA);
                if (q >= 2) bVh = (bf16x8){0, 0, 0, 0, 0, 0, 0, 0};
                f32x4 T[8];
#pragma unroll
                for (int mb = 0; mb < 8; ++mb) T[mb] = Sacc[mb] * *(const LAS f32x4*)(MF + (j == 0 ? MF_E7 : MF_G + (j - 1) * 128) + 16 * mb + 4 * q);
                f32x4 acc = (f32x4){0.f, 0.f, 0.f, 0.f};
#pragma unroll
                for (int ks = 0; ks < 4; ++ks) acc = mfma16(aQ[ks], pack_acc(T[2 * ks], T[2 * ks + 1]), acc);
                acc = mfma16(aP, bVh, acc);
                oacc[j] = acc;
#pragma unroll
                for (int mb = 0; mb < 8; ++mb) { Sacc[mb] = mfma16(aK[mb], bVh, T[mb]); if (j == 3) Sacc[mb] = Sacc[mb] * *(const LAS f32x4*)(MF + MF_E157 + 3 * 128 + 16 * mb + 4 * q); }
            }
            {
            { const int cn_ = c + 1 < SEGT / 64 ? c + 1 : c; MIX_LOAD_RAW(cn_); }
            {
                const int dvc = 16 * wave + r; LAS unsigned char* ob_ = L + HAB_OFF + 1024 * q + 2 * (dvc & 7); const unsigned oa_ = 16u * (unsigned)((dvc >> 3) ^ q);
#pragma unroll
                for (int e = 0; e < 4; ++e) { LAS unsigned char* pe_ = ob_ + (oa_ ^ (64u * e)) + 256 * e;
#pragma unroll
                    for (int mt = 0; mt < 4; ++mt) { const unsigned w_ = pkbf(hval[mt][e], oacc[mt][e]);
                        *(LAS unsigned short*)(pe_ + 4096 * mt) = (unsigned short)(w_ & 0xffffu); *(LAS unsigned short*)(pe_ + (OBB_OFF - HAB_OFF) + 4096 * mt) = (unsigned short)(w_ >> 16); } }
            }
            __syncthreads();
            if (tid < 128) { MF[MF_N + tid] = decay * MF[MF_N + tid] + MF[MF_NRED + tid]; }
            {
                float ha[16], ob[16], ca[16], cb[16];
                const v4u a0 = *(const LAS v4u*)(L + HAB_OFF + offb(t4, 2 * c8)), a1 = *(const LAS v4u*)(L + HAB_OFF + offb(t4, 2 * c8 + 1)), b0 = *(const LAS v4u*)(L + OBB_OFF + offb(t4, 2 * c8)), b1 = *(const LAS v4u*)(L + OBB_OFF + offb(t4, 2 * c8 + 1));
                { float x[8]; unpack8(a0, x);
#pragma unroll
                  for (int e = 0; e < 8; ++e) ha[e] = x[e];
                  unpack8(a1, x);
#pragma unroll
                  for (int e = 0; e < 8; ++e) ha[8 + e] = x[e];
                  unpack8(b0, x);
#pragma unroll
                  for (int e = 0; e < 8; ++e) ob[e] = x[e];
                  unpack8(b1, x);
#pragma unroll
                  for (int e = 0; e < 8; ++e) ob[8 + e] = x[e];
                  unpack8(ca0, x);
#pragma unroll
                  for (int e = 0; e < 8; ++e) ca[e] = x[e];
                  unpack8(ca1, x);
#pragma unroll
                  for (int e = 0; e < 8; ++e) ca[8 + e] = x[e];
                  unpack8(cb0, x);
#pragma unroll
                  for (int e = 0; e < 8; ++e) cb[e] = x[e];
                  unpack8(cb1, x);
#pragma unroll
                  for (int e = 0; e < 8; ++e) cb[8 + e] = x[e]; }
                float ssa = 0.f, ssb = 0.f;
#pragma unroll
                for (int d = 0; d < 4; ++d) { ssa = dot2bf(a0[d], a0[d], ssa); ssa = dot2bf(a1[d], a1[d], ssa); ssb = dot2bf(b0[d], b0[d], ssb); ssb = dot2bf(b1[d], b1[d], ssb); }
                ssa = sum8_dpp(ssa); ssb = sum8_dpp(ssb);
                const float ra = rsqrtf(ssa * (1.f / 128.f) + RMS_EPS), rb = rsqrtf(ssb * (1.f / 128.f) + RMS_EPS);
                float y[16];
#pragma unroll
                for (int e4 = 0; e4 < 4; ++e4) { const f32x4 wa = *(const LAS f32x4*)(MF + MF_WN + 16 * c8 + 4 * e4), wb = *(const LAS f32x4*)(MF + MF_WN + 128 + 16 * c8 + 4 * e4);
#pragma unroll
                    for (int e = 0; e < 4; ++e) y[4 * e4 + e] = ca[4 * e4 + e] * (ha[4 * e4 + e] * ra * wa[e]) + cb[4 * e4 + e] * (ob[4 * e4 + e] * rb * wb[e]); }
                v4u o0, o1; o0.x = pkbf(y[0], y[1]); o0.y = pkbf(y[2], y[3]); o0.z = pkbf(y[4], y[5]); o0.w = pkbf(y[6], y[7]); o1.x = pkbf(y[8], y[9]); o1.y = pkbf(y[10], y[11]); o1.z = pkbf(y[12], y[13]); o1.w = pkbf(y[14], y[15]);
                bf16* yp = Y + (grow0 + t4) * D + h * 128 + 16 * c8;
                if (!DRY) { *(GAS v4u*)yp = o0; *(GAS v4u*)(yp + 8) = o1; } else { asm volatile("" :: "v"(o0), "v"(o1)); }
            }
            }
        }
        { int l_h; asm volatile("v_mbcnt_lo_u32_b32 %0, -1, 0\n\tv_mbcnt_hi_u32_b32 %0, -1, %0" : "=v"(l_h)); const int th = wave * 64 + l_h;
          if (!DRY && seg + 1 < NSEG && th < 96) { const int row = th >> 5, c16 = th & 31; *(GAS v4u*)(Halo + (size_t)(bh * 3 + row) * 256 + c16 * 8) = *(const GAS v4u*)(Pcur + (size_t)(b * SEGT + SEGT - 3 + row) * PW + h * HB + c16 * 8); } }
        int lane_s; asm volatile("v_mbcnt_lo_u32_b32 %0, -1, 0\n\tv_mbcnt_hi_u32_b32 %0, -1, %0" : "=v"(lane_s));
#pragma unroll
        for (int mb = 0; mb < 8; ++mb)
#pragma unroll
            for (int e = 0; e < 4; ++e) { if (!DRY && seg + 1 < NSEG) { stC[((size_t)(bh * 8 + wave) * 32 + mb * 4 + e) * 64 + lane_s] = Cacc[mb][e]; stS[((size_t)(bh * 8 + wave) * 32 + mb * 4 + e) * 64 + lane_s] = Sacc[mb][e]; } else { asm volatile("" :: "v"(Cacc[mb][e]), "v"(Sacc[mb][e])); } }
        __syncthreads();
        if (!DRY && seg + 1 < NSEG) { const int tid_s = wave * 64 + lane_s; if (tid_s < 128) stN[bh * 128 + tid_s] = MF[MF_N + tid_s];
        if (tid_s == 64) stM[bh] = mst; }
        __syncthreads();
    }
}

__global__ void __launch_bounds__(NWAVES * 64, 2) fwd_kernel(Args kernel_args_unused) {
    extern __shared__ __attribute__((aligned(16))) unsigned char lds[];
    Ctx F;
    F.lds = (LAS unsigned char*)lds;
    F.wave_s = __builtin_amdgcn_readfirstlane(threadIdx.x >> 6);
    F.G = gridDim.x; { const int bx = blockIdx.x; F.vcu = (F.G % 8 == 0) ? (bx % 8) * (F.G / 8) + bx / 8 : bx; }
    volatile LAS unsigned* MISC = (volatile LAS unsigned*)(F.lds + MISC_OFF);
    if (threadIdx.x < 64) MISC[threadIdx.x] = 0u;
    __syncthreads();
    unsigned bar_x;
    { ARGS(); const XcdBarrier b0 = xcd_barrier_post((unsigned*)((gu32*)(A.ws + WS_CTL) + CW_BAR), MISC + 8); bar_x = b0.x; }
#define GRID_BAR() do { ARGS(); XcdBarrier bb; bb.bar = (unsigned*)((gu32*)(A.ws + WS_CTL) + CW_BAR); bb.x = bar_x; asm volatile("" : "+s"(bb.x)); bb.st = (volatile LAS unsigned*)(F.lds + MISC_OFF) + 8; int l_b; asm volatile("v_mbcnt_lo_u32_b32 %0, -1, 0\n\tv_mbcnt_hi_u32_b32 %0, -1, %0" : "=v"(l_b)); const bool lead_b = (F.wave_s == 0) && (l_b == 0); xcd_barrier(bb, lead_b); } while (0)

    p0_prologue(F);
    GRID_BAR();

    for (int layer = 0; layer < DEPTH; ++layer) {
#define PHASE_PTRS() ARGS(); const float* src = layer == 0 ? A.in[0] : (const float*)A.out; const float* modl = (const float*)(A.ws + WS_MOD) + (size_t)layer * BATCH * MODW; bf16* hn = (bf16*)(A.ws + WS_HN); (void)src; (void)modl; (void)hn
        { PHASE_PTRS();
        norm_gates_phase(F, src, A.in[4] + (size_t)layer * D, modl, 0, D, hn, (float*)(A.ws + WS_GATES), (const float*)(A.ws + WS_WG) + (size_t)layer * 16 * D, (const float*)(A.ws + WS_BG) + layer * 16); }
        GRID_BAR();
#if defined(SEG_STAGGER) && SEG_STAGGER > 0
        {
            const unsigned long long t0_ = __builtin_amdgcn_s_memrealtime(), dt_ = (unsigned long long)((blockIdx.x >> 3) & 7) * SEG_STAGGER;
            while (__builtin_amdgcn_s_memrealtime() - t0_ < dt_) __builtin_amdgcn_s_sleep(8);
        }
#endif
        for (int seg = 0; seg < NSEG; ++seg) {
            {
                PHASE_PTRS();
                pg8::Gemm g{hn, (const bf16*)(A.ws + WS_WIN) + (size_t)layer * NPROJ * D, SEGROWS, NPROJ, D, SEG_SH, SEQ / 256, seg * (SEGT / 256), SEGT / 256 - 1};
                pg8::OwnOrder S; S.init(F.G, (int)blockIdx.x, SEGT / 256);
                pg8::EpiInProj E{(bf16*)(A.ws + WS_P + (size_t)(seg & PBUF_MASK) * P_BYTES), PW, (const float*)(A.ws + WS_BIASP) + (size_t)layer * NPROJ, -1};
                pg8::gemm_phase<pg8::EpiInProj, pg8::OwnOrder, PG8_ALIGN, PG8_SP2>(F.lds + RING_OFF, g, S, E, F.wave_s);
            }
            asm volatile("s_waitcnt vmcnt(0)" ::: "memory"); __syncthreads();
            mixer_fast_phase<false>(F, layer, seg);
            asm volatile("s_waitcnt vmcnt(0)" ::: "memory"); __syncthreads();
        }
        GRID_BAR();
        {
            PHASE_PTRS();
            pg8::Gemm g{(const bf16*)(A.ws + WS_Y), (const bf16*)(A.ws + WS_WOUT) + (size_t)layer * D * D, M, D, D, 0, 1, 0, 0};
            pg8::StaticOrder S; S.init(M, D, F.G, (int)blockIdx.x);
            pg8::EpiResid E{src, A.out, D, modl + 2 * D, MODW, 0, -1};
            pg8::gemm_phase<pg8::EpiResid, pg8::StaticOrder, PG8_ALIGN, PG8_SP2>(F.lds + RING_OFF, g, S, E, F.wave_s);
        }
        GRID_BAR();
        { PHASE_PTRS();
        norm_phase<false>(F, (const float*)A.out, A.in[13] + (size_t)layer * D, modl, 3 * D, 4 * D, hn, nullptr, nullptr, nullptr); }
        GRID_BAR();
        {
            PHASE_PTRS();
            pg8::Gemm g{hn, (const bf16*)(A.ws + WS_WUP) + (size_t)layer * 2 * DFF * D, M, 2 * DFF, D, 0, 1, 0, 0};
            pg8::StaticOrder S; S.init(M, 2 * DFF, F.G, (int)blockIdx.x);
            pg8::EpiUpGlu E{(bf16*)(A.ws + WS_G), (bf16*)(A.ws + WS_S), A.in[15] + (size_t)layer * 3 * 2 * DFF, A.in[16] + (size_t)layer * 2 * DFF, DFF, -1};
            pg8::gemm_phase<pg8::EpiUpGlu, pg8::StaticOrder, PG8_ALIGN, PG8_SP2>(F.lds + RING_OFF, g, S, E, F.wave_s);
        }
        GRID_BAR();
        { ARGS(); ffn_fix_phase(F, (const bf16*)(A.ws + WS_S), (bf16*)(A.ws + WS_G), A.in[15] + (size_t)layer * 3 * 2 * DFF, A.in[16] + (size_t)layer * 2 * DFF); }
        GRID_BAR();
        {
            PHASE_PTRS();
            pg8::Gemm g{(const bf16*)(A.ws + WS_G), (const bf16*)(A.ws + WS_WDN) + (size_t)layer * D * DFF, M, D, DFF, 0, 1, 0, 0};
            pg8::StaticOrder S; S.init(M, D, F.G, (int)blockIdx.x);
            pg8::EpiResid E{(const float*)A.out, A.out, D, modl + 5 * D, MODW, 0, -1};
            pg8::gemm_phase<pg8::EpiResid, pg8::StaticOrder, PG8_ALIGN, PG8_SP2>(F.lds + RING_OFF, g, S, E, F.wave_s);
        }
        GRID_BAR();
    }
    { ARGS(); final_norm_phase(F, A.out, A.in[18]); }

#undef GRID_BAR
}

extern "C" void kernel_launch(void* const* d_in, const int* in_sizes, int n_in, void* d_out, int out_size, void* d_ws, size_t ws_size, hipStream_t stream) {
    static int grid = 0;
    if (grid == 0) {
        if (n_in != 19 || in_sizes[0] != M * D || out_size != M * D || ws_size < WS_END) { fprintf(stderr, "kernel_launch: unexpected shapes (n_in %d, in0 %d, out %d, ws %zu; need ws >= %zu); nothing launched\n", n_in, n_in > 0 ? in_sizes[0] : -1, out_size, ws_size, (size_t)WS_END); grid = -1; return; }
        int dev = 0, cus = 0, per_cu = 0;
        if (hipGetDevice(&dev) != hipSuccess || hipDeviceGetAttribute(&cus, hipDeviceAttributeMultiprocessorCount, dev) != hipSuccess) { grid = -1; return; }
        if (hipFuncSetAttribute((const void*)fwd_kernel, hipFuncAttributeMaxDynamicSharedMemorySize, LDS_BYTES) != hipSuccess) { fprintf(stderr, "kernel_launch: hipFuncSetAttribute failed\n"); grid = -1; return; }
        if (hipOccupancyMaxActiveBlocksPerMultiprocessor(&per_cu, (const void*)fwd_kernel, NWAVES * 64, LDS_BYTES) != hipSuccess || per_cu < 1)
            fprintf(stderr, "kernel_launch: note: occupancy query reports %d workgroups per CU\n", per_cu);
        (void)hipGetLastError();
        grid = cus;
    }
    if (grid < 0) return;
    if (hipMemsetAsync((char*)d_ws + WS_CTL, 0, CTL_ZERO_BYTES, stream) != hipSuccess) return;
    Args a{};
    for (int i = 0; i < 19; ++i) a.in[i] = (const float*)d_in[i];
    a.out = (float*)d_out; a.ws = (unsigned char*)d_ws;
    hipLaunchKernelGGL(fwd_kernel, dim3(grid), dim3(NWAVES * 64), LDS_BYTES, stream, a);
}
```
